# Optimizing an MI355X kernel written in HIP

```python
import jax, jax.numpy as jnp
from jax import lax
import numpy as np

D_MODEL = 1024
BATCH = 2
SEQ = 8192
DEPTH = 2

GRID_W = 64
CTX_LEN = 256
N_EVEN = (DEPTH + 1) // 2
N_ODD = DEPTH // 2
N_MOD = 6
EPS = 1e-6
NEG = -1e30
D_LRU = D_MODEL // 2
LRU_HEADS = 8
LRU_HEAD_DIM = D_LRU // LRU_HEADS
LRU_C = 8.0
CONV_A_W = 4
D_SC = D_MODEL // 2
CONV_B_W = 3
RC_IN_WIDTH = 2 * D_LRU + 3 * D_SC
HEAD_DIM = 64
N_Q_HEADS = D_MODEL // HEAD_DIM
N_KV_HEADS = 4
GQA_GROUP = N_Q_HEADS // N_KV_HEADS
D_Q = N_Q_HEADS * HEAD_DIM
D_KV = N_KV_HEADS * HEAD_DIM
WINDOW = 128
BLOCK = 128
ROPE_BASE = 10000.0
ROPE_FREQS = HEAD_DIM // 4
D_FF = -(-8 * D_MODEL // (3 * 256)) * 256

kernel_name = "hybrid_rglru_shortconv_swa_dit_prefix"


def rmsnorm(x, g):
    x32 = x.astype(jnp.float32)
    y = x32 * lax.rsqrt(jnp.mean(x32 * x32, axis=-1, keepdims=True) + EPS)
    return (y * g.astype(jnp.float32)).astype(x.dtype)


def modulate(h, shift, scale):
    return h * (1 + scale) + shift


def swiglu(h, w_in, w_out):
    g, u = jnp.split(h @ w_in, 2, axis=-1)
    return (jax.nn.silu(g) * u) @ w_out


def depthwise_conv(x, w, pad):
    return lax.conv_general_dilated(
        x, w[:, None, :], window_strides=(1,), padding=[pad],
        dimension_numbers=('NWC', 'WIO', 'NWC'), feature_group_count=x.shape[-1])


def block_diag(x, w, b):
    B_, T, _ = x.shape
    xh = x.reshape(B_, T, LRU_HEADS, LRU_HEAD_DIM)
    return (jnp.einsum('bthi,hij->bthj', xh, w) + b).reshape(B_, T, D_LRU)


def rglru_coeffs(xc, r_w, r_b, i_w, i_b, lam):
    r = jax.nn.sigmoid(block_diag(xc, r_w, r_b).astype(jnp.float32))
    ig = jax.nn.sigmoid(block_diag(xc, i_w, i_b).astype(jnp.float32))
    log_a = -LRU_C * r * jax.nn.softplus(-lam.astype(jnp.float32))
    a = jnp.exp(log_a)
    mult = jnp.sqrt(jnp.maximum(-jnp.expm1(2.0 * log_a), 1e-12))
    return a, mult * ig * xc.astype(jnp.float32)


def _lin_combine(left, right):
    a_l, b_l = left
    a_r, b_r = right
    return a_r * a_l, a_r * b_l + b_r


def linear_scan(a, b, h0):
    a_cum, b_cum = lax.associative_scan(_lin_combine, (a, b), axis=1)
    h = a_cum * h0[:, None, :] + b_cum
    return h, h[:, -1]


def bidir_rglru(xc_c, xc_l, r_w, r_b, i_w, i_b, lam):
    outs_c, outs_l = [], []
    for d in range(2):
        ac, bc = rglru_coeffs(xc_c, r_w[d], r_b[d], i_w[d], i_b[d], lam[d])
        al, bl = rglru_coeffs(xc_l, r_w[d], r_b[d], i_w[d], i_b[d], lam[d])
        if d == 1:
            ac, bc, al, bl = (jnp.flip(t, axis=1) for t in (ac, bc, al, bl))
        hc, hc_last = linear_scan(ac, bc, jnp.zeros_like(ac[:, 0]))
        hl, _ = linear_scan(al, bl, hc_last)
        if d == 1:
            hc, hl = jnp.flip(hc, axis=1), jnp.flip(hl, axis=1)
        outs_c.append(hc)
        outs_l.append(hl)
    return outs_c[0] + outs_c[1], outs_l[0] + outs_l[1]


def rc_mixer(hc, hl, w_in, conv_a_w, conv_a_b, r_w, r_b, i_w, i_b, lam, conv_b_w, w_out, ctx_out):
    splits = [D_LRU, 2 * D_LRU, 2 * D_LRU + D_SC, 2 * D_LRU + 2 * D_SC]
    xa_c, ga_c, bg_c, cg_c, v_c = jnp.split(hc @ w_in, splits, axis=-1)
    xa_l, ga_l, bg_l, cg_l, v_l = jnp.split(hl @ w_in, splits, axis=-1)
    xa_c = depthwise_conv(xa_c, conv_a_w, (2, 1)) + conv_a_b
    xa_l = depthwise_conv(xa_l, conv_a_w, (2, 1)) + conv_a_b
    hsum_c, hsum_l = bidir_rglru(xa_c, xa_l, r_w, r_b, i_w, i_b, lam)

    def merge(hsum, ga, bg, cg, v):
        ya = hsum.astype(ga.dtype) * jax.nn.gelu(ga)
        yb = bg * depthwise_conv(cg * v, conv_b_w, (1, 1))
        return jnp.concatenate([ya, yb], axis=-1) @ w_out

    yl = merge(hsum_l, ga_l, bg_l, cg_l, v_l)
    yc = merge(hsum_c, ga_c, bg_c, cg_c, v_c) if ctx_out else None
    return yc, yl


def rope_2d(x, cos, sin):
    S = x.shape[1]
    bshape = (1, S) + (1,) * (x.ndim - 3) + (2, ROPE_FREQS)
    c, s = cos.reshape(bshape), sin.reshape(bshape)
    xr = x.reshape(x.shape[:-1] + (2, 2, ROPE_FREQS))
    x1, x2 = xr[..., 0, :], xr[..., 1, :]
    out = jnp.stack([x1 * c - x2 * s, x2 * c + x1 * s], axis=-2)
    return out.reshape(x.shape)


def attn_mixer(hc, hl, w_qkv, sink, w_out, cos, sin, ctx_out):
    B_, S, _ = hl.shape
    T = hc.shape[1]
    nb = S // BLOCK
    scale = HEAD_DIM ** -0.5

    def qkv(h):
        L = h.shape[1]
        q, k, v = jnp.split(h @ w_qkv, [D_Q, D_Q + D_KV], axis=-1)
        return (q.reshape(B_, L, N_KV_HEADS, GQA_GROUP, HEAD_DIM),
                k.reshape(B_, L, N_KV_HEADS, HEAD_DIM),
                v.reshape(B_, L, N_KV_HEADS, HEAD_DIM))

    ql, kl, vl = qkv(hl)
    qc, kc, vc = qkv(hc)
    ql, kl = rope_2d(ql, cos, sin), rope_2d(kl, cos, sin)
    sink32 = sink.astype(jnp.float32).reshape(N_KV_HEADS, GQA_GROUP, 1, 1)

    qb = ql.reshape(B_, nb, BLOCK, N_KV_HEADS, GQA_GROUP, HEAD_DIM) * scale

    def band(t):
        tb = t.reshape(B_, nb, BLOCK, N_KV_HEADS, HEAD_DIM)
        tp = jnp.pad(tb, ((0, 0), (1, 1), (0, 0), (0, 0), (0, 0)))
        return jnp.concatenate([tp[:, :-2], tp[:, 1:-1], tp[:, 2:]], axis=2)

    kw, vw = band(kl), band(vl)
    qi = jnp.arange(BLOCK)[:, None]
    kj = jnp.arange(3 * BLOCK)[None, :]
    in_window = jnp.abs(kj - BLOCK - qi) <= WINDOW
    kblk = jnp.arange(nb)[:, None] + (jnp.arange(3 * BLOCK) // BLOCK)[None, :] - 1
    valid = (kblk >= 0) & (kblk < nb)
    mask = in_window[None] & valid[:, None, :]

    s_win = jnp.einsum('bnqhgd,bnkhd->bnhgqk', qb, kw).astype(jnp.float32)
    s_win = jnp.where(mask[None, :, None, None], s_win, NEG)
    s_ctx = jnp.einsum('bnqhgd,bchd->bnhgqc', qb, kc).astype(jnp.float32)
    m = jnp.maximum(jnp.maximum(s_win.max(-1, keepdims=True), s_ctx.max(-1, keepdims=True)), sink32)
    e_win = jnp.exp(s_win - m)
    e_ctx = jnp.exp(s_ctx - m)
    denom = e_win.sum(-1, keepdims=True) + e_ctx.sum(-1, keepdims=True) + jnp.exp(sink32 - m)
    o = (jnp.einsum('bnhgqk,bnkhd->bnhgqd', e_win.astype(vl.dtype), vw)
         + jnp.einsum('bnhgqc,bchd->bnhgqd', e_ctx.astype(vl.dtype), vc))
    o = (o / denom.astype(o.dtype)).transpose(0, 1, 4, 2, 3, 5).reshape(B_, S, D_Q)
    yl = o @ w_out

    yc = None
    if ctx_out:
        sc = jnp.einsum('bihgd,bjhd->bhgij', qc * scale, kc).astype(jnp.float32)
        mc = jnp.maximum(sc.max(-1, keepdims=True), sink32)
        ec = jnp.exp(sc - mc)
        dc = ec.sum(-1, keepdims=True) + jnp.exp(sink32 - mc)
        oc = jnp.einsum('bhgij,bjhd->bhgid', ec.astype(vc.dtype), vc) / dc.astype(vc.dtype)
        yc = oc.transpose(0, 3, 1, 2, 4).reshape(B_, T, D_Q) @ w_out
    return yc, yl


def setup_inputs(seed: int = 0) -> dict:
    key = jax.random.key(seed)
    ks = iter(jax.random.split(key, 40))
    D = D_MODEL

    def nrm(shape, scale):
        return jax.random.normal(next(ks), shape, jnp.float32) * scale

    a_c = jax.random.uniform(next(ks), (N_EVEN, 2, D_LRU), jnp.float32, minval=0.9, maxval=0.999)
    sig = a_c ** (1.0 / LRU_C)
    rc_lambda = jnp.log(sig) - jnp.log1p(-sig)
    return {
        "x": nrm((BATCH, SEQ, D), 1.0),
        "c": nrm((BATCH, D), 1.0),
        "ctx": nrm((BATCH, CTX_LEN, D), 1.0),
        "c_ctx": nrm((D,), 1.0),
        "ada_w": nrm((DEPTH, D, N_MOD * D), 0.5 * D ** -0.5),
        "ada_b": nrm((DEPTH, N_MOD * D), 0.02),
        "norm_mix_g": 1.0 + nrm((DEPTH, D), 0.05),
        "norm_ffn_g": 1.0 + nrm((DEPTH, D), 0.05),
        "norm_final_g": 1.0 + nrm((D,), 0.05),
        "ffn_w_in": nrm((DEPTH, D, 2 * D_FF), D ** -0.5),
        "ffn_w_out": nrm((DEPTH, D_FF, D), D_FF ** -0.5),
        "rc_w_in": nrm((N_EVEN, D, RC_IN_WIDTH), D ** -0.5),
        "rc_conv_a_w": nrm((N_EVEN, CONV_A_W, D_LRU), CONV_A_W ** -0.5),
        "rc_conv_a_b": nrm((N_EVEN, D_LRU), 0.02),
        "rc_gate_r_w": nrm((N_EVEN, 2, LRU_HEADS, LRU_HEAD_DIM, LRU_HEAD_DIM), LRU_HEAD_DIM ** -0.5),
        "rc_gate_r_b": nrm((N_EVEN, 2, LRU_HEADS, LRU_HEAD_DIM), 0.02),
        "rc_gate_i_w": nrm((N_EVEN, 2, LRU_HEADS, LRU_HEAD_DIM, LRU_HEAD_DIM), LRU_HEAD_DIM ** -0.5),
        "rc_gate_i_b": nrm((N_EVEN, 2, LRU_HEADS, LRU_HEAD_DIM), 0.02),
        "rc_lambda": rc_lambda,
        "rc_conv_b_w": nrm((N_EVEN, CONV_B_W, D_SC), CONV_B_W ** -0.5),
        "rc_w_out": nrm((N_EVEN, D_LRU + D_SC, D), (D_LRU + D_SC) ** -0.5),
        "at_w_qkv": nrm((N_ODD, D, D_Q + 2 * D_KV), D ** -0.5),
        "at_sink": nrm((N_ODD, N_Q_HEADS), 0.5),
        "at_w_out": nrm((N_ODD, D_Q, D), D_Q ** -0.5),
    }


def reference(x, c, ctx, c_ctx, ada_w, ada_b, norm_mix_g, norm_ffn_g, norm_final_g,
              ffn_w_in, ffn_w_out, rc_w_in, rc_conv_a_w, rc_conv_a_b, rc_gate_r_w, rc_gate_r_b,
              rc_gate_i_w, rc_gate_i_b, rc_lambda, rc_conv_b_w, rc_w_out,
              at_w_qkv, at_sink, at_w_out):
    S = x.shape[1]
    ROWS = S // GRID_W
    row = jnp.repeat(jnp.arange(ROWS), GRID_W).astype(jnp.float32)
    col = jnp.tile(jnp.arange(GRID_W), ROWS).astype(jnp.float32)
    inv_freq = ROPE_BASE ** (-jnp.arange(ROPE_FREQS, dtype=jnp.float32) / ROPE_FREQS)
    ang = jnp.stack([row[:, None] * inv_freq, col[:, None] * inv_freq], axis=1)
    cos, sin = jnp.cos(ang).astype(x.dtype), jnp.sin(ang).astype(x.dtype)

    silu_c = jax.nn.silu(c)
    silu_cc = jax.nn.silu(c_ctx)
    xl, xc = x, ctx
    for i in range(DEPTH):
        last = i == DEPTH - 1
        j = i // 2
        mod_l = jnp.split((silu_c @ ada_w[i] + ada_b[i])[:, None, :], N_MOD, axis=-1)
        mod_c = jnp.split(silu_cc @ ada_w[i] + ada_b[i], N_MOD, axis=-1)
        sh1_l, sc1_l, g1_l, sh2_l, sc2_l, g2_l = mod_l
        sh1_c, sc1_c, g1_c, sh2_c, sc2_c, g2_c = mod_c

        hl = modulate(rmsnorm(xl, norm_mix_g[i]), sh1_l, sc1_l)
        hc = modulate(rmsnorm(xc, norm_mix_g[i]), sh1_c, sc1_c)
        if i % 2 == 0:
            yc, yl = rc_mixer(hc, hl, rc_w_in[j], rc_conv_a_w[j], rc_conv_a_b[j],
                              rc_gate_r_w[j], rc_gate_r_b[j], rc_gate_i_w[j], rc_gate_i_b[j],
                              rc_lambda[j], rc_conv_b_w[j], rc_w_out[j], not last)
        else:
            yc, yl = attn_mixer(hc, hl, at_w_qkv[j], at_sink[j], at_w_out[j], cos, sin, not last)

        xl = xl + g1_l * yl
        hl = modulate(rmsnorm(xl, norm_ffn_g[i]), sh2_l, sc2_l)
        xl = xl + g2_l * swiglu(hl, ffn_w_in[i], ffn_w_out[i])
        if not last:
            xc = xc + g1_c * yc
            hc = modulate(rmsnorm(xc, norm_ffn_g[i]), sh2_c, sc2_c)
            xc = xc + g2_c * swiglu(hc, ffn_w_in[i], ffn_w_out[i])
    return rmsnorm(xl, norm_final_g)
```

```cpp
#include <hip/hip_runtime.h>
#include <hip/hip_cooperative_groups.h>
#include <cstdio>
#include <cstdint>
namespace cg = cooperative_groups;
namespace pg8 {
#define PG8_LAS __attribute__((address_space(3)))
typedef unsigned short bf16_t;
typedef short bf16x8 __attribute__((ext_vector_type(8)));
typedef float f32x4 __attribute__((ext_vector_type(4)));
typedef unsigned u32x4 __attribute__((ext_vector_type(4)));
constexpr int BM = 256, BK = 64, HALF = 128, HTB = HALF * BK * 2  , STAGE_BYTES = 8 * HTB, NXCD = 8, WGM = 8;

__host__ __device__ __forceinline__ int lds_byte(int r, int c) { const int st = (r >> 4) * 2 + (c >> 5), rr = r & 15, cc = c & 31, ob = rr * 64 + cc * 2; return st * 1024 + (ob ^ (((ob >> 9) & 1) << 5)); }
__host__ __device__ __forceinline__ void stage_rc(int b, int& R, int& C) { const int st = b / 1024, sb = b % 1024, swz = sb ^ (((sb >> 9) & 1) << 5); R = (st >> 1) * 16 + swz / 64; C = (st & 1) * 32 + (swz % 64) / 2; }
__host__ __device__ __forceinline__ int perm32(int rho) { const int n = rho >> 4, i = rho & 15; return 8 * (i >> 2) + 4 * n + (i & 3); }

struct Unit { int pm, pn, ord; };
struct Gemm { const bf16_t* A; const bf16_t* Bt; int M, N, K; };

struct StaticOrder {
    int nM, nN, nwg, G, c;
    __host__ __device__ void init(int M, int N, int G_, int c_) { nM = M / BM; nN = N / BM; nwg = nM * nN; G = G_; c = c_; }
    __host__ __device__ bool next(int i, Unit& u) const {
        const long L = (long)i * G + c; if (L >= nwg) return false;
        int wgid = (int)L; { const int q = nwg / NXCD, r = nwg % NXCD, xcd = wgid % NXCD, off = wgid / NXCD; wgid = (xcd < r ? xcd * (q + 1) : r * (q + 1) + (xcd - r) * q) + off; }
        const int nig = WGM * nN, gid = wgid / nig, fm = gid * WGM, gsz = (nM - fm) < WGM ? (nM - fm) : WGM;
        u.pm = fm + ((wgid % nig) % gsz); u.pn = (wgid % nig) / gsz; return true;
    }
    __device__ __forceinline__ void a_ready(const Unit&) const {}
    __device__ __forceinline__ void done(const Unit&) const {}
};
template <class Epi, class Sched, bool ALIGN_EPI = false, bool SP2 = false>
__device__ __forceinline__ void gemm_phase(PG8_LAS unsigned char* lds, const Gemm g, const Sched& S, const Epi& E) {
    const int tid = threadIdx.x, wid = __builtin_amdgcn_readfirstlane(tid >> 6), lane = tid & 63, wr = wid >> 2, wc = wid & 3, fr = lane & 15, fq = lane >> 4;
    const int K = g.K, nt = K / BK;
    unsigned voffA[2], voffB[2];
#pragma unroll
    for (int i = 0; i < 2; ++i) { int R, C; stage_rc(tid * 16 + i * 8192, R, C); const int Rb = Epi::PERM ? ((R & ~31) + perm32(R & 31)) : R;
        voffA[i] = (unsigned)(R * K + C) * 2u; voffB[i] = (unsigned)(Rb * K + C) * 2u; }
    const size_t kstep = (size_t)(BK * 2);
    const size_t hstep = (size_t)HALF * K * 2;
    const size_t tstep = 2 * hstep;
    const unsigned ldsw = (unsigned)wid * 1024u;
    const int aoff = lds_byte(wr * 64 + fr, fq * 8), boff = lds_byte(wc * 32 + fr, fq * 8);
#define PG8_SA(b, h) (((b) * 2 + (h)) * HTB)
#define PG8_SB(b, h) ((4 + (b) * 2 + (h)) * HTB)
#define PG8_STAGE(bufoff, gbase, voff) do { _Pragma("unroll") for (int _i = 0; _i < 2; ++_i) \
        __builtin_amdgcn_global_load_lds((const unsigned*)((const char*)(gbase) + (voff)[_i]), (PG8_LAS unsigned*)(lds + (bufoff) + ldsw + _i * 8192), 16, 0, 0); } while (0)
#define PG8_LDA(dst, b, h) do { _Pragma("unroll") for (int m = 0; m < 4; ++m) _Pragma("unroll") for (int k = 0; k < 2; ++k) dst[m][k] = *(const PG8_LAS bf16x8*)(lds + PG8_SA(b, h) + aoff + m * 2048 + k * 1024); } while (0)
#define PG8_LDB(dst, b, h) do { _Pragma("unroll") for (int n = 0; n < 2; ++n) _Pragma("unroll") for (int k = 0; k < 2; ++k) dst[n][k] = *(const PG8_LAS bf16x8*)(lds + PG8_SB(b, h) + boff + n * 2048 + k * 1024); } while (0)
#define PG8_MMA(ai, bj, At, Bt) do { __builtin_amdgcn_s_setprio(1); _Pragma("unroll") for (int m = 0; m < 4; ++m) _Pragma("unroll") for (int n = 0; n < 2; ++n) _Pragma("unroll") for (int k = 0; k < 2; ++k) \
        acc[ai][bj][m][n] = __builtin_amdgcn_mfma_f32_16x16x32_bf16(Bt[n][k], At[m][k], acc[ai][bj][m][n], 0, 0, 0); __builtin_amdgcn_s_setprio(0); } while (0)
#define PG8_WAIT_V(n) asm volatile("s_waitcnt vmcnt(" #n ")" ::: "memory")
#define PG8_WAIT_L(n) asm volatile("s_waitcnt lgkmcnt(" #n ")" ::: "memory")
#define PG8_BAR __builtin_amdgcn_s_barrier()
#define PG8_SCHED __builtin_amdgcn_sched_barrier(0)
    Unit cur, nxt; int ui = 0;
    if (!S.next(0, cur)) return; cur.ord = 0;
    f32x4 acc[2][2][4][2];
#pragma unroll
    for (int a = 0; a < 2; ++a)
#pragma unroll
        for (int b = 0; b < 2; ++b)
#pragma unroll
            for (int m = 0; m < 4; ++m)
#pragma unroll
                for (int n = 0; n < 2; ++n) acc[a][b][m][n] = (f32x4){0.f, 0.f, 0.f, 0.f};
    bf16x8 At[4][2], B0[2][2], B1[2][2];
    const char* cA = (const char*)g.A + (size_t)cur.pm * tstep; const char* cB = (const char*)g.Bt + (size_t)cur.pn * tstep;
    S.a_ready(cur);
    if constexpr (SP2) {
        PG8_STAGE(PG8_SB(0, 0), cB, voffB); PG8_STAGE(PG8_SB(0, 1), cB + hstep, voffB); PG8_STAGE(PG8_SA(0, 0), cA, voffA); PG8_STAGE(PG8_SA(0, 1), cA + hstep, voffA);
        if (wr == 1) PG8_BAR;
        PG8_WAIT_V(2); PG8_BAR;
        PG8_STAGE(PG8_SB(1, 0), cB + kstep, voffB); PG8_STAGE(PG8_SA(1, 0), cA + kstep, voffA); PG8_STAGE(PG8_SB(1, 1), cB + hstep + kstep, voffB);
        PG8_WAIT_V(6); PG8_BAR;
    } else {
        PG8_STAGE(PG8_SB(0, 0), cB, voffB); PG8_STAGE(PG8_SA(0, 0), cA, voffA); PG8_STAGE(PG8_SB(0, 1), cB + hstep, voffB); PG8_STAGE(PG8_SA(0, 1), cA + hstep, voffA);
        if (wr == 1) PG8_BAR;
        PG8_WAIT_V(4); PG8_BAR;
        PG8_STAGE(PG8_SB(1, 0), cB + kstep, voffB); PG8_STAGE(PG8_SA(1, 0), cA + kstep, voffA); PG8_STAGE(PG8_SB(1, 1), cB + hstep + kstep, voffB);
        PG8_WAIT_V(6); PG8_BAR;
    }
    for (;;) {
        const bool has_next = S.next(ui + 1, nxt); nxt.ord = ui + 1;
        const char* nA = has_next ? (const char*)g.A + (size_t)nxt.pm * tstep : cA; const char* nB = has_next ? (const char*)g.Bt + (size_t)nxt.pn * tstep : cB;
        for (int t = 0; t < nt; t += 2) {
            const bool last = (t == nt - 2);
            const char* a1 = cA + (size_t)(t + 1) * kstep;
            const char* a2 = last ? nA : cA + (size_t)(t + 2) * kstep; const char* b2 = last ? nB : cB + (size_t)(t + 2) * kstep;
            const char* a3 = a2 + kstep; const char* b3 = b2 + kstep;
            if (last && has_next) S.a_ready(nxt);
            if constexpr (SP2) {
            PG8_LDB(B0, 0, 0); PG8_LDB(B1, 0, 1); PG8_SCHED; PG8_LDA(At, 0, 0); PG8_STAGE(PG8_SA(1, 1), a1 + hstep, voffA);
            PG8_WAIT_V(8); PG8_WAIT_L(0); PG8_BAR; PG8_MMA(0, 0, At, B0); PG8_MMA(0, 1, At, B1); PG8_BAR; PG8_SCHED;
            PG8_LDA(At, 0, 1); PG8_STAGE(PG8_SB(0, 0), b2, voffB); PG8_STAGE(PG8_SB(0, 1), b2 + hstep, voffB); PG8_STAGE(PG8_SA(0, 0), a2, voffA);
            PG8_WAIT_V(8); PG8_WAIT_L(0); PG8_BAR; PG8_MMA(1, 0, At, B0); PG8_MMA(1, 1, At, B1); PG8_BAR; PG8_SCHED;
            PG8_LDB(B0, 1, 0); PG8_LDB(B1, 1, 1); PG8_SCHED; PG8_LDA(At, 1, 0); PG8_STAGE(PG8_SA(0, 1), a2 + hstep, voffA);
            PG8_WAIT_V(8); PG8_WAIT_L(0); PG8_BAR; PG8_MMA(0, 0, At, B0); PG8_MMA(0, 1, At, B1); PG8_BAR; PG8_SCHED;
            PG8_LDA(At, 1, 1); PG8_STAGE(PG8_SB(1, 0), b3, voffB); PG8_STAGE(PG8_SB(1, 1), b3 + hstep, voffB); PG8_STAGE(PG8_SA(1, 0), a3, voffA);
            PG8_WAIT_V(8); PG8_WAIT_L(0); PG8_BAR; PG8_MMA(1, 0, At, B0); PG8_MMA(1, 1, At, B1); PG8_BAR; PG8_SCHED;
            } else {
            PG8_LDB(B0, 0, 0); PG8_SCHED; PG8_LDA(At, 0, 0); PG8_STAGE(PG8_SA(1, 1), a1 + hstep, voffA);
            PG8_WAIT_L(8); PG8_BAR; PG8_WAIT_L(0); PG8_MMA(0, 0, At, B0); PG8_BAR; PG8_SCHED;
            PG8_LDB(B1, 0, 1); PG8_STAGE(PG8_SB(0, 0), b2, voffB);
            PG8_BAR; PG8_WAIT_L(0); PG8_MMA(0, 1, At, B1); PG8_BAR;
            PG8_LDA(At, 0, 1); PG8_STAGE(PG8_SA(0, 0), a2, voffA);
            PG8_BAR; PG8_WAIT_L(0); PG8_MMA(1, 0, At, B0); PG8_BAR; PG8_SCHED;
            PG8_STAGE(PG8_SB(0, 1), b2 + hstep, voffB);
            PG8_WAIT_V(6); PG8_BAR; PG8_MMA(1, 1, At, B1); PG8_BAR;
            PG8_LDB(B0, 1, 0); PG8_SCHED; PG8_LDA(At, 1, 0); PG8_STAGE(PG8_SA(0, 1), a2 + hstep, voffA);
            PG8_WAIT_L(8); PG8_BAR; PG8_WAIT_L(0); PG8_MMA(0, 0, At, B0); PG8_BAR; PG8_SCHED;
            PG8_LDB(B1, 1, 1); PG8_STAGE(PG8_SB(1, 0), b3, voffB);
            PG8_BAR; PG8_WAIT_L(0); PG8_MMA(0, 1, At, B1); PG8_BAR;
            PG8_LDA(At, 1, 1); PG8_STAGE(PG8_SA(1, 0), a3, voffA);
            PG8_BAR; PG8_WAIT_L(0); PG8_MMA(1, 0, At, B0); PG8_BAR; PG8_SCHED;
            PG8_STAGE(PG8_SB(1, 1), b3 + hstep, voffB);
            PG8_WAIT_V(6); PG8_BAR; PG8_MMA(1, 1, At, B1); PG8_BAR;
            }
        }
        if constexpr (ALIGN_EPI) { if (wr == 0) PG8_BAR; }
        if constexpr (!Epi::AFTER_DRAIN) { E(acc, cur, wr, wc, fr, fq); S.done(cur); }
        if (!has_next) break;
#pragma unroll
        for (int a = 0; a < 2; ++a)
#pragma unroll
            for (int b = 0; b < 2; ++b)
#pragma unroll
                for (int m = 0; m < 4; ++m)
#pragma unroll
                    for (int n = 0; n < 2; ++n) acc[a][b][m][n] = (f32x4){0.f, 0.f, 0.f, 0.f};
        cur = nxt; cA = nA; cB = nB; ++ui;
        if constexpr (ALIGN_EPI) { if (wr == 1) PG8_BAR; }
    }
    PG8_WAIT_V(0);
    if constexpr (!ALIGN_EPI) { if (wr == 0) PG8_BAR; }
    PG8_BAR;
    if constexpr (Epi::AFTER_DRAIN) { E.fused(acc, cur, wr, wc, fr, fq, lds, wid, lane); S.done(cur); }
#undef PG8_SA
#undef PG8_SB
#undef PG8_STAGE
#undef PG8_LDA
#undef PG8_LDB
#undef PG8_MMA
#undef PG8_WAIT_V
#undef PG8_WAIT_L
#undef PG8_BAR
#undef PG8_SCHED
}
}

#define DI __device__ __forceinline__
#define LAS __attribute__((address_space(3)))
typedef unsigned short bf16;
typedef pg8::f32x4 f32x4;
typedef pg8::bf16x8 bf16x8;
typedef pg8::u32x4 u32x4;
typedef unsigned u32x2 __attribute__((ext_vector_type(2)));
typedef float f32x16 __attribute__((ext_vector_type(16)));
typedef float f32x2_t __attribute__((ext_vector_type(2)));
typedef __bf16 bf16x2_t __attribute__((ext_vector_type(2)));

constexpr int DM = 1024, NB = 2, SEQ = 8192, CTX = 256;
constexpr int ML = NB * SEQ, MC = NB * CTX, MT = ML + MC;
constexpr int DFF = 2816, RCW = 2560, NQKV = 1536, DLRU = 512;
constexpr int NCH = 264;
constexpr int NWAVES = 8;
constexpr float LOG2E = 1.4426950408889634f;
constexpr float QSCALE = 0.125f * LOG2E;

constexpr size_t MiB = 1u << 20;
constexpr size_t WS_WRCIN = 0, WS_WRCOUT = 5 * MiB, WS_WFIN0 = 7 * MiB, WS_WFIN1 = 18 * MiB, WS_WFOUT0 = 29 * MiB, WS_WFOUT1 = 29 * MiB + 5632 * 1024,
                 WS_WQKV = 40 * MiB, WS_WAOUT = 43 * MiB;
constexpr size_t WS_SMALL = 45 * MiB;
constexpr size_t WS_GW = WS_SMALL, WS_MOD = WS_SMALL + 256 * 1024, WS_ROPEC = WS_SMALL + 512 * 1024, WS_ROPES = WS_ROPEC + 8192, WS_SP8 = WS_ROPES + 8192,
                 WS_SUMA = WS_SMALL + 1 * MiB, WS_SUMB = WS_SMALL + 3 * MiB + 256 * 1024, WS_HIN = WS_SMALL + 5 * MiB + 512 * 1024;
constexpr size_t WS_HB = 53 * MiB;
constexpr size_t WS_X = 86 * MiB;
constexpr size_t WS_R1 = 152 * MiB;
constexpr size_t WS_Q = WS_R1, WS_KV = WS_R1 + 33 * MiB, WS_O = WS_KV + 17 * MiB;
constexpr size_t WS_SSP = 244 * MiB;
constexpr size_t WS_BV = 246 * MiB, WS_GM = 247 * MiB;
constexpr size_t WS_BTAIL = 235 * MiB;
constexpr size_t WS_CTL = 243 * MiB, CTL_BYTES = 65536;
constexpr size_t WS_END = 248 * MiB;
static_assert(WS_O + (size_t)ML * DM * 2 <= WS_CTL && WS_R1 + (size_t)MT * DFF * 2 <= WS_CTL, "ws map");
static_assert(WS_SUMB - WS_SUMA >= (size_t)NB * NCH * 2 * DLRU * 4 && WS_HIN + (size_t)NB * NCH * 2 * DLRU * 4 <= WS_HB, "ws small map");

constexpr int LDS_BYTES = 147456;

struct Args { const float* in[24]; float* out; unsigned char* ws; int ph_lo, ph_hi; };

DI unsigned pk2(float lo, float hi) { f32x2_t v = {lo, hi}; bf16x2_t b = __builtin_convertvector(v, bf16x2_t); return __builtin_bit_cast(unsigned, b); }
DI float bflo(unsigned u) { return __uint_as_float(u << 16); }
DI float bfhi(unsigned u) { return __uint_as_float(u & 0xffff0000u); }
DI f32x4 unpack4(u32x2 u) { return (f32x4){bflo(u.x), bfhi(u.x), bflo(u.y), bfhi(u.y)}; }
DI u32x2 pack4(f32x4 v) { u32x2 r; r.x = pk2(v[0], v[1]); r.y = pk2(v[2], v[3]); return r; }
DI float wave_sum(float v) {
#pragma unroll
    for (int o = 1; o < 64; o <<= 1) v += __shfl_xor(v, o);
    return v;
}
DI float fast_exp(float x) { return __builtin_amdgcn_exp2f(x * LOG2E); }
DI float sigmoidf_(float x) { return __builtin_amdgcn_rcpf(1.f + fast_exp(-x)); }
DI float siluf_(float x) { return x * sigmoidf_(x); }
DI float gelu_tanh(float x) { const float u = 0.7978845608028654f * (x + 0.044715f * x * x * x); return x * __builtin_amdgcn_rcpf(1.f + fast_exp(-2.f * u)); }
DI int bsel(int row) { return row < SEQ ? 0 : (row < ML ? 1 : 2); }

struct EpiStore {
    static constexpr bool PERM = true, AFTER_DRAIN = false;
    bf16* O; int ldc;
    DI void operator()(const f32x4 (&acc)[2][2][4][2], const pg8::Unit& u, int wr, int wc, int fr, int fq) const {
        const int row0 = u.pm * 256 + wr * 64 + fr, col0 = u.pn * 256 + wc * 32 + 8 * fq;
#pragma unroll
        for (int ai = 0; ai < 2; ++ai)
#pragma unroll
            for (int m = 0; m < 4; ++m) { bf16* rowp = O + (size_t)(row0 + ai * 128 + m * 16) * ldc + col0;
#pragma unroll
                for (int bj = 0; bj < 2; ++bj) { const f32x4 v0 = acc[ai][bj][m][0], v1 = acc[ai][bj][m][1];
                    u32x4 w; w.x = pk2(v0[0], v0[1]); w.y = pk2(v0[2], v0[3]); w.z = pk2(v1[0], v1[1]); w.w = pk2(v1[2], v1[3]);
                    *(u32x4*)(rowp + bj * 128) = w; } }
    }
};
constexpr int RS_TAB_OFF = 132096, RS_TAB_UNITS = 12;
template <class Sched> DI void rstd_table(LAS unsigned char* lds, const float* ssp, const Sched& S, int tid) {
    LAS float* tab = (LAS float*)(lds + RS_TAB_OFF);
    pg8::Unit u;
    for (int i = 0; i < RS_TAB_UNITS && S.next(i, u); ++i) {
        const int rr = tid >> 1, hf = tid & 1; const f32x4* q = (const f32x4*)(ssp + (size_t)(u.pm * 256 + rr) * 16 + hf * 8); const f32x4 a = q[0], b = q[1];
        float s = ((a[0] + a[1]) + (a[2] + a[3])) + ((b[0] + b[1]) + (b[2] + b[3]));
        s += __shfl_xor(s, 1);
        if (hf == 0) tab[i * 256 + rr] = 1.0f / sqrtf(s * (1.f / DM) + 1e-6f);
    }
    __syncthreads();
}
DI float row_rstd(LAS unsigned char* lds, int ord, int rin) { return ((const LAS float*)(lds + RS_TAB_OFF))[ord * 256 + rin]; }
struct EpiSwiGLU {
    static constexpr bool PERM = true, AFTER_DRAIN = false;
    bf16* O; int ldc; LAS unsigned char* lds; const float* bias;
    DI void operator()(const f32x4 (&acc)[2][2][4][2], const pg8::Unit& u, int wr, int wc, int fr, int fq) const {
        const int row0 = u.pm * 256 + wr * 64 + fr, col0 = u.pn * 128 + wc * 32 + 8 * fq;
        const int bs = u.pm < 32 ? 0 : (u.pm < 64 ? 1 : 2);
        const float* bp = bias + bs * (2 * DFF) + u.pn * 256 + wc * 32 + 8 * fq;
        f32x4 bv[2][2];
#pragma unroll
        for (int bj = 0; bj < 2; ++bj)
#pragma unroll
            for (int n = 0; n < 2; ++n) bv[bj][n] = *(const f32x4*)(bp + bj * 128 + 4 * n);
#pragma unroll
        for (int ai = 0; ai < 2; ++ai)
#pragma unroll
            for (int m = 0; m < 4; ++m) { const int r = row0 + ai * 128 + m * 16; bf16* rowp = O + (size_t)r * ldc + col0;
                const float rs = row_rstd(lds, u.ord, wr * 64 + fr + ai * 128 + m * 16);
                float v[8];
#pragma unroll
                for (int n = 0; n < 2; ++n)
#pragma unroll
                    for (int j = 0; j < 4; ++j) v[n * 4 + j] = siluf_(__builtin_fmaf(acc[ai][0][m][n][j], rs, bv[0][n][j])) * __builtin_fmaf(acc[ai][1][m][n][j], rs, bv[1][n][j]);
                u32x4 w; w.x = pk2(v[0], v[1]); w.y = pk2(v[2], v[3]); w.z = pk2(v[4], v[5]); w.w = pk2(v[6], v[7]);
                *(u32x4*)rowp = w; }
    }
};
struct EpiResid {
    static constexpr bool PERM = false, AFTER_DRAIN = false;
    const float* baseL; const float* baseC;
    float* X; const float* gate;
    bf16* HBn; const float* gm; float* ssp;
    DI void operator()(const f32x4 (&acc)[2][2][4][2], const pg8::Unit& u, int wr, int wc, int fr, int fq) const {
        const int bs = u.pm < 32 ? 0 : (u.pm < 64 ? 1 : 2);
        const int col0 = u.pn * 256 + wc * 32 + 4 * fq;
        const float* gp = gate + bs * 6144 + col0;
        f32x4 gv[2][2], gmv[2][2];
#pragma unroll
        for (int bj = 0; bj < 2; ++bj)
#pragma unroll
            for (int n = 0; n < 2; ++n) { gv[bj][n] = *(const f32x4*)(gp + bj * 128 + n * 16); if (HBn) gmv[bj][n] = *(const f32x4*)(gm + bs * 1024 + col0 + bj * 128 + n * 16); }
#pragma unroll
        for (int ai = 0; ai < 2; ++ai)
#pragma unroll
            for (int m = 0; m < 4; ++m) { const int r = u.pm * 256 + ai * 128 + wr * 64 + m * 16 + fr;
                const float* bp = (r < ML ? baseL + (size_t)r * DM : baseC + (size_t)(r - ML) * DM) + col0;
                float* op = X + (size_t)r * DM + col0;
                float ss = 0.f;
#pragma unroll
                for (int bj = 0; bj < 2; ++bj)
#pragma unroll
                    for (int n = 0; n < 2; ++n) { const f32x4 b4 = *(const f32x4*)(bp + bj * 128 + n * 16);
                        const f32x4 xn = b4 + gv[bj][n] * acc[ai][bj][m][n];
                        *(f32x4*)(op + bj * 128 + n * 16) = xn;
                        if (HBn) { ss += (xn[0] * xn[0] + xn[1] * xn[1]) + (xn[2] * xn[2] + xn[3] * xn[3]);
                            *(u32x2*)(HBn + (size_t)r * DM + col0 + bj * 128 + n * 16) = pack4(xn * gmv[bj][n]); } }
                if (HBn) { ss += __shfl_xor(ss, 16); ss += __shfl_xor(ss, 32); if (fq == 0) ssp[(size_t)r * 16 + u.pn * 4 + wc] = ss; } }
    }
};
struct EpiQKV {
    static constexpr bool PERM = false, AFTER_DRAIN = false;
    bf16 *Q, *KV; const float *ropec, *ropes; LAS unsigned char* lds; const float* bias;
    DI void operator()(const f32x4 (&acc)[2][2][4][2], const pg8::Unit& u, int wr, int wc, int fr, int fq) const {
        const bool rope_on = (u.pm < 64) && (u.pn < 5);
        const float scale = u.pn < 4 ? QSCALE : 1.0f;
        bf16* dst = u.pn < 4 ? Q + u.pn * 256 : KV + (u.pn - 4) * 256; const int ld = u.pn < 4 ? DM : 512;
        const int ax = wc & 1, cc = wc * 32 + 4 * fq;
        const int bs = u.pm < 32 ? 0 : (u.pm < 64 ? 1 : 2);
        const float* bp = bias + bs * NQKV + u.pn * 256 + cc;
        f32x4 bv[2][2];
#pragma unroll
        for (int bj = 0; bj < 2; ++bj)
#pragma unroll
            for (int n = 0; n < 2; ++n) bv[bj][n] = *(const f32x4*)(bp + bj * 128 + n * 16);
#pragma unroll
        for (int ai = 0; ai < 2; ++ai)
#pragma unroll
            for (int m = 0; m < 4; ++m) { const int r = u.pm * 256 + ai * 128 + wr * 64 + m * 16 + fr;
                const float rs = row_rstd(lds, u.ord, ai * 128 + wr * 64 + m * 16 + fr);
                const int s = r & (SEQ - 1); const int pos = ax ? (s & 63) : (s >> 6);
                f32x4 c4 = (f32x4){1.f, 1.f, 1.f, 1.f}, s4 = (f32x4){0.f, 0.f, 0.f, 0.f};
                if (rope_on) { c4 = *(const f32x4*)(ropec + pos * 16 + 4 * fq); s4 = *(const f32x4*)(ropes + pos * 16 + 4 * fq); }
                bf16* p = dst + (size_t)r * ld + cc;
#pragma unroll
                for (int bj = 0; bj < 2; ++bj) { const f32x4 x1 = acc[ai][bj][m][0] * rs + bv[bj][0], x2 = acc[ai][bj][m][1] * rs + bv[bj][1];
                    const f32x4 o1 = (x1 * c4 - x2 * s4) * scale, o2 = (x2 * c4 + x1 * s4) * scale;
                    *(u32x2*)(p + bj * 128) = pack4(o1); *(u32x2*)(p + bj * 128 + 16) = pack4(o2); } }
    }
};

DI void transpose_item(const float* W, int ldN, bf16* WT, int K, int k0, int src_n0, int dst_n0, LAS float* scr, int lane) {
#pragma unroll 8
    for (int i = 0; i < 32; ++i) { const int kk = 2 * i + (lane >> 5); scr[kk * 33 + (lane & 31)] = W[(size_t)(k0 + kk) * ldN + src_n0 + (lane & 31)]; }
    asm volatile("s_waitcnt lgkmcnt(0)" ::: "memory");
    const int c = lane & 7;
#pragma unroll
    for (int j = 0; j < 4; ++j) { const int n = (lane >> 3) + 8 * j; const LAS float* s = scr + (8 * c) * 33 + n;
        u32x4 o; o.x = pk2(s[0 * 33], s[1 * 33]); o.y = pk2(s[2 * 33], s[3 * 33]); o.z = pk2(s[4 * 33], s[5 * 33]); o.w = pk2(s[6 * 33], s[7 * 33]);
        *(u32x4*)(WT + (size_t)(dst_n0 + n) * K + k0 + 8 * c) = o; }
    asm volatile("s_waitcnt lgkmcnt(0)" ::: "memory");
}
DI void mat_item(int r, const float* W, int K, int N, bf16* WT, bool remap, LAS float* scr, int lane) {
    const int nblk = N / 32, kb = r / nblk, nb = r % nblk; const int dst_n0 = 32 * nb; int src_n0 = dst_n0;
    if (remap) { const int pn = dst_n0 >> 8, w = dst_n0 & 255; src_n0 = (w < 128) ? 128 * pn + w : DFF + 128 * pn + (w - 128); }
    transpose_item(W, N, WT, K, 64 * kb, src_n0, dst_n0, scr, lane);
}
DI void prologue(const Args& a, LAS unsigned char* lds, int tid, int lane, int wave) {
    unsigned char* ws = a.ws;
    {
        LAS float* scr = (LAS float*)(lds + wave * 16384);
        const int gw = blockIdx.x * NWAVES + wave, NGW = gridDim.x * NWAVES;
        constexpr int I0 = 16 * 80, I1 = 16 * 32, I2 = 16 * 176, I4 = 44 * 32, I6 = 16 * 48, I7 = 16 * 32;
        constexpr int NITEMS = I0 + I1 + 2 * I2 + 2 * I4 + I6 + I7;
        for (int it = gw; it < NITEMS; it += NGW) {
            int r = it;
            if (r < I0) { mat_item(r, a.in[11], 1024, RCW, (bf16*)(ws + WS_WRCIN), false, scr, lane); continue; } r -= I0;
            if (r < I1) { mat_item(r, a.in[20], 1024, 1024, (bf16*)(ws + WS_WRCOUT), false, scr, lane); continue; } r -= I1;
            if (r < I2) { mat_item(r, a.in[9], 1024, 2 * DFF, (bf16*)(ws + WS_WFIN0), true, scr, lane); continue; } r -= I2;
            if (r < I2) { mat_item(r, a.in[9] + (size_t)1024 * 2 * DFF, 1024, 2 * DFF, (bf16*)(ws + WS_WFIN1), true, scr, lane); continue; } r -= I2;
            if (r < I4) { mat_item(r, a.in[10], DFF, 1024, (bf16*)(ws + WS_WFOUT0), false, scr, lane); continue; } r -= I4;
            if (r < I4) { mat_item(r, a.in[10] + (size_t)DFF * 1024, DFF, 1024, (bf16*)(ws + WS_WFOUT1), false, scr, lane); continue; } r -= I4;
            if (r < I6) { mat_item(r, a.in[21], 1024, NQKV, (bf16*)(ws + WS_WQKV), false, scr, lane); continue; } r -= I6;
            mat_item(r, a.in[23], 1024, 1024, (bf16*)(ws + WS_WAOUT), false, scr, lane);
        }
    }
    {
        const int gt = blockIdx.x * 512 + tid, NT = gridDim.x * 512;
        bf16* GW = (bf16*)(ws + WS_GW);
        for (int idx = gt; idx < 131072; idx += NT) {
            const int j = idx & 7, ln = (idx >> 3) & 63, ks = (idx >> 9) & 3, mt = (idx >> 11) & 1, head = (idx >> 12) & 7, dg = idx >> 15;
            const int hi = ln >> 5, m = ln & 31;
            const int cin = 32 * (ks >> 1) + 16 * (ks & 1) + 8 * (j >> 2) + 4 * hi + (j & 3), cout = 32 * mt + m;
            const int d = dg >> 1; const float* src = (dg & 1) ? a.in[16] : a.in[14];
            const float v = src[((size_t)(d * 8 + head) * 64 + cin) * 64 + cout];
            GW[idx] = (bf16)(pk2(v, 0.f) & 0xffffu);
        }
        float* sp8 = (float*)(ws + WS_SP8);
        for (int idx = gt; idx < 2 * DLRU; idx += NT) sp8[idx] = -8.0f * log1pf(expf(-a.in[18][idx]));
        float* rc = (float*)(ws + WS_ROPEC); float* rs = (float*)(ws + WS_ROPES);
        for (int idx = gt; idx < 2048; idx += NT) {
            const int pos = idx >> 4, f = idx & 15;
            const float inv = (float)exp2(-(double)f * (13.287712379549449 / 16.0));
            const float ang = (float)pos * inv;
            double x = (double)ang; const double n = rint(x * 0.15915494309189535); x -= n * 6.283185307179586476925;
            const double x2 = x * x; double cs = 1.0, sn = 1.0;
            { double t = 1.0, s = 1.0;
              for (int i = 1; i <= 14; ++i) { t *= -x2 / (double)((2 * i - 1) * (2 * i)); s += t; } cs = s; }
            { double t = 1.0, s = 1.0;
              for (int i = 1; i <= 14; ++i) { t *= -x2 / (double)((2 * i) * (2 * i + 1)); s += t; } sn = s * x; }
            rc[idx] = (float)cs; rs[idx] = (float)sn;
        }
    }
    {
        LAS float* red = (LAS float*)lds;
        float* MOD = (float*)(ws + WS_MOD);
        for (int it = blockIdx.x; it < 192; it += gridDim.x) {
            __syncthreads();
            const int l = it / 96, n0 = (it % 96) * 64, cl = lane & 15, ksub = lane >> 4;
            f32x4 a0 = {0.f, 0.f, 0.f, 0.f}, a1 = a0, a2 = a0;
            const float* wbase = a.in[4] + (size_t)l * 1024 * 6144 + n0 + 4 * cl;
#pragma unroll 8
            for (int i = 0; i < 32; ++i) { const int k = 128 * wave + 4 * i + ksub;
                const f32x4 w = *(const f32x4*)(wbase + (size_t)k * 6144);
                const float s0 = siluf_(a.in[1][k]), s1 = siluf_(a.in[1][1024 + k]), s2 = siluf_(a.in[3][k]);
                a0 += w * s0; a1 += w * s1; a2 += w * s2; }
#pragma unroll
            for (int j = 0; j < 4; ++j) { a0[j] += __shfl_xor(a0[j], 16); a0[j] += __shfl_xor(a0[j], 32); a1[j] += __shfl_xor(a1[j], 16); a1[j] += __shfl_xor(a1[j], 32); a2[j] += __shfl_xor(a2[j], 16); a2[j] += __shfl_xor(a2[j], 32); }
            if (ksub == 0) {
#pragma unroll
                for (int j = 0; j < 4; ++j) { red[(wave * 3 + 0) * 64 + 4 * cl + j] = a0[j]; red[(wave * 3 + 1) * 64 + 4 * cl + j] = a1[j]; red[(wave * 3 + 2) * 64 + 4 * cl + j] = a2[j]; } }
            __syncthreads();
            if (tid < 192) { const int bs = tid >> 6, col = tid & 63; float s = a.in[5][l * 6144 + n0 + col];
#pragma unroll
                for (int w = 0; w < 8; ++w) s += red[(w * 3 + bs) * 64 + col];
                MOD[(size_t)(l * 3 + bs) * 6144 + n0 + col] = s; }
        }
        __syncthreads();
    }
}

DI void norm_mod_phase(const float* srcL, const float* srcC, int nrows, const float* g, const float* mod, int shk, int sck, bf16* dst, int wave, int lane) {
    const int gw = blockIdx.x * NWAVES + wave, NGW = gridDim.x * NWAVES;
    for (int row = gw; row < nrows; row += NGW) {
        const float* src = row < ML ? srcL + (size_t)row * DM : srcC + (size_t)(row - ML) * DM;
        const float* mb = mod + bsel(row) * 6144;
        const f32x4* x4 = (const f32x4*)src + lane;
        f32x4 v[4]; float ss = 0.f;
#pragma unroll
        for (int j = 0; j < 4; ++j) { v[j] = x4[64 * j]; ss += (v[j][0] * v[j][0] + v[j][1] * v[j][1]) + (v[j][2] * v[j][2] + v[j][3] * v[j][3]); }
        const float rstd = 1.0f / sqrtf(wave_sum(ss) * (1.f / DM) + 1e-6f);
        u32x2* o = (u32x2*)(dst + (size_t)row * DM) + lane;
#pragma unroll
        for (int j = 0; j < 4; ++j) { const f32x4 gg = ((const f32x4*)g)[lane + 64 * j], sc = ((const f32x4*)(mb + sck * 1024))[lane + 64 * j], sh = ((const f32x4*)(mb + shk * 1024))[lane + 64 * j];
            const f32x4 y = (v[j] * rstd * gg) * (sc + 1.0f) + sh; o[64 * j] = pack4(y); }
    }
}
DI void final_norm_phase(const float* X, const float* g, float* out, int wave, int lane) {
    const int gw = blockIdx.x * NWAVES + wave, NGW = gridDim.x * NWAVES;
    for (int row = gw; row < ML; row += NGW) {
        const f32x4* x4 = (const f32x4*)(X + (size_t)row * DM) + lane;
        f32x4 v[4]; float ss = 0.f;
#pragma unroll
        for (int j = 0; j < 4; ++j) { v[j] = x4[64 * j]; ss += (v[j][0] * v[j][0] + v[j][1] * v[j][1]) + (v[j][2] * v[j][2] + v[j][3] * v[j][3]); }
        const float rstd = 1.0f / sqrtf(wave_sum(ss) * (1.f / DM) + 1e-6f);
        f32x4* o = (f32x4*)(out + (size_t)row * DM) + lane;
#pragma unroll
        for (int j = 0; j < 4; ++j) o[64 * j] = v[j] * rstd * ((const f32x4*)g)[lane + 64 * j];
    }
}

DI void aux_phase(const Args& a, int tid, int wave, int lane) {
    unsigned char* ws = a.ws;
    const float* MOD = (const float*)(ws + WS_MOD);
    float* GM = (float*)(ws + WS_GM); float* BV = (float*)(ws + WS_BV);
    const int gt = blockIdx.x * 512 + tid, NT = gridDim.x * 512;
    for (int idx = gt; idx < 9 * 1024; idx += NT) { const int c = idx & 1023, bs = (idx >> 10) % 3, which = idx / 3072;
        const float g = which == 0 ? a.in[7][c] : (which == 1 ? a.in[6][DM + c] : a.in[7][DM + c]);
        const float sc = MOD[(size_t)((which == 0 ? 0 : 1) * 3 + bs) * 6144 + (which == 1 ? 1 : 4) * 1024 + c];
        GM[idx] = g * (1.0f + sc); }
    const int gw = blockIdx.x * NWAVES + wave, NGW = gridDim.x * NWAVES;
    for (int it = gw; it < 2 * DFF + NQKV + 2 * DFF; it += NGW) {
        int which, n; if (it < 2 * DFF) { which = 0; n = it; } else if (it < 2 * DFF + NQKV) { which = 1; n = it - 2 * DFF; } else { which = 2; n = it - 2 * DFF - NQKV; }
        const bf16* Bt = (const bf16*)(ws + (which == 0 ? WS_WFIN0 : (which == 1 ? WS_WQKV : WS_WFIN1))) + (size_t)n * DM + 16 * lane;
        const int N = which == 1 ? NQKV : 2 * DFF;
        const float* shb = MOD + (size_t)((which == 0 ? 0 : 1) * 3) * 6144 + (which == 1 ? 0 : 3) * 1024 + 16 * lane;
        const u32x4 w0 = *(const u32x4*)Bt, w1 = *(const u32x4*)(Bt + 8);
        const f32x4 wv[4] = {unpack4((u32x2){w0.x, w0.y}), unpack4((u32x2){w0.z, w0.w}), unpack4((u32x2){w1.x, w1.y}), unpack4((u32x2){w1.z, w1.w})};
        float acc[3];
#pragma unroll
        for (int bs = 0; bs < 3; ++bs) { float s_ = 0.f;
#pragma unroll
            for (int q = 0; q < 4; ++q) { const f32x4 sh = *(const f32x4*)(shb + bs * 6144 + 4 * q); s_ += (wv[q][0] * sh[0] + wv[q][1] * sh[1]) + (wv[q][2] * sh[2] + wv[q][3] * sh[3]); }
            acc[bs] = wave_sum(s_); }
        if (lane == 0) { float* o = BV + (size_t)which * 3 * (2 * DFF) + n; o[0] = acc[0]; o[N] = acc[1]; o[2 * N] = acc[2]; }
    }
}

constexpr int RG_UNITS = NB * NCH * 8;
DI float* rg_bcum_ptr(const Args& a, int unit) { return unit < 4096 ? a.out + (size_t)unit * 4096 : (float*)(a.ws + WS_BTAIL) + (size_t)(unit - 4096) * 4096; }
template <int CTRL, int RMASK> DI float dppf(float oldv, float v) {
    return __builtin_bit_cast(float, __builtin_amdgcn_update_dpp(__builtin_bit_cast(int, oldv), __builtin_bit_cast(int, v), CTRL, RMASK, 0xf, false));
}
#define RG_SCAN_STEP(CTRL, RMASK) do { _Pragma("unroll") for (int r = 0; r < 16; ++r) { const float am = aR[r], bm = aI[r]; \
        const float ap = dppf<CTRL, RMASK>(1.0f, am), bp = dppf<CTRL, RMASK>(0.0f, bm); aR[r] = am * ap; aI[r] = __builtin_fmaf(am, bp, bm); } } while (0)
template <int D, int MT_> DI void rg1_quarter(const float (&xc)[2][16], const bf16x8 (&xb)[4], const LAS unsigned char* gwl, const LAS float* pv,
                                              float* acum, float* bcum, float* SUMA, float* SUMB, int lane, size_t sbase) {
    const int hi = lane >> 5;
    f32x16 aR, aI;
#pragma unroll
    for (int i = 0; i < 16; ++i) { aR[i] = 0.f; aI[i] = 0.f; }
#pragma unroll
    for (int ks = 0; ks < 4; ++ks) {
        const bf16x8 wr_ = *(const LAS bf16x8*)(gwl + ((((D * 2 + 0) * 2 + MT_) * 4 + ks) * 64 + lane) * 16);
        const bf16x8 wi_ = *(const LAS bf16x8*)(gwl + ((((D * 2 + 1) * 2 + MT_) * 4 + ks) * 64 + lane) * 16);
        aR = __builtin_amdgcn_mfma_f32_32x32x16_bf16(wr_, xb[ks], aR, 0, 0, 0);
        aI = __builtin_amdgcn_mfma_f32_32x32x16_bf16(wi_, xb[ks], aI, 0, 0, 0);
    }
#pragma unroll
    for (int rq = 0; rq < 4; ++rq) {
        const int c0 = 32 * MT_ + 8 * rq + 4 * hi;
        const f32x4 rb4 = *(const LAS f32x4*)(pv + 320 + D * 64 + c0), ib4 = *(const LAS f32x4*)(pv + 448 + D * 64 + c0), lm4 = *(const LAS f32x4*)(pv + 576 + D * 64 + c0);
#pragma unroll
        for (int j = 0; j < 4; ++j) { const int r = 4 * rq + j;
            const float rr = __builtin_amdgcn_rcpf(1.0f + __builtin_amdgcn_exp2f(__builtin_fmaf(aR[r], -LOG2E, rb4[j])));
            const float ii = __builtin_amdgcn_rcpf(1.0f + __builtin_amdgcn_exp2f(__builtin_fmaf(aI[r], -LOG2E, ib4[j])));
            const float av = __builtin_amdgcn_exp2f(rr * lm4[j]);
            const float mult = __builtin_amdgcn_sqrtf(fmaxf(__builtin_fmaf(-av, av, 1.0f), 1e-12f));
            aR[r] = av; aI[r] = mult * ii * xc[MT_][r]; }
    }
    if (D == 1) {
#pragma unroll
        for (int r = 0; r < 16; ++r) { aR[r] = __shfl_xor(aR[r], 31); aI[r] = __shfl_xor(aI[r], 31); }
    }
    RG_SCAN_STEP(0x111, 0xf);
    RG_SCAN_STEP(0x112, 0xf);
    RG_SCAN_STEP(0x114, 0xf);
    RG_SCAN_STEP(0x118, 0xf);
    RG_SCAN_STEP(0x142, 0xa);
#pragma unroll
    for (int rq = 0; rq < 4; ++rq) {
        *(f32x4*)(acum + ((D * 2 + MT_) * 4 + rq) * 256 + lane * 4) = (f32x4){aR[4 * rq], aR[4 * rq + 1], aR[4 * rq + 2], aR[4 * rq + 3]};
        *(f32x4*)(bcum + ((D * 2 + MT_) * 4 + rq) * 256 + lane * 4) = (f32x4){aI[4 * rq], aI[4 * rq + 1], aI[4 * rq + 2], aI[4 * rq + 3]};
    }
    if ((lane & 31) == 31) {
#pragma unroll
        for (int rq = 0; rq < 4; ++rq) { const int c0 = 32 * MT_ + 8 * rq + 4 * hi;
            *(f32x4*)(SUMA + sbase + D * DLRU + c0) = (f32x4){aR[4 * rq], aR[4 * rq + 1], aR[4 * rq + 2], aR[4 * rq + 3]};
            *(f32x4*)(SUMB + sbase + D * DLRU + c0) = (f32x4){aI[4 * rq], aI[4 * rq + 1], aI[4 * rq + 2], aI[4 * rq + 3]}; }
    }
}
template <int QMASK> DI void rg1_unit(const Args& a, const LAS unsigned char* gwl, const LAS float* pv, int cb, int head, int lane_in) {
    unsigned char* ws = a.ws;
    const bf16* U = (const bf16*)(ws + WS_R1);
    float* SUMA = (float*)(ws + WS_SUMA); float* SUMB = (float*)(ws + WS_SUMB);
    int lane_o = lane_in; asm volatile("" : "+v"(lane_o));
    const int lane = lane_o, tok = lane & 31, hi = lane >> 5;
    const int gc = cb >> 1, b = cb & 1, unit = cb * 8 + head;
    const bool lat = gc < 256;
    const int ts0 = lat ? gc * 32 : (gc - 256) * 32, len = lat ? SEQ : CTX, rowbase = lat ? b * SEQ : ML + b * CTX;
    const int ts = ts0 + tok;
    u32x2 tap[8][4];
#pragma unroll
    for (int k = 0; k < 4; ++k) { const int tt = ts - 2 + k; const bool ok = (tt >= 0) && (tt < len); const int ttc = ok ? tt : ts;
        const bf16* up = U + (size_t)(rowbase + ttc) * RCW + head * 64 + 4 * hi;
#pragma unroll
        for (int q = 0; q < 8; ++q) { u32x2 v = *(const u32x2*)(up + 8 * q); if (!ok) { v.x = 0u; v.y = 0u; } tap[q][k] = v; } }
    float xc[2][16];
#pragma unroll
    for (int q = 0; q < 8; ++q) {
        f32x4 acc = *(const LAS f32x4*)(pv + 256 + 8 * q + 4 * hi);
#pragma unroll
        for (int k = 0; k < 4; ++k) acc += *(const LAS f32x4*)(pv + k * 64 + 8 * q + 4 * hi) * unpack4(tap[q][k]);
#pragma unroll
        for (int j = 0; j < 4; ++j) xc[q >> 2][4 * (q & 3) + j] = acc[j];
    }
    bf16x8 xb[4];
#pragma unroll
    for (int ks = 0; ks < 4; ++ks) { const int mt = ks >> 1, r0 = 8 * (ks & 1);
        u32x4 p; p.x = pk2(xc[mt][r0], xc[mt][r0 + 1]); p.y = pk2(xc[mt][r0 + 2], xc[mt][r0 + 3]); p.z = pk2(xc[mt][r0 + 4], xc[mt][r0 + 5]); p.w = pk2(xc[mt][r0 + 6], xc[mt][r0 + 7]);
        xb[ks] = __builtin_bit_cast(bf16x8, p); }
    float* acum = (float*)(ws + WS_X) + (size_t)unit * 4096; float* bcum = rg_bcum_ptr(a, unit);
    const size_t sbase = ((size_t)(b * NCH + gc) * 2) * DLRU + head * 64;
    if (QMASK & 1) { rg1_quarter<0, 0>(xc, xb, gwl, pv, acum, bcum, SUMA, SUMB, lane, sbase); asm volatile("" ::: "memory"); }
    if (QMASK & 2) { rg1_quarter<0, 1>(xc, xb, gwl, pv, acum, bcum, SUMA, SUMB, lane, sbase); asm volatile("" ::: "memory"); }
    if (QMASK & 4) { rg1_quarter<1, 0>(xc, xb, gwl, pv, acum, bcum, SUMA, SUMB, lane, sbase); asm volatile("" ::: "memory"); }
    if (QMASK & 8) { rg1_quarter<1, 1>(xc, xb, gwl, pv, acum, bcum, SUMA, SUMB, lane, sbase); asm volatile("" ::: "memory"); }
}
DI void rg1_phase(const Args& a, LAS unsigned char* lds, int tid, int lane, int wave) {
    unsigned char* ws = a.ws;
    const int head = blockIdx.x & 7, nbh = ((int)gridDim.x - head + 7) >> 3;
    const int wslot = (blockIdx.x >> 3) * NWAVES + wave, NWS = nbh * NWAVES;
    LAS unsigned char* gwl = lds; LAS float* pv = (LAS float*)(lds + 32768);
    {
        const bf16* GW = (const bf16*)(ws + WS_GW);
#pragma unroll
        for (int i = 0; i < 4; ++i) { const int idx16 = tid + 512 * i, dg = idx16 >> 9;
            *(LAS u32x4*)(gwl + idx16 * 16) = *(const u32x4*)(GW + (size_t)(dg * 8 + head) * 4096 + (idx16 & 511) * 8); }
        for (int t = tid; t < 704; t += 512) { const int c = t & 63; float v;
            if (t < 256) v = a.in[12][(t >> 6) * DLRU + head * 64 + c];
            else if (t < 320) v = a.in[13][head * 64 + c];
            else if (t < 448) v = -LOG2E * a.in[15][((t - 320) >> 6) * DLRU + head * 64 + c];
            else if (t < 576) v = -LOG2E * a.in[17][((t - 448) >> 6) * DLRU + head * 64 + c];
            else v = LOG2E * ((const float*)(ws + WS_SP8))[((t - 576) >> 6) * DLRU + head * 64 + c];
            pv[t] = v; }
        __syncthreads();
    }
    for (int cb = wslot; cb < 512; cb += NWS) rg1_unit<15>(a, gwl, pv, cb, head, lane);
    for (int qi = wslot; qi < 64; qi += NWS) { const int cb = 512 + (qi >> 2), qq = qi & 3;
        if (qq == 0) rg1_unit<1>(a, gwl, pv, cb, head, lane); else if (qq == 1) rg1_unit<2>(a, gwl, pv, cb, head, lane);
        else if (qq == 2) rg1_unit<4>(a, gwl, pv, cb, head, lane); else rg1_unit<8>(a, gwl, pv, cb, head, lane); }
    __syncthreads();
}
DI void rg_carry_phase(const Args& a, LAS unsigned char* lds, int wave, int lane) {
    unsigned char* ws = a.ws;
    const float* SUMA = (const float*)(ws + WS_SUMA); const float* SUMB = (const float*)(ws + WS_SUMB); float* HIN = (float*)(ws + WS_HIN);
    LAS float* sh = (LAS float*)lds;
    for (int it = blockIdx.x; it < 32; it += gridDim.x) {
        const int head = it & 7, d = (it >> 3) & 1, b = it >> 4;
        const int c = lane, seg = wave; const float* sa = SUMA + c; const float* sb = SUMB + c; float* ho = HIN + c;
        float av[33], bv[33];
#pragma unroll
        for (int i = 0; i < 33; ++i) { const int st = seg * 33 + i; const int gc = d == 0 ? (st + 256) % NCH : (NCH - 1 - st);
            const unsigned idx = (unsigned)(((b * NCH + gc) * 2 + d) * DLRU + head * 64); av[i] = sa[idx]; bv[i] = sb[idx]; }
        float A = 1.f, B = 0.f;
#pragma unroll
        for (int i = 0; i < 33; ++i) { B = av[i] * B + bv[i]; A = av[i] * A; }
        __syncthreads();
        sh[(seg * 64 + c) * 2] = A; sh[(seg * 64 + c) * 2 + 1] = B;
        __syncthreads();
        float h = 0.f;
        for (int s = 0; s < seg; ++s) h = sh[(s * 64 + c) * 2] * h + sh[(s * 64 + c) * 2 + 1];
#pragma unroll
        for (int i = 0; i < 33; ++i) { const int st = seg * 33 + i; const int gc = d == 0 ? (st + 256) % NCH : (NCH - 1 - st);
            const unsigned idx = (unsigned)(((b * NCH + gc) * 2 + d) * DLRU + head * 64); ho[idx] = h; h = av[i] * h + bv[i]; }
    }
    __syncthreads();
}
DI void rg3_phase(const Args& a, int wave, int lane_in) {
    unsigned char* ws = a.ws;
    const bf16* U = (const bf16*)(ws + WS_R1);
    const float* HIN = (const float*)(ws + WS_HIN);
    bf16* Y = (bf16*)(ws + WS_HB);
    const int gw = blockIdx.x * NWAVES + wave, NGW = gridDim.x * NWAVES;
    for (int hu = gw; hu < 2 * RG_UNITS; hu += NGW) {
        int lane_o = lane_in; asm volatile("" : "+v"(lane_o));
        const int lane = lane_o, tok = lane & 31, hi = lane >> 5;
        const int mt = hu & 1, unit = hu >> 1, head = unit & 7, cb = unit >> 3, gc = cb >> 1, b = cb & 1;
        const bool lat = gc < 256;
        const int row = (lat ? b * SEQ + gc * 32 : ML + b * CTX + (gc - 256) * 32) + tok;
        const float* acum = (const float*)(ws + WS_X) + (size_t)unit * 4096 + mt * 1024 + lane * 4; const float* bcum = rg_bcum_ptr(a, unit) + mt * 1024 + lane * 4;
        const float* hin = HIN + ((size_t)(b * NCH + gc) * 2) * DLRU + head * 64 + 32 * mt + 4 * hi;
        f32x4 A4[2][4], B4[2][4], H4[2][4];
#pragma unroll
        for (int d = 0; d < 2; ++d)
#pragma unroll
            for (int rq = 0; rq < 4; ++rq) { A4[d][rq] = *(const f32x4*)(acum + d * 2048 + rq * 256); B4[d][rq] = *(const f32x4*)(bcum + d * 2048 + rq * 256);
                H4[d][rq] = *(const f32x4*)(hin + d * DLRU + 8 * rq); }
        u32x2 gau[4];
#pragma unroll
        for (int rq = 0; rq < 4; ++rq) gau[rq] = *(const u32x2*)(U + (size_t)row * RCW + DLRU + head * 64 + 32 * mt + 8 * rq + 4 * hi);
#pragma unroll
        for (int rq = 0; rq < 4; ++rq) { const f32x4 ga = unpack4(gau[rq]); f32x4 y;
#pragma unroll
            for (int j = 0; j < 4; ++j) { const float h0 = __builtin_fmaf(A4[0][rq][j], H4[0][rq][j], B4[0][rq][j]), h1 = __builtin_fmaf(A4[1][rq][j], H4[1][rq][j], B4[1][rq][j]);
                y[j] = (h0 + __shfl_xor(h1, 31)) * gelu_tanh(ga[j]); }
            *(u32x2*)(Y + (size_t)row * DM + head * 64 + 32 * mt + 8 * rq + 4 * hi) = pack4(y); }
    }
}
DI void sc_phase(const Args& a, int wave, int lane) {
    unsigned char* ws = a.ws;
    const bf16* U = (const bf16*)(ws + WS_R1);
    bf16* Y = (bf16*)(ws + WS_HB);
    const float* convB = a.in[19];
    const int gw = blockIdx.x * NWAVES + wave, NGW = gridDim.x * NWAVES;
    f32x4 w[3][2];
#pragma unroll
    for (int k = 0; k < 3; ++k) { w[k][0] = *(const f32x4*)(convB + k * DLRU + 8 * lane); w[k][1] = *(const f32x4*)(convB + k * DLRU + 8 * lane + 4); }
    for (int tile = gw; tile < MT / 8; tile += NGW) {
        const int row0 = tile * 8;
        const int seq0 = row0 < ML ? (row0 & ~(SEQ - 1)) : ML + ((row0 - ML) & ~(CTX - 1)), seqlen = row0 < ML ? SEQ : CTX;
        const bf16* up = U + (size_t)row0 * RCW + 8 * lane;
        u32x4 cgr[10], vr[10], bgr[8];
#pragma unroll
        for (int i = 0; i < 10; ++i) { const int r = row0 - 1 + i; const bool ok = (r >= seq0) && (r < seq0 + seqlen); const bf16* q = up + (ptrdiff_t)(ok ? i - 1 : 0) * RCW;
            cgr[i] = *(const u32x4*)(q + 3 * DLRU); vr[i] = *(const u32x4*)(q + 4 * DLRU); if (!ok) { cgr[i] = (u32x4){0u, 0u, 0u, 0u}; } }
#pragma unroll
        for (int i = 0; i < 8; ++i) bgr[i] = *(const u32x4*)(up + (size_t)i * RCW + 2 * DLRU);
        f32x4 p[10][2];
#pragma unroll
        for (int i = 0; i < 10; ++i) { p[i][0] = unpack4((u32x2){cgr[i].x, cgr[i].y}) * unpack4((u32x2){vr[i].x, vr[i].y}); p[i][1] = unpack4((u32x2){cgr[i].z, cgr[i].w}) * unpack4((u32x2){vr[i].z, vr[i].w}); }
#pragma unroll
        for (int i = 0; i < 8; ++i) {
            const f32x4 o0 = unpack4((u32x2){bgr[i].x, bgr[i].y}) * (w[0][0] * p[i][0] + w[1][0] * p[i + 1][0] + w[2][0] * p[i + 2][0]);
            const f32x4 o1 = unpack4((u32x2){bgr[i].z, bgr[i].w}) * (w[0][1] * p[i][1] + w[1][1] * p[i + 1][1] + w[2][1] * p[i + 2][1]);
            const u32x2 q0 = pack4(o0), q1 = pack4(o1);
            *(u32x4*)(Y + (size_t)(row0 + i) * DM + DLRU + 8 * lane) = (u32x4){q0.x, q0.y, q1.x, q1.y}; }
    }
}

DI void attn_phase(const Args& a, LAS unsigned char* lds, int tid, int lane, int wave) {
    unsigned char* ws = a.ws;
    const bf16* Q = (const bf16*)(ws + WS_Q); const bf16* KV = (const bf16*)(ws + WS_KV);
    bf16* O = (bf16*)(ws + WS_O);
    const float* sink = a.in[22];
    const int r32 = lane & 31, hi = lane >> 5, srow = tid >> 3, sch = tid & 7;
    constexpr int TB = 64 * 144;
    for (int u = blockIdx.x; u < NB * 128 * 4; u += gridDim.x) {
        const int hk = u & 3, q64 = (u >> 2) & 127, b = u >> 9;
        const int head = hk * 4 + (wave >> 1);
        const int qrow = q64 * 64 + (wave & 1) * 32 + r32;
        bf16x8 qr[4];
#pragma unroll
        for (int d0 = 0; d0 < 4; ++d0) qr[d0] = *(const bf16x8*)(Q + (size_t)(b * SEQ + qrow) * DM + head * 64 + 16 * d0 + 8 * hi);
        const int kt_lo = q64 - 2 < 0 ? 0 : q64 - 2, kt_hi = q64 + 2 > 127 ? 127 : q64 + 2, nwin = kt_hi - kt_lo + 1, nt = nwin + 4;
        float m = sink[head] * LOG2E, l = (hi == 0) ? 1.f : 0.f;
        f32x16 o[2];
#pragma unroll
        for (int i = 0; i < 16; ++i) { o[0][i] = 0.f; o[1][i] = 0.f; }
        u32x4 kreg, vreg;
#define ATT_LOAD(t) do { const int rowk_ = ((t) < nwin) ? (b * SEQ + (kt_lo + (t)) * 64 + srow) : (ML + b * CTX + ((t) - nwin) * 64 + srow); \
            const bf16* kp_ = KV + (size_t)rowk_ * 512 + hk * 64 + sch * 8; kreg = *(const u32x4*)kp_; vreg = *(const u32x4*)(kp_ + 256); } while (0)
#define ATT_STORE(buf) do { *(LAS u32x4*)(lds + (buf) * 2 * TB + srow * 144 + sch * 16) = kreg; \
            LAS bf16* vt_ = (LAS bf16*)(lds + (buf) * 2 * TB + TB + (sch * 8) * 144 + srow * 2); \
            vt_[0 * 72] = (bf16)(vreg.x & 0xffffu); vt_[1 * 72] = (bf16)(vreg.x >> 16); vt_[2 * 72] = (bf16)(vreg.y & 0xffffu); vt_[3 * 72] = (bf16)(vreg.y >> 16); \
            vt_[4 * 72] = (bf16)(vreg.z & 0xffffu); vt_[5 * 72] = (bf16)(vreg.z >> 16); vt_[6 * 72] = (bf16)(vreg.w & 0xffffu); vt_[7 * 72] = (bf16)(vreg.w >> 16); } while (0)
        ATT_LOAD(0); ATT_STORE(0);
        __syncthreads();
        for (int t = 0; t < nt; ++t) {
            const int buf = t & 1;
            if (t + 1 < nt) ATT_LOAD(t + 1);
            const LAS unsigned char* kb_ = lds + buf * 2 * TB; const LAS unsigned char* vb_ = kb_ + TB;
            f32x16 p[2];
#pragma unroll
            for (int i = 0; i < 16; ++i) { p[0][i] = 0.f; p[1][i] = 0.f; }
#pragma unroll
            for (int sub = 0; sub < 2; ++sub)
#pragma unroll
                for (int d0 = 0; d0 < 4; ++d0) { const bf16x8 kf = *(const LAS bf16x8*)(kb_ + (32 * sub + r32) * 144 + (16 * d0 + 8 * hi) * 2);
                    p[sub] = __builtin_amdgcn_mfma_f32_32x32x16_bf16(kf, qr[d0], p[sub], 0, 0, 0); }
            if (t < nwin) { const int kt = kt_lo + t;
                if (kt == q64 - 2 || kt == q64 + 2) {
#pragma unroll
                    for (int sub = 0; sub < 2; ++sub)
#pragma unroll
                        for (int r = 0; r < 16; ++r) { const int kpos = kt * 64 + 32 * sub + (r & 3) + 8 * (r >> 2) + 4 * hi; const int df = kpos - qrow;
                            if (df > 128 || df < -128) p[sub][r] = -1e30f; }
                } }
            float mx = p[0][0];
#pragma unroll
            for (int r = 1; r < 16; ++r) mx = fmaxf(mx, p[0][r]);
#pragma unroll
            for (int r = 0; r < 16; ++r) mx = fmaxf(mx, p[1][r]);
            mx = fmaxf(mx, __shfl_xor(mx, 32));
            const float mnew = fmaxf(m, mx), sc = __builtin_amdgcn_exp2f(m - mnew); m = mnew;
            float ls = 0.f;
#pragma unroll
            for (int sub = 0; sub < 2; ++sub)
#pragma unroll
                for (int r = 0; r < 16; ++r) { const float e = __builtin_amdgcn_exp2f(p[sub][r] - m); p[sub][r] = e; ls += e; }
            l = l * sc + ls;
#pragma unroll
            for (int i = 0; i < 16; ++i) { o[0][i] *= sc; o[1][i] *= sc; }
            bf16x8 pb[4];
#pragma unroll
            for (int ks = 0; ks < 4; ++ks) { const int sub = ks >> 1, r0 = 8 * (ks & 1);
                u32x4 w; w.x = pk2(p[sub][r0], p[sub][r0 + 1]); w.y = pk2(p[sub][r0 + 2], p[sub][r0 + 3]); w.z = pk2(p[sub][r0 + 4], p[sub][r0 + 5]); w.w = pk2(p[sub][r0 + 6], p[sub][r0 + 7]);
                pb[ks] = __builtin_bit_cast(bf16x8, w); }
#pragma unroll
            for (int dt = 0; dt < 2; ++dt)
#pragma unroll
                for (int ks = 0; ks < 4; ++ks) { const LAS unsigned char* vp = vb_ + (32 * dt + r32) * 144 + (16 * ks + 4 * hi) * 2;
                    const u32x2 lo = *(const LAS u32x2*)vp, hi2 = *(const LAS u32x2*)(vp + 16);
                    u32x4 w; w.x = lo.x; w.y = lo.y; w.z = hi2.x; w.w = hi2.y;
                    o[dt] = __builtin_amdgcn_mfma_f32_32x32x16_bf16(__builtin_bit_cast(bf16x8, w), pb[ks], o[dt], 0, 0, 0); }
            if (t + 1 < nt) ATT_STORE(buf ^ 1);
            __syncthreads();
        }
#undef ATT_LOAD
#undef ATT_STORE
        const float lt = l + __shfl_xor(l, 32), inv = 1.0f / lt;
        bf16* op = O + (size_t)(b * SEQ + qrow) * DM + head * 64;
#pragma unroll
        for (int dt = 0; dt < 2; ++dt)
#pragma unroll
            for (int rq = 0; rq < 4; ++rq) { f32x4 v = {o[dt][4 * rq] * inv, o[dt][4 * rq + 1] * inv, o[dt][4 * rq + 2] * inv, o[dt][4 * rq + 3] * inv};
                *(u32x2*)(op + 32 * dt + 8 * rq + 4 * hi) = pack4(v); }
    }
}

#define XB_TMO      128
#define XB_XCNT(j)  (256  + 64 * (j))
#define XB_XSUB(j)  (1280 + 64 * (j))
#define XB_XGEN(j)  (2304 + 64 * (j))
#define XB_TOP      3328
#define XB_TOPGEN   3392
#define XCD_BAR_WORDS 3456
#define XB_SPIN_CAP (1u << 18)

__device__ __forceinline__ unsigned xb_ld(unsigned* p)              { return __hip_atomic_load(p, __ATOMIC_RELAXED, __HIP_MEMORY_SCOPE_AGENT); }
__device__ __forceinline__ unsigned xb_add(unsigned* p, unsigned v) { return __hip_atomic_fetch_add(p, v, __ATOMIC_RELAXED, __HIP_MEMORY_SCOPE_AGENT); }
__device__ __forceinline__ unsigned xb_xcc_id() { return (unsigned)__builtin_amdgcn_s_getreg((3 << 11) | 20) & 0xFu; }
#define XB_SPIN(cond, bar) do { unsigned _sp = 0; while (cond) { __builtin_amdgcn_s_sleep(1); \
    if ((++_sp & 255u) == 0u) { if (xb_ld(&(bar)[XB_TMO])) break; if (_sp > XB_SPIN_CAP) { atomicAdd(&(bar)[XB_TMO], 1u); break; } } } } while (0)

struct XcdBarrier {
    unsigned* bar; unsigned x;
    volatile LAS unsigned* st;
};

__device__ __forceinline__ XcdBarrier xcd_barrier_post(unsigned* bar, volatile LAS unsigned* st) {
    XcdBarrier b; b.bar = bar; b.x = xb_xcc_id(); b.st = st;
    if (threadIdx.x == 0) (void)xb_add(&bar[XB_XCNT(b.x)], 1u);
    return b;
}
__device__ __forceinline__ void xcd_barrier_complete(unsigned* bar, unsigned x, unsigned& nloc, unsigned& nx) {
    const unsigned G = gridDim.x * gridDim.y * gridDim.z;
    unsigned sum, cnt, mine, sp = 0u;
    for (;;) {
        sum = 0u; cnt = 0u; mine = 0u;
#pragma unroll
        for (unsigned j = 0; j < 16; ++j) { const unsigned c = xb_ld(&bar[XB_XCNT(j)]); sum += c; cnt += (c > 0u) ? 1u : 0u; mine = (j == x) ? c : mine; }
        if (sum == G) break;
        __builtin_amdgcn_s_sleep(1);
        if ((++sp & 255u) == 0u) { if (xb_ld(&bar[XB_TMO])) break; if (sp > XB_SPIN_CAP) { atomicAdd(&bar[XB_TMO], 1u); break; } }
    }
    nloc = mine > 0u ? mine : 1u; nx = cnt > 0u ? cnt : 1u;
}

__device__ __forceinline__ void xcd_barrier(const XcdBarrier& b) {
    asm volatile("s_waitcnt vmcnt(0)" ::: "memory");
    __syncthreads();
    if (threadIdx.x == 0) {
        unsigned* bar = b.bar;
        __builtin_amdgcn_s_waitcnt(0);
        unsigned nloc = b.st[0], nx = b.st[1];
        if (nloc == 0u) { xcd_barrier_complete(bar, b.x, nloc, nx); b.st[0] = nloc; b.st[1] = nx; }
        const unsigned old = xb_add(&bar[XB_XSUB(b.x)], 1u);
        const unsigned gen = old / nloc;
        if (old + 1u == (gen + 1u) * nloc) {
            __builtin_amdgcn_fence(__ATOMIC_RELEASE, "agent");
            asm volatile("s_waitcnt vmcnt(0)" ::: "memory");
            const unsigned og = xb_add(&bar[XB_TOP], 1u);
            const unsigned tg = og / nx;
            if (og + 1u == (tg + 1u) * nx) xb_add(&bar[XB_TOPGEN], 1u);
            else XB_SPIN(xb_ld(&bar[XB_TOPGEN]) == tg, bar);
            __builtin_amdgcn_fence(__ATOMIC_ACQUIRE, "agent");
            xb_add(&bar[XB_XGEN(b.x)], 1u);
            asm volatile("s_waitcnt vmcnt(0)" ::: "memory");
        } else {
            XB_SPIN(xb_ld(&bar[XB_XGEN(b.x)]) == gen, bar);
            __builtin_amdgcn_fence(__ATOMIC_ACQUIRE, "agent");
            asm volatile("s_waitcnt vmcnt(0)" ::: "memory");
        }
    }
    __syncthreads();
}

constexpr int N_PHASES = 18;
__global__ void __launch_bounds__(NWAVES * 64, 2) fwd_kernel(Args a) {
    extern __shared__ __attribute__((aligned(16))) unsigned char lds_raw[];
    LAS unsigned char* lds = (LAS unsigned char*)lds_raw;
    cg::grid_group grid = cg::this_grid();
    const int tid = threadIdx.x, lane = tid & 63, wave = __builtin_amdgcn_readfirstlane(tid >> 6);
    unsigned char* ws = a.ws;
    const int lo = a.ph_lo, hi = a.ph_hi, G = gridDim.x, bx = blockIdx.x;
#ifndef PHASE_MASK
#define PHASE_MASK 0x3ffff
#endif
#define IN(k) (((PHASE_MASK >> (k)) & 1) && lo <= (k) && (k) < hi)
    {
        if (tid < 64) ((LAS unsigned*)(lds + 131072))[tid] = 0u;
        __syncthreads();
    }
    XcdBarrier bar = xcd_barrier_post((unsigned*)(ws + WS_CTL), (volatile LAS unsigned*)(lds + 131072 + 64));
    if (a.ph_lo < 0) grid.sync();
#define GSYNC() xcd_barrier(bar)
#define SEAM(k) do { if (IN(k) && (k) + 1 < hi) GSYNC(); } while (0)
#ifndef RPT_MASK
#define RPT_MASK 0
#endif
#ifndef RPT_N
#define RPT_N 1
#endif
#ifndef EXTRA_SYNCS
#define EXTRA_SYNCS 0
#endif
#define PHASE(k, ...) do { if (IN(k)) { __VA_ARGS__; if ((RPT_MASK >> (k)) & 1) { for (int rp_ = 0; rp_ < RPT_N; ++rp_) { GSYNC(); __VA_ARGS__; } } } SEAM(k); } while (0)
    bf16* HB = (bf16*)(ws + WS_HB); float* X = (float*)(ws + WS_X);
    bf16* U = (bf16*)(ws + WS_R1); bf16* FH = (bf16*)(ws + WS_R1);
    const float* MOD = (const float*)(ws + WS_MOD); const float* GM = (const float*)(ws + WS_GM); const float* BV = (const float*)(ws + WS_BV); float* SSP = (float*)(ws + WS_SSP);
    const float* xin = a.in[0]; const float* ctxin = a.in[2];

    PHASE(0, prologue(a, lds, tid, lane, wave););
    PHASE(1, norm_mod_phase(xin, ctxin, MT, a.in[6], MOD, 0, 1, HB, wave, lane); aux_phase(a, tid, wave, lane););
    PHASE(2, pg8::Gemm g{HB, (const bf16*)(ws + WS_WRCIN), MT, RCW, DM}; pg8::StaticOrder S; S.init(MT, RCW, G, bx);
        EpiStore E{U, RCW}; pg8::gemm_phase<EpiStore, pg8::StaticOrder, true, true>(lds, g, S, E););
    PHASE(3, rg1_phase(a, lds, tid, lane, wave););
    PHASE(4, rg_carry_phase(a, lds, wave, lane); sc_phase(a, wave, lane););
    PHASE(5, rg3_phase(a, wave, lane););
    PHASE(6, pg8::Gemm g{HB, (const bf16*)(ws + WS_WRCOUT), MT, DM, DM}; pg8::StaticOrder S; S.init(MT, DM, G, bx);
        EpiResid E{xin, ctxin, X, MOD + 2 * 1024, (bf16*)a.out, GM, SSP}; pg8::gemm_phase<EpiResid, pg8::StaticOrder, true, true>(lds, g, S, E););
    PHASE(8, pg8::Gemm g{(const bf16*)a.out, (const bf16*)(ws + WS_WFIN0), MT, 2 * DFF, DM}; pg8::StaticOrder S; S.init(MT, 2 * DFF, G, bx);
        rstd_table(lds, SSP, S, tid); EpiSwiGLU E{FH, DFF, lds, BV}; pg8::gemm_phase<EpiSwiGLU, pg8::StaticOrder, true, true>(lds, g, S, E););
    PHASE(9, pg8::Gemm g{FH, (const bf16*)(ws + WS_WFOUT0), MT, DM, DFF}; pg8::StaticOrder S; S.init(MT, DM, G, bx);
        EpiResid E{X, X + (size_t)ML * DM, X, MOD + 5 * 1024, HB, GM + 3072, SSP}; pg8::gemm_phase<EpiResid, pg8::StaticOrder, true, true>(lds, g, S, E););
    const float* MOD1 = MOD + 3 * 6144;
    PHASE(11, pg8::Gemm g{HB, (const bf16*)(ws + WS_WQKV), MT, NQKV, DM}; pg8::StaticOrder S; S.init(MT, NQKV, G, bx);
        EpiQKV E{(bf16*)(ws + WS_Q), (bf16*)(ws + WS_KV), (const float*)(ws + WS_ROPEC), (const float*)(ws + WS_ROPES), lds, BV + 3 * 2 * DFF}; rstd_table(lds, SSP, S, tid);
        pg8::gemm_phase<EpiQKV, pg8::StaticOrder, true, true>(lds, g, S, E););
    PHASE(12, attn_phase(a, lds, tid, lane, wave););
    PHASE(13, pg8::Gemm g{(const bf16*)(ws + WS_O), (const bf16*)(ws + WS_WAOUT), ML, DM, DM}; pg8::StaticOrder S; S.init(ML, DM, G, bx);
        EpiResid E{X, X + (size_t)ML * DM, X, MOD1 + 2 * 1024, HB, GM + 2 * 3072, SSP}; pg8::gemm_phase<EpiResid, pg8::StaticOrder, true, true>(lds, g, S, E););
    PHASE(15, pg8::Gemm g{HB, (const bf16*)(ws + WS_WFIN1), ML, 2 * DFF, DM}; pg8::StaticOrder S; S.init(ML, 2 * DFF, G, bx);
        rstd_table(lds, SSP, S, tid); EpiSwiGLU E{FH, DFF, lds, BV + 2 * 3 * 2 * DFF}; pg8::gemm_phase<EpiSwiGLU, pg8::StaticOrder, true, true>(lds, g, S, E););
    PHASE(16, pg8::Gemm g{FH, (const bf16*)(ws + WS_WFOUT1), ML, DM, DFF}; pg8::StaticOrder S; S.init(ML, DM, G, bx);
        EpiResid E{X, X + (size_t)ML * DM, X, MOD1 + 5 * 1024, nullptr, nullptr, nullptr}; pg8::gemm_phase<EpiResid, pg8::StaticOrder, true, true>(lds, g, S, E););
    PHASE(17, final_norm_phase(X, a.in[8], a.out, wave, lane););
    for (int es_ = 0; es_ < EXTRA_SYNCS; ++es_) GSYNC();
#undef IN
#undef SEAM
}

#ifndef MK_MULTI
#define MK_MULTI 0
#endif
extern "C" void kernel_launch(void* const* d_in, const int* in_sizes, int n_in, void* d_out, int out_size, void* d_ws, size_t ws_size, hipStream_t stream) {
    static int grid = 0;
    if (grid == 0) {
        if (n_in != 24 || out_size != ML * DM || ws_size < WS_END) { fprintf(stderr, "kernel_launch: unexpected shapes n_in %d out %d ws %zu\n", n_in, out_size, ws_size); grid = -1; return; }
        int dev = 0, cus = 0, per_cu = 0;
        hipGetDevice(&dev); hipDeviceGetAttribute(&cus, hipDeviceAttributeMultiprocessorCount, dev);
        if (hipFuncSetAttribute((const void*)fwd_kernel, hipFuncAttributeMaxDynamicSharedMemorySize, LDS_BYTES) != hipSuccess) { fprintf(stderr, "kernel_launch: hipFuncSetAttribute failed\n"); grid = -1; return; }
        if (hipOccupancyMaxActiveBlocksPerMultiprocessor(&per_cu, (const void*)fwd_kernel, NWAVES * 64, LDS_BYTES) != hipSuccess || per_cu < 1) { fprintf(stderr, "kernel_launch: occupancy query says %d\n", per_cu); per_cu = 1; }
        (void)hipGetLastError();
        grid = cus * 1;
    }
    if (grid < 0) return;
    Args a{};
    for (int i = 0; i < 24; ++i) a.in[i] = (const float*)d_in[i];
    a.out = (float*)d_out; a.ws = (unsigned char*)d_ws;
#if MK_MULTI
    for (int p = 0; p < N_PHASES; ++p) { a.ph_lo = p; a.ph_hi = p + 1; hipLaunchKernelGGL(fwd_kernel, dim3(grid), dim3(NWAVES * 64), LDS_BYTES, stream, a); }
#else
    a.ph_lo = 0; a.ph_hi = N_PHASES;
    if (hipMemsetAsync((char*)d_ws + WS_CTL, 0, CTL_BYTES, stream) != hipSuccess) { fprintf(stderr, "kernel_launch: memset failed\n"); return; }
    void* args[] = {&a};
    hipError_t e = hipLaunchCooperativeKernel((const void*)fwd_kernel, dim3(grid), dim3(NWAVES * 64), args, LDS_BYTES, stream);
    if (e != hipSuccess) fprintf(stderr, "kernel_launch: cooperative launch failed: %s (grid %d)\n", hipGetErrorString(e), grid);
#endif
}
```

```cpp
#include <hip/hip_runtime.h>
#include <hip/hip_cooperative_groups.h>
#include <cstdio>
#include <cstdint>
namespace cg = cooperative_groups;
namespace pg8 {
#define PG8_LAS __attribute__((address_space(3)))
typedef unsigned short bf16_t;
typedef short bf16x8 __attribute__((ext_vector_type(8)));
typedef float f32x4 __attribute__((ext_vector_type(4)));
typedef unsigned u32x4 __attribute__((ext_vector_type(4)));
constexpr int BM = 256, BK = 64, HALF = 128, HTB = HALF * BK * 2  , STAGE_BYTES = 8 * HTB, NXCD = 8, WGM = 8;

__host__ __device__ __forceinline__ int lds_byte(int r, int c) { const int st = (r >> 4) * 2 + (c >> 5), rr = r & 15, cc = c & 31, ob = rr * 64 + cc * 2; return st * 1024 + (ob ^ (((ob >> 9) & 1) << 5)); }
__host__ __device__ __forceinline__ void stage_rc(int b, int& R, int& C) { const int st = b / 1024, sb = b % 1024, swz = sb ^ (((sb >> 9) & 1) << 5); R = (st >> 1) * 16 + swz / 64; C = (st & 1) * 32 + (swz % 64) / 2; }
__host__ __device__ __forceinline__ int perm32(int rho) { const int n = rho >> 4, i = rho & 15; return 8 * (i >> 2) + 4 * n + (i & 3); }

struct Unit { int pm, pn, ord; };
struct Gemm { const bf16_t* A; const bf16_t* Bt; int M, N, K, ld; };

struct StaticOrder {
    int nM, nN, nwg, G, c;
    __host__ __device__ void init(int M, int N, int G_, int c_) { nM = M / BM; nN = N / BM; nwg = nM * nN; G = G_; c = c_; }
    __host__ __device__ bool next(int i, Unit& u) const {
        const long L = (long)i * G + c; if (L >= nwg) return false;
        int wgid = (int)L; { const int q = nwg / NXCD, r = nwg % NXCD, xcd = wgid % NXCD, off = wgid / NXCD; wgid = (xcd < r ? xcd * (q + 1) : r * (q + 1) + (xcd - r) * q) + off; }
        const int nig = WGM * nN, gid = wgid / nig, fm = gid * WGM, gsz = (nM - fm) < WGM ? (nM - fm) : WGM;
        u.pm = fm + ((wgid % nig) % gsz); u.pn = (wgid % nig) / gsz; return true;
    }
    __device__ __forceinline__ void a_ready(const Unit&) const {}
    __device__ __forceinline__ void done(const Unit&) const {}
};
template <class Epi, class Sched, bool ALIGN_EPI = false, bool SP2 = false>
__device__ __forceinline__ void gemm_phase(PG8_LAS unsigned char* lds, const Gemm g, const Sched& S, const Epi& E) {
    const int tid = threadIdx.x, wid = __builtin_amdgcn_readfirstlane(tid >> 6), lane = tid & 63, wr = wid >> 2, wc = wid & 3, fr = lane & 15, fq = lane >> 4;
    const int nt = g.K / BK, K = g.ld ? g.ld : g.K;
    unsigned voffA[2], voffB[2];
#pragma unroll
    for (int i = 0; i < 2; ++i) { int R, C; stage_rc(tid * 16 + i * 8192, R, C); const int Rb = Epi::PERM ? ((R & ~31) + perm32(R & 31)) : R;
        voffA[i] = (unsigned)(R * K + C) * 2u; voffB[i] = (unsigned)(Rb * K + C) * 2u; }
    const size_t kstep = (size_t)(BK * 2);
    const size_t hstep = (size_t)HALF * K * 2;
    const size_t tstep = 2 * hstep;
    const unsigned ldsw = (unsigned)wid * 1024u;
    const int aoff = lds_byte(wr * 64 + fr, fq * 8), boff = lds_byte(wc * 32 + fr, fq * 8);
#define PG8_SA(b, h) (((b) * 2 + (h)) * HTB)
#define PG8_SB(b, h) ((4 + (b) * 2 + (h)) * HTB)
#define PG8_STAGE(bufoff, gbase, voff) do { _Pragma("unroll") for (int _i = 0; _i < 2; ++_i) \
        __builtin_amdgcn_global_load_lds((const unsigned*)((const char*)(gbase) + (voff)[_i]), (PG8_LAS unsigned*)(lds + (bufoff) + ldsw + _i * 8192), 16, 0, 0); } while (0)
#define PG8_LDA(dst, b, h) do { _Pragma("unroll") for (int m = 0; m < 4; ++m) _Pragma("unroll") for (int k = 0; k < 2; ++k) dst[m][k] = *(const PG8_LAS bf16x8*)(lds + PG8_SA(b, h) + aoff + m * 2048 + k * 1024); } while (0)
#define PG8_LDB(dst, b, h) do { _Pragma("unroll") for (int n = 0; n < 2; ++n) _Pragma("unroll") for (int k = 0; k < 2; ++k) dst[n][k] = *(const PG8_LAS bf16x8*)(lds + PG8_SB(b, h) + boff + n * 2048 + k * 1024); } while (0)
#define PG8_MMA(ai, bj, At, Bt) do { __builtin_amdgcn_s_setprio(1); _Pragma("unroll") for (int m = 0; m < 4; ++m) _Pragma("unroll") for (int n = 0; n < 2; ++n) _Pragma("unroll") for (int k = 0; k < 2; ++k) \
        acc[ai][bj][m][n] = __builtin_amdgcn_mfma_f32_16x16x32_bf16(Bt[n][k], At[m][k], acc[ai][bj][m][n], 0, 0, 0); __builtin_amdgcn_s_setprio(0); } while (0)
#define PG8_WAIT_V(n) asm volatile("s_waitcnt vmcnt(" #n ")" ::: "memory")
#define PG8_WAIT_L(n) asm volatile("s_waitcnt lgkmcnt(" #n ")" ::: "memory")
#define PG8_BAR __builtin_amdgcn_s_barrier()
#define PG8_SCHED __builtin_amdgcn_sched_barrier(0)
    Unit cur, nxt; int ui = 0;
    if (!S.next(0, cur)) return; cur.ord = 0;
    f32x4 acc[2][2][4][2];
#pragma unroll
    for (int a = 0; a < 2; ++a)
#pragma unroll
        for (int b = 0; b < 2; ++b)
#pragma unroll
            for (int m = 0; m < 4; ++m)
#pragma unroll
                for (int n = 0; n < 2; ++n) acc[a][b][m][n] = (f32x4){0.f, 0.f, 0.f, 0.f};
    bf16x8 At[4][2], B0[2][2], B1[2][2];
    const char* cA = (const char*)g.A + (size_t)cur.pm * tstep; const char* cB = (const char*)g.Bt + (size_t)cur.pn * tstep;
    S.a_ready(cur);
    if constexpr (SP2) {
        PG8_STAGE(PG8_SB(0, 0), cB, voffB); PG8_STAGE(PG8_SB(0, 1), cB + hstep, voffB); PG8_STAGE(PG8_SA(0, 0), cA, voffA); PG8_STAGE(PG8_SA(0, 1), cA + hstep, voffA);
        if (wr == 1) PG8_BAR;
        PG8_WAIT_V(2); PG8_BAR;
        PG8_STAGE(PG8_SB(1, 0), cB + kstep, voffB); PG8_STAGE(PG8_SA(1, 0), cA + kstep, voffA); PG8_STAGE(PG8_SB(1, 1), cB + hstep + kstep, voffB);
        PG8_WAIT_V(6); PG8_BAR;
    } else {
        PG8_STAGE(PG8_SB(0, 0), cB, voffB); PG8_STAGE(PG8_SA(0, 0), cA, voffA); PG8_STAGE(PG8_SB(0, 1), cB + hstep, voffB); PG8_STAGE(PG8_SA(0, 1), cA + hstep, voffA);
        if (wr == 1) PG8_BAR;
        PG8_WAIT_V(4); PG8_BAR;
        PG8_STAGE(PG8_SB(1, 0), cB + kstep, voffB); PG8_STAGE(PG8_SA(1, 0), cA + kstep, voffA); PG8_STAGE(PG8_SB(1, 1), cB + hstep + kstep, voffB);
        PG8_WAIT_V(6); PG8_BAR;
    }
    for (;;) {
        const bool has_next = S.next(ui + 1, nxt); nxt.ord = ui + 1;
        const char* nA = has_next ? (const char*)g.A + (size_t)nxt.pm * tstep : cA; const char* nB = has_next ? (const char*)g.Bt + (size_t)nxt.pn * tstep : cB;
        for (int t = 0; t < nt; t += 2) {
            const bool last = (t == nt - 2);
            const char* a1 = cA + (size_t)(t + 1) * kstep;
            const char* a2 = last ? nA : cA + (size_t)(t + 2) * kstep; const char* b2 = last ? nB : cB + (size_t)(t + 2) * kstep;
            const char* a3 = a2 + kstep; const char* b3 = b2 + kstep;
            if (last && has_next) S.a_ready(nxt);
            if constexpr (SP2) {
            PG8_LDB(B0, 0, 0); PG8_LDB(B1, 0, 1); PG8_SCHED; PG8_LDA(At, 0, 0); PG8_STAGE(PG8_SA(1, 1), a1 + hstep, voffA);
            PG8_WAIT_V(8); PG8_WAIT_L(0); PG8_BAR; PG8_MMA(0, 0, At, B0); PG8_MMA(0, 1, At, B1); PG8_BAR; PG8_SCHED;
            PG8_LDA(At, 0, 1); PG8_STAGE(PG8_SB(0, 0), b2, voffB); PG8_STAGE(PG8_SB(0, 1), b2 + hstep, voffB); PG8_STAGE(PG8_SA(0, 0), a2, voffA);
            PG8_WAIT_V(8); PG8_WAIT_L(0); PG8_BAR; PG8_MMA(1, 0, At, B0); PG8_MMA(1, 1, At, B1); PG8_BAR; PG8_SCHED;
            PG8_LDB(B0, 1, 0); PG8_LDB(B1, 1, 1); PG8_SCHED; PG8_LDA(At, 1, 0); PG8_STAGE(PG8_SA(0, 1), a2 + hstep, voffA);
            PG8_WAIT_V(8); PG8_WAIT_L(0); PG8_BAR; PG8_MMA(0, 0, At, B0); PG8_MMA(0, 1, At, B1); PG8_BAR; PG8_SCHED;
            PG8_LDA(At, 1, 1); PG8_STAGE(PG8_SB(1, 0), b3, voffB); PG8_STAGE(PG8_SB(1, 1), b3 + hstep, voffB); PG8_STAGE(PG8_SA(1, 0), a3, voffA);
            PG8_WAIT_V(8); PG8_WAIT_L(0); PG8_BAR; PG8_MMA(1, 0, At, B0); PG8_MMA(1, 1, At, B1); PG8_BAR; PG8_SCHED;
            } else {
            PG8_LDB(B0, 0, 0); PG8_SCHED; PG8_LDA(At, 0, 0); PG8_STAGE(PG8_SA(1, 1), a1 + hstep, voffA);
            PG8_WAIT_L(8); PG8_BAR; PG8_WAIT_L(0); PG8_MMA(0, 0, At, B0); PG8_BAR; PG8_SCHED;
            PG8_LDB(B1, 0, 1); PG8_STAGE(PG8_SB(0, 0), b2, voffB);
            PG8_BAR; PG8_WAIT_L(0); PG8_MMA(0, 1, At, B1); PG8_BAR;
            PG8_LDA(At, 0, 1); PG8_STAGE(PG8_SA(0, 0), a2, voffA);
            PG8_BAR; PG8_WAIT_L(0); PG8_MMA(1, 0, At, B0); PG8_BAR; PG8_SCHED;
            PG8_STAGE(PG8_SB(0, 1), b2 + hstep, voffB);
            PG8_WAIT_V(6); PG8_BAR; PG8_MMA(1, 1, At, B1); PG8_BAR;
            PG8_LDB(B0, 1, 0); PG8_SCHED; PG8_LDA(At, 1, 0); PG8_STAGE(PG8_SA(0, 1), a2 + hstep, voffA);
            PG8_WAIT_L(8); PG8_BAR; PG8_WAIT_L(0); PG8_MMA(0, 0, At, B0); PG8_BAR; PG8_SCHED;
            PG8_LDB(B1, 1, 1); PG8_STAGE(PG8_SB(1, 0), b3, voffB);
            PG8_BAR; PG8_WAIT_L(0); PG8_MMA(0, 1, At, B1); PG8_BAR;
            PG8_LDA(At, 1, 1); PG8_STAGE(PG8_SA(1, 0), a3, voffA);
            PG8_BAR; PG8_WAIT_L(0); PG8_MMA(1, 0, At, B0); PG8_BAR; PG8_SCHED;
            PG8_STAGE(PG8_SB(1, 1), b3 + hstep, voffB);
            PG8_WAIT_V(6); PG8_BAR; PG8_MMA(1, 1, At, B1); PG8_BAR;
            }
        }
        if constexpr (ALIGN_EPI) { if (wr == 0) PG8_BAR; }
        if constexpr (!Epi::AFTER_DRAIN) { E(acc, cur, wr, wc, fr, fq); S.done(cur); }
        if (!has_next) break;
#pragma unroll
        for (int a = 0; a < 2; ++a)
#pragma unroll
            for (int b = 0; b < 2; ++b)
#pragma unroll
                for (int m = 0; m < 4; ++m)
#pragma unroll
                    for (int n = 0; n < 2; ++n) acc[a][b][m][n] = (f32x4){0.f, 0.f, 0.f, 0.f};
        cur = nxt; cA = nA; cB = nB; ++ui;
        if constexpr (ALIGN_EPI) { if (wr == 1) PG8_BAR; }
    }
    PG8_WAIT_V(0);
    if constexpr (!ALIGN_EPI) { if (wr == 0) PG8_BAR; }
    PG8_BAR;
    if constexpr (Epi::AFTER_DRAIN) { E.fused(acc, cur, wr, wc, fr, fq, lds, wid, lane); S.done(cur); }
#undef PG8_SA
#undef PG8_SB
#undef PG8_STAGE
#undef PG8_LDA
#undef PG8_LDB
#undef PG8_MMA
#undef PG8_WAIT_V
#undef PG8_WAIT_L
#undef PG8_BAR
#undef PG8_SCHED
}
}

#define DI __device__ __forceinline__
#define LAS __attribute__((address_space(3)))
typedef unsigned short bf16;
typedef pg8::f32x4 f32x4;
typedef pg8::bf16x8 bf16x8;
typedef pg8::u32x4 u32x4;
typedef unsigned u32x2 __attribute__((ext_vector_type(2)));
typedef float f32x16 __attribute__((ext_vector_type(16)));
typedef float f32x2_t __attribute__((ext_vector_type(2)));
typedef __bf16 bf16x2_t __attribute__((ext_vector_type(2)));

constexpr int DM = 1024, NB = 2, SEQ = 8192, CTX = 256;
constexpr int ML = NB * SEQ, MC = NB * CTX, MT = ML + MC;
constexpr int DFF = 2816, RCW = 2560, NQKV = 1536, DLRU = 512;
constexpr int NCH = 264;
constexpr int NWAVES = 8;
constexpr float LOG2E = 1.4426950408889634f;
constexpr float QSCALE = 0.125f * LOG2E;

constexpr size_t MiB = 1u << 20;
constexpr size_t WS_WRCIN = 0, WS_WRCOUT = 5 * MiB, WS_WFIN0 = 7 * MiB, WS_WFIN1 = 18 * MiB, WS_WFOUT0 = 29 * MiB, WS_WFOUT1 = 29 * MiB + 5632 * 1024,
                 WS_WQKV = 40 * MiB, WS_WAOUT = 43 * MiB;
constexpr size_t WS_SMALL = 45 * MiB;
constexpr size_t WS_GW = WS_SMALL, WS_MOD = WS_SMALL + 256 * 1024, WS_ROPEC = WS_SMALL + 512 * 1024, WS_ROPES = WS_ROPEC + 8192, WS_SP8 = WS_ROPES + 8192,
                 WS_SUMA = WS_SMALL + 1 * MiB, WS_SUMB = WS_SMALL + 3 * MiB + 256 * 1024, WS_HIN = WS_SMALL + 5 * MiB + 512 * 1024;
constexpr size_t WS_HB = 53 * MiB;
constexpr size_t WS_X = 86 * MiB;
constexpr size_t WS_R1 = 152 * MiB;
constexpr size_t WS_Q = WS_R1, WS_KV = WS_R1 + 33 * MiB, WS_O = WS_KV + 17 * MiB;
constexpr size_t WS_SSP = 244 * MiB;
constexpr size_t WS_BV = 246 * MiB, WS_GM = 247 * MiB;
constexpr size_t WS_BTAIL = 235 * MiB;
constexpr size_t WS_CTL = 243 * MiB, CTL_BYTES = 65536;
constexpr size_t WS_PART = 248 * MiB;
constexpr size_t WS_END = 256 * MiB;
constexpr int CTL_CTXCNT = 4096;
static_assert(WS_O + (size_t)ML * DM * 2 <= WS_CTL && WS_R1 + (size_t)MT * DFF * 2 <= WS_CTL, "ws map");
static_assert(WS_SUMB - WS_SUMA >= (size_t)NB * NCH * 2 * DLRU * 4 && WS_HIN + (size_t)NB * NCH * 2 * DLRU * 4 <= WS_HB, "ws small map");

constexpr int LDS_BYTES = 147456;

struct Args { const float* in[24]; float* out; unsigned char* ws; int ph_lo, ph_hi; };

DI unsigned pk2(float lo, float hi) { f32x2_t v = {lo, hi}; bf16x2_t b = __builtin_convertvector(v, bf16x2_t); return __builtin_bit_cast(unsigned, b); }
DI float bflo(unsigned u) { return __uint_as_float(u << 16); }
DI float bfhi(unsigned u) { return __uint_as_float(u & 0xffff0000u); }
DI f32x4 unpack4(u32x2 u) { return (f32x4){bflo(u.x), bfhi(u.x), bflo(u.y), bfhi(u.y)}; }
DI u32x2 pack4(f32x4 v) { u32x2 r; r.x = pk2(v[0], v[1]); r.y = pk2(v[2], v[3]); return r; }
DI float wave_sum(float v) {
#pragma unroll
    for (int o = 1; o < 64; o <<= 1) v += __shfl_xor(v, o);
    return v;
}
DI float fast_exp(float x) { return __builtin_amdgcn_exp2f(x * LOG2E); }
DI float sigmoidf_(float x) { return __builtin_amdgcn_rcpf(1.f + fast_exp(-x)); }
DI float siluf_(float x) { return x * sigmoidf_(x); }
DI float gelu_tanh(float x) { const float u = 0.7978845608028654f * (x + 0.044715f * x * x * x); return x * __builtin_amdgcn_rcpf(1.f + fast_exp(-2.f * u)); }
DI int bsel(int row) { return row < SEQ ? 0 : (row < ML ? 1 : 2); }

struct EpiStore {
    static constexpr bool PERM = true, AFTER_DRAIN = false;
    bf16* O; int ldc;
    DI void operator()(const f32x4 (&acc)[2][2][4][2], const pg8::Unit& u, int wr, int wc, int fr, int fq) const {
        const int row0 = u.pm * 256 + wr * 64 + fr, col0 = u.pn * 256 + wc * 32 + 8 * fq;
#pragma unroll
        for (int ai = 0; ai < 2; ++ai)
#pragma unroll
            for (int m = 0; m < 4; ++m) { bf16* rowp = O + (size_t)(row0 + ai * 128 + m * 16) * ldc + col0;
#pragma unroll
                for (int bj = 0; bj < 2; ++bj) { const f32x4 v0 = acc[ai][bj][m][0], v1 = acc[ai][bj][m][1];
                    u32x4 w; w.x = pk2(v0[0], v0[1]); w.y = pk2(v0[2], v0[3]); w.z = pk2(v1[0], v1[1]); w.w = pk2(v1[2], v1[3]);
                    *(u32x4*)(rowp + bj * 128) = w; } }
    }
};
constexpr int RS_TAB_OFF = 132096, RS_TAB_UNITS = 12;
template <class Sched> DI void rstd_table(LAS unsigned char* lds, const float* ssp, const Sched& S, int tid) {
    LAS float* tab = (LAS float*)(lds + RS_TAB_OFF);
    pg8::Unit u;
    for (int i = 0; i < RS_TAB_UNITS && S.next(i, u); ++i) {
        const int rr = tid >> 1, hf = tid & 1; const f32x4* q = (const f32x4*)(ssp + (size_t)(u.pm * 256 + rr) * 16 + hf * 8); const f32x4 a = q[0], b = q[1];
        float s = ((a[0] + a[1]) + (a[2] + a[3])) + ((b[0] + b[1]) + (b[2] + b[3]));
        s += __shfl_xor(s, 1);
        if (hf == 0) tab[i * 256 + rr] = 1.0f / sqrtf(s * (1.f / DM) + 1e-6f);
    }
    __syncthreads();
}
DI float row_rstd(LAS unsigned char* lds, int ord, int rin) { return ((const LAS float*)(lds + RS_TAB_OFF))[ord * 256 + rin]; }
struct EpiSwiGLU {
    static constexpr bool PERM = true, AFTER_DRAIN = false;
    bf16* O; int ldc; LAS unsigned char* lds; const float* bias;
    DI void operator()(const f32x4 (&acc)[2][2][4][2], const pg8::Unit& u, int wr, int wc, int fr, int fq) const {
        const int row0 = u.pm * 256 + wr * 64 + fr, col0 = u.pn * 128 + wc * 32 + 8 * fq;
        const int bs = u.pm < 32 ? 0 : (u.pm < 64 ? 1 : 2);
        const float* bp = bias + bs * (2 * DFF) + u.pn * 256 + wc * 32 + 8 * fq;
        f32x4 bv[2][2];
#pragma unroll
        for (int bj = 0; bj < 2; ++bj)
#pragma unroll
            for (int n = 0; n < 2; ++n) bv[bj][n] = *(const f32x4*)(bp + bj * 128 + 4 * n);
#pragma unroll
        for (int ai = 0; ai < 2; ++ai)
#pragma unroll
            for (int m = 0; m < 4; ++m) { const int r = row0 + ai * 128 + m * 16; bf16* rowp = O + (size_t)r * ldc + col0;
                const float rs = row_rstd(lds, u.ord, wr * 64 + fr + ai * 128 + m * 16);
                float v[8];
#pragma unroll
                for (int n = 0; n < 2; ++n)
#pragma unroll
                    for (int j = 0; j < 4; ++j) v[n * 4 + j] = siluf_(__builtin_fmaf(acc[ai][0][m][n][j], rs, bv[0][n][j])) * __builtin_fmaf(acc[ai][1][m][n][j], rs, bv[1][n][j]);
                u32x4 w; w.x = pk2(v[0], v[1]); w.y = pk2(v[2], v[3]); w.z = pk2(v[4], v[5]); w.w = pk2(v[6], v[7]);
                *(u32x4*)rowp = w; }
    }
};
struct EpiResid {
    static constexpr bool PERM = false, AFTER_DRAIN = false;
    const float* baseL; const float* baseC;
    float* X; const float* gate;
    bf16* HBn; const float* gm; float* ssp;
    DI void operator()(const f32x4 (&acc)[2][2][4][2], const pg8::Unit& u, int wr, int wc, int fr, int fq) const {
        const int bs = u.pm < 32 ? 0 : (u.pm < 64 ? 1 : 2);
        const int col0 = u.pn * 256 + wc * 32 + 4 * fq;
        const float* gp = gate + bs * 6144 + col0;
        f32x4 gv[2][2], gmv[2][2];
#pragma unroll
        for (int bj = 0; bj < 2; ++bj)
#pragma unroll
            for (int n = 0; n < 2; ++n) { gv[bj][n] = *(const f32x4*)(gp + bj * 128 + n * 16); if (HBn) gmv[bj][n] = *(const f32x4*)(gm + bs * 1024 + col0 + bj * 128 + n * 16); }
#pragma unroll
        for (int ai = 0; ai < 2; ++ai)
#pragma unroll
            for (int m = 0; m < 4; ++m) { const int r = u.pm * 256 + ai * 128 + wr * 64 + m * 16 + fr;
                const float* bp = (r < ML ? baseL + (size_t)r * DM : baseC + (size_t)(r - ML) * DM) + col0;
                float* op = X + (size_t)r * DM + col0;
                float ss = 0.f;
#pragma unroll
                for (int bj = 0; bj < 2; ++bj)
#pragma unroll
                    for (int n = 0; n < 2; ++n) { const f32x4 b4 = *(const f32x4*)(bp + bj * 128 + n * 16);
                        const f32x4 xn = b4 + gv[bj][n] * acc[ai][bj][m][n];
                        *(f32x4*)(op + bj * 128 + n * 16) = xn;
                        if (HBn) { ss += (xn[0] * xn[0] + xn[1] * xn[1]) + (xn[2] * xn[2] + xn[3] * xn[3]);
                            *(u32x2*)(HBn + (size_t)r * DM + col0 + bj * 128 + n * 16) = pack4(xn * gmv[bj][n]); } }
                if (HBn) { ss += __shfl_xor(ss, 16); ss += __shfl_xor(ss, 32); if (fq == 0) ssp[(size_t)r * 16 + u.pn * 4 + wc] = ss; } }
    }
};
struct EpiQKV {
    static constexpr bool PERM = false, AFTER_DRAIN = false;
    bf16 *Q, *KV; const float *ropec, *ropes; LAS unsigned char* lds; const float* bias;
    DI void operator()(const f32x4 (&acc)[2][2][4][2], const pg8::Unit& u, int wr, int wc, int fr, int fq) const {
        const bool rope_on = (u.pm < 64) && (u.pn < 5);
        const float scale = u.pn < 4 ? QSCALE : 1.0f;
        bf16* dst = u.pn < 4 ? Q + u.pn * 256 : KV + (u.pn - 4) * 256; const int ld = u.pn < 4 ? DM : 512;
        const int ax = wc & 1, cc = wc * 32 + 4 * fq;
        const int bs = u.pm < 32 ? 0 : (u.pm < 64 ? 1 : 2);
        const float* bp = bias + bs * NQKV + u.pn * 256 + cc;
        f32x4 bv[2][2];
#pragma unroll
        for (int bj = 0; bj < 2; ++bj)
#pragma unroll
            for (int n = 0; n < 2; ++n) bv[bj][n] = *(const f32x4*)(bp + bj * 128 + n * 16);
#pragma unroll
        for (int ai = 0; ai < 2; ++ai)
#pragma unroll
            for (int m = 0; m < 4; ++m) { const int r = u.pm * 256 + ai * 128 + wr * 64 + m * 16 + fr;
                const float rs = row_rstd(lds, u.ord, ai * 128 + wr * 64 + m * 16 + fr);
                const int s = r & (SEQ - 1); const int pos = ax ? (s & 63) : (s >> 6);
                f32x4 c4 = (f32x4){1.f, 1.f, 1.f, 1.f}, s4 = (f32x4){0.f, 0.f, 0.f, 0.f};
                if (rope_on) { c4 = *(const f32x4*)(ropec + pos * 16 + 4 * fq); s4 = *(const f32x4*)(ropes + pos * 16 + 4 * fq); }
                bf16* p = dst + (size_t)r * ld + cc;
#pragma unroll
                for (int bj = 0; bj < 2; ++bj) { const f32x4 x1 = acc[ai][bj][m][0] * rs + bv[bj][0], x2 = acc[ai][bj][m][1] * rs + bv[bj][1];
                    const f32x4 o1 = (x1 * c4 - x2 * s4) * scale, o2 = (x2 * c4 + x1 * s4) * scale;
                    *(u32x2*)(p + bj * 128) = pack4(o1); *(u32x2*)(p + bj * 128 + 16) = pack4(o2); } }
    }
};

DI void transpose_item(const float* W, int ldN, bf16* WT, int K, int k0, int src_n0, int dst_n0, LAS float* scr, int lane) {
#pragma unroll 8
    for (int i = 0; i < 32; ++i) { const int kk = 2 * i + (lane >> 5); scr[kk * 33 + (lane & 31)] = W[(size_t)(k0 + kk) * ldN + src_n0 + (lane & 31)]; }
    asm volatile("s_waitcnt lgkmcnt(0)" ::: "memory");
    const int c = lane & 7;
#pragma unroll
    for (int j = 0; j < 4; ++j) { const int n = (lane >> 3) + 8 * j; const LAS float* s = scr + (8 * c) * 33 + n;
        u32x4 o; o.x = pk2(s[0 * 33], s[1 * 33]); o.y = pk2(s[2 * 33], s[3 * 33]); o.z = pk2(s[4 * 33], s[5 * 33]); o.w = pk2(s[6 * 33], s[7 * 33]);
        *(u32x4*)(WT + (size_t)(dst_n0 + n) * K + k0 + 8 * c) = o; }
    asm volatile("s_waitcnt lgkmcnt(0)" ::: "memory");
}
DI void mat_item(int r, const float* W, int K, int N, bf16* WT, bool remap, LAS float* scr, int lane) {
    const int nblk = N / 32, kb = r / nblk, nb = r % nblk; const int dst_n0 = 32 * nb; int src_n0 = dst_n0;
    if (remap) { const int pn = dst_n0 >> 8, w = dst_n0 & 255; src_n0 = (w < 128) ? 128 * pn + w : DFF + 128 * pn + (w - 128); }
    transpose_item(W, N, WT, K, 64 * kb, src_n0, dst_n0, scr, lane);
}
DI void prologue(const Args& a, LAS unsigned char* lds, int tid, int lane, int wave) {
    unsigned char* ws = a.ws;
    {
        LAS float* scr = (LAS float*)(lds + wave * 16384);
        const int gw = blockIdx.x * NWAVES + wave, NGW = gridDim.x * NWAVES;
        constexpr int I0 = 16 * 80, I1 = 16 * 32, I2 = 16 * 176, I4 = 44 * 32, I6 = 16 * 48, I7 = 16 * 32;
        constexpr int NITEMS = I0 + I1 + 2 * I2 + 2 * I4 + I6 + I7;
        for (int it = gw; it < NITEMS; it += NGW) {
            int r = it;
            if (r < I0) { mat_item(r, a.in[11], 1024, RCW, (bf16*)(ws + WS_WRCIN), false, scr, lane); continue; } r -= I0;
            if (r < I1) { mat_item(r, a.in[20], 1024, 1024, (bf16*)(ws + WS_WRCOUT), false, scr, lane); continue; } r -= I1;
            if (r < I2) { mat_item(r, a.in[9], 1024, 2 * DFF, (bf16*)(ws + WS_WFIN0), true, scr, lane); continue; } r -= I2;
            if (r < I2) { mat_item(r, a.in[9] + (size_t)1024 * 2 * DFF, 1024, 2 * DFF, (bf16*)(ws + WS_WFIN1), true, scr, lane); continue; } r -= I2;
            if (r < I4) { mat_item(r, a.in[10], DFF, 1024, (bf16*)(ws + WS_WFOUT0), false, scr, lane); continue; } r -= I4;
            if (r < I4) { mat_item(r, a.in[10] + (size_t)DFF * 1024, DFF, 1024, (bf16*)(ws + WS_WFOUT1), false, scr, lane); continue; } r -= I4;
            if (r < I6) { mat_item(r, a.in[21], 1024, NQKV, (bf16*)(ws + WS_WQKV), false, scr, lane); continue; } r -= I6;
            mat_item(r, a.in[23], 1024, 1024, (bf16*)(ws + WS_WAOUT), false, scr, lane);
        }
    }
    {
        const int gt = blockIdx.x * 512 + tid, NT = gridDim.x * 512;
        bf16* GW = (bf16*)(ws + WS_GW);
        for (int idx = gt; idx < 131072; idx += NT) {
            const int j = idx & 7, ln = (idx >> 3) & 63, ks = (idx >> 9) & 3, mt = (idx >> 11) & 1, head = (idx >> 12) & 7, dg = idx >> 15;
            const int hi = ln >> 5, m = ln & 31;
            const int cin = 32 * (ks >> 1) + 16 * (ks & 1) + 8 * (j >> 2) + 4 * hi + (j & 3), cout = 32 * mt + m;
            const int d = dg >> 1; const float* src = (dg & 1) ? a.in[16] : a.in[14];
            const float v = src[((size_t)(d * 8 + head) * 64 + cin) * 64 + cout];
            GW[idx] = (bf16)(pk2(v, 0.f) & 0xffffu);
        }
        float* sp8 = (float*)(ws + WS_SP8);
        for (int idx = gt; idx < 2 * DLRU; idx += NT) sp8[idx] = -8.0f * log1pf(expf(-a.in[18][idx]));
        float* rc = (float*)(ws + WS_ROPEC); float* rs = (float*)(ws + WS_ROPES);
        for (int idx = gt; idx < 2048; idx += NT) {
            const int pos = idx >> 4, f = idx & 15;
            const float inv = (float)exp2(-(double)f * (13.287712379549449 / 16.0));
            const float ang = (float)pos * inv;
            double x = (double)ang; const double n = rint(x * 0.15915494309189535); x -= n * 6.283185307179586476925;
            const double x2 = x * x; double cs = 1.0, sn = 1.0;
            { double t = 1.0, s = 1.0;
              for (int i = 1; i <= 14; ++i) { t *= -x2 / (double)((2 * i - 1) * (2 * i)); s += t; } cs = s; }
            { double t = 1.0, s = 1.0;
              for (int i = 1; i <= 14; ++i) { t *= -x2 / (double)((2 * i) * (2 * i + 1)); s += t; } sn = s * x; }
            rc[idx] = (float)cs; rs[idx] = (float)sn;
        }
    }
    {
        LAS float* red = (LAS float*)lds;
        float* MOD = (float*)(ws + WS_MOD);
        for (int it = blockIdx.x; it < 192; it += gridDim.x) {
            __syncthreads();
            const int l = it / 96, n0 = (it % 96) * 64, cl = lane & 15, ksub = lane >> 4;
            f32x4 a0 = {0.f, 0.f, 0.f, 0.f}, a1 = a0, a2 = a0;
            const float* wbase = a.in[4] + (size_t)l * 1024 * 6144 + n0 + 4 * cl;
#pragma unroll 8
            for (int i = 0; i < 32; ++i) { const int k = 128 * wave + 4 * i + ksub;
                const f32x4 w = *(const f32x4*)(wbase + (size_t)k * 6144);
                const float s0 = siluf_(a.in[1][k]), s1 = siluf_(a.in[1][1024 + k]), s2 = siluf_(a.in[3][k]);
                a0 += w * s0; a1 += w * s1; a2 += w * s2; }
#pragma unroll
            for (int j = 0; j < 4; ++j) { a0[j] += __shfl_xor(a0[j], 16); a0[j] += __shfl_xor(a0[j], 32); a1[j] += __shfl_xor(a1[j], 16); a1[j] += __shfl_xor(a1[j], 32); a2[j] += __shfl_xor(a2[j], 16); a2[j] += __shfl_xor(a2[j], 32); }
            if (ksub == 0) {
#pragma unroll
                for (int j = 0; j < 4; ++j) { red[(wave * 3 + 0) * 64 + 4 * cl + j] = a0[j]; red[(wave * 3 + 1) * 64 + 4 * cl + j] = a1[j]; red[(wave * 3 + 2) * 64 + 4 * cl + j] = a2[j]; } }
            __syncthreads();
            if (tid < 192) { const int bs = tid >> 6, col = tid & 63; float s = a.in[5][l * 6144 + n0 + col];
#pragma unroll
                for (int w = 0; w < 8; ++w) s += red[(w * 3 + bs) * 64 + col];
                MOD[(size_t)(l * 3 + bs) * 6144 + n0 + col] = s; }
        }
        __syncthreads();
    }
}

DI void norm_mod_phase(const float* srcL, const float* srcC, int nrows, const float* g, const float* mod, int shk, int sck, bf16* dst, int wave, int lane) {
    const int gw = blockIdx.x * NWAVES + wave, NGW = gridDim.x * NWAVES;
    for (int row = gw; row < nrows; row += NGW) {
        const float* src = row < ML ? srcL + (size_t)row * DM : srcC + (size_t)(row - ML) * DM;
        const float* mb = mod + bsel(row) * 6144;
        const f32x4* x4 = (const f32x4*)src + lane;
        f32x4 v[4]; float ss = 0.f;
#pragma unroll
        for (int j = 0; j < 4; ++j) { v[j] = x4[64 * j]; ss += (v[j][0] * v[j][0] + v[j][1] * v[j][1]) + (v[j][2] * v[j][2] + v[j][3] * v[j][3]); }
        const float rstd = 1.0f / sqrtf(wave_sum(ss) * (1.f / DM) + 1e-6f);
        u32x2* o = (u32x2*)(dst + (size_t)row * DM) + lane;
#pragma unroll
        for (int j = 0; j < 4; ++j) { const f32x4 gg = ((const f32x4*)g)[lane + 64 * j], sc = ((const f32x4*)(mb + sck * 1024))[lane + 64 * j], sh = ((const f32x4*)(mb + shk * 1024))[lane + 64 * j];
            const f32x4 y = (v[j] * rstd * gg) * (sc + 1.0f) + sh; o[64 * j] = pack4(y); }
    }
}
DI void final_norm_phase(const float* X, const float* g, float* out, int wave, int lane) {
    const int gw = blockIdx.x * NWAVES + wave, NGW = gridDim.x * NWAVES;
    for (int row = gw; row < ML; row += NGW) {
        const f32x4* x4 = (const f32x4*)(X + (size_t)row * DM) + lane;
        f32x4 v[4]; float ss = 0.f;
#pragma unroll
        for (int j = 0; j < 4; ++j) { v[j] = x4[64 * j]; ss += (v[j][0] * v[j][0] + v[j][1] * v[j][1]) + (v[j][2] * v[j][2] + v[j][3] * v[j][3]); }
        const float rstd = 1.0f / sqrtf(wave_sum(ss) * (1.f / DM) + 1e-6f);
        f32x4* o = (f32x4*)(out + (size_t)row * DM) + lane;
#pragma unroll
        for (int j = 0; j < 4; ++j) o[64 * j] = v[j] * rstd * ((const f32x4*)g)[lane + 64 * j];
    }
}

DI void aux_phase(const Args& a, int tid, int wave, int lane) {
    unsigned char* ws = a.ws;
    const float* MOD = (const float*)(ws + WS_MOD);
    float* GM = (float*)(ws + WS_GM); float* BV = (float*)(ws + WS_BV);
    const int gt = blockIdx.x * 512 + tid, NT = gridDim.x * 512;
    for (int idx = gt; idx < 9 * 1024; idx += NT) { const int c = idx & 1023, bs = (idx >> 10) % 3, which = idx / 3072;
        const float g = which == 0 ? a.in[7][c] : (which == 1 ? a.in[6][DM + c] : a.in[7][DM + c]);
        const float sc = MOD[(size_t)((which == 0 ? 0 : 1) * 3 + bs) * 6144 + (which == 1 ? 1 : 4) * 1024 + c];
        GM[idx] = g * (1.0f + sc); }
    const int gw = blockIdx.x * NWAVES + wave, NGW = gridDim.x * NWAVES;
    for (int it = gw; it < 2 * DFF + NQKV + 2 * DFF; it += NGW) {
        int which, n; if (it < 2 * DFF) { which = 0; n = it; } else if (it < 2 * DFF + NQKV) { which = 1; n = it - 2 * DFF; } else { which = 2; n = it - 2 * DFF - NQKV; }
        const bf16* Bt = (const bf16*)(ws + (which == 0 ? WS_WFIN0 : (which == 1 ? WS_WQKV : WS_WFIN1))) + (size_t)n * DM + 16 * lane;
        const int N = which == 1 ? NQKV : 2 * DFF;
        const float* shb = MOD + (size_t)((which == 0 ? 0 : 1) * 3) * 6144 + (which == 1 ? 0 : 3) * 1024 + 16 * lane;
        const u32x4 w0 = *(const u32x4*)Bt, w1 = *(const u32x4*)(Bt + 8);
        const f32x4 wv[4] = {unpack4((u32x2){w0.x, w0.y}), unpack4((u32x2){w0.z, w0.w}), unpack4((u32x2){w1.x, w1.y}), unpack4((u32x2){w1.z, w1.w})};
        float acc[3];
#pragma unroll
        for (int bs = 0; bs < 3; ++bs) { float s_ = 0.f;
#pragma unroll
            for (int q = 0; q < 4; ++q) { const f32x4 sh = *(const f32x4*)(shb + bs * 6144 + 4 * q); s_ += (wv[q][0] * sh[0] + wv[q][1] * sh[1]) + (wv[q][2] * sh[2] + wv[q][3] * sh[3]); }
            acc[bs] = wave_sum(s_); }
        if (lane == 0) { float* o = BV + (size_t)which * 3 * (2 * DFF) + n; o[0] = acc[0]; o[N] = acc[1]; o[2 * N] = acc[2]; }
    }
}

constexpr int RG_UNITS = NB * NCH * 8;
DI float* rg_bcum_ptr(const Args& a, int unit) { return unit < 4096 ? a.out + (size_t)unit * 4096 : (float*)(a.ws + WS_BTAIL) + (size_t)(unit - 4096) * 4096; }
template <int CTRL, int RMASK> DI float dppf(float oldv, float v) {
    return __builtin_bit_cast(float, __builtin_amdgcn_update_dpp(__builtin_bit_cast(int, oldv), __builtin_bit_cast(int, v), CTRL, RMASK, 0xf, false));
}
#define RG_SCAN_STEP(CTRL, RMASK) do { _Pragma("unroll") for (int r = 0; r < 16; ++r) { const float am = aR[r], bm = aI[r]; \
        const float ap = dppf<CTRL, RMASK>(1.0f, am), bp = dppf<CTRL, RMASK>(0.0f, bm); aR[r] = am * ap; aI[r] = __builtin_fmaf(am, bp, bm); } } while (0)
template <int D, int MT_> DI void rg1_quarter(const float (&xc)[2][16], const bf16x8 (&xb)[4], const LAS unsigned char* gwl, const LAS float* pv,
                                              float* acum, float* bcum, float* SUMA, float* SUMB, int lane, size_t sbase) {
    const int hi = lane >> 5;
    f32x16 aR, aI;
#pragma unroll
    for (int i = 0; i < 16; ++i) { aR[i] = 0.f; aI[i] = 0.f; }
#pragma unroll
    for (int ks = 0; ks < 4; ++ks) {
        const bf16x8 wr_ = *(const LAS bf16x8*)(gwl + ((((D * 2 + 0) * 2 + MT_) * 4 + ks) * 64 + lane) * 16);
        const bf16x8 wi_ = *(const LAS bf16x8*)(gwl + ((((D * 2 + 1) * 2 + MT_) * 4 + ks) * 64 + lane) * 16);
        aR = __builtin_amdgcn_mfma_f32_32x32x16_bf16(wr_, xb[ks], aR, 0, 0, 0);
        aI = __builtin_amdgcn_mfma_f32_32x32x16_bf16(wi_, xb[ks], aI, 0, 0, 0);
    }
#pragma unroll
    for (int rq = 0; rq < 4; ++rq) {
        const int c0 = 32 * MT_ + 8 * rq + 4 * hi;
        const f32x4 rb4 = *(const LAS f32x4*)(pv + 320 + D * 64 + c0), ib4 = *(const LAS f32x4*)(pv + 448 + D * 64 + c0), lm4 = *(const LAS f32x4*)(pv + 576 + D * 64 + c0);
#pragma unroll
        for (int j = 0; j < 4; ++j) { const int r = 4 * rq + j;
            const float rr = __builtin_amdgcn_rcpf(1.0f + __builtin_amdgcn_exp2f(__builtin_fmaf(aR[r], -LOG2E, rb4[j])));
            const float ii = __builtin_amdgcn_rcpf(1.0f + __builtin_amdgcn_exp2f(__builtin_fmaf(aI[r], -LOG2E, ib4[j])));
            const float av = __builtin_amdgcn_exp2f(rr * lm4[j]);
            const float mult = __builtin_amdgcn_sqrtf(fmaxf(__builtin_fmaf(-av, av, 1.0f), 1e-12f));
            aR[r] = av; aI[r] = mult * ii * xc[MT_][r]; }
    }
    if (D == 1) {
#pragma unroll
        for (int r = 0; r < 16; ++r) { aR[r] = __shfl_xor(aR[r], 31); aI[r] = __shfl_xor(aI[r], 31); }
    }
    RG_SCAN_STEP(0x111, 0xf);
    RG_SCAN_STEP(0x112, 0xf);
    RG_SCAN_STEP(0x114, 0xf);
    RG_SCAN_STEP(0x118, 0xf);
    RG_SCAN_STEP(0x142, 0xa);
#pragma unroll
    for (int rq = 0; rq < 4; ++rq) {
        *(f32x4*)(acum + ((D * 2 + MT_) * 4 + rq) * 256 + lane * 4) = (f32x4){aR[4 * rq], aR[4 * rq + 1], aR[4 * rq + 2], aR[4 * rq + 3]};
        *(f32x4*)(bcum + ((D * 2 + MT_) * 4 + rq) * 256 + lane * 4) = (f32x4){aI[4 * rq], aI[4 * rq + 1], aI[4 * rq + 2], aI[4 * rq + 3]};
    }
    if ((lane & 31) == 31) {
#pragma unroll
        for (int rq = 0; rq < 4; ++rq) { const int c0 = 32 * MT_ + 8 * rq + 4 * hi;
            *(f32x4*)(SUMA + sbase + D * DLRU + c0) = (f32x4){aR[4 * rq], aR[4 * rq + 1], aR[4 * rq + 2], aR[4 * rq + 3]};
            *(f32x4*)(SUMB + sbase + D * DLRU + c0) = (f32x4){aI[4 * rq], aI[4 * rq + 1], aI[4 * rq + 2], aI[4 * rq + 3]}; }
    }
}
template <int QMASK> DI void rg1_unit(const Args& a, const LAS unsigned char* gwl, const LAS float* pv, int cb, int head, int lane_in) {
    unsigned char* ws = a.ws;
    const bf16* U = (const bf16*)(ws + WS_R1);
    float* SUMA = (float*)(ws + WS_SUMA); float* SUMB = (float*)(ws + WS_SUMB);
    int lane_o = lane_in; asm volatile("" : "+v"(lane_o));
    const int lane = lane_o, tok = lane & 31, hi = lane >> 5;
    const int gc = cb >> 1, b = cb & 1, unit = cb * 8 + head;
    const bool lat = gc < 256;
    const int ts0 = lat ? gc * 32 : (gc - 256) * 32, len = lat ? SEQ : CTX, rowbase = lat ? b * SEQ : ML + b * CTX;
    const int ts = ts0 + tok;
    u32x2 tap[8][4];
#pragma unroll
    for (int k = 0; k < 4; ++k) { const int tt = ts - 2 + k; const bool ok = (tt >= 0) && (tt < len); const int ttc = ok ? tt : ts;
        const bf16* up = U + (size_t)(rowbase + ttc) * RCW + head * 64 + 4 * hi;
#pragma unroll
        for (int q = 0; q < 8; ++q) { u32x2 v = *(const u32x2*)(up + 8 * q); if (!ok) { v.x = 0u; v.y = 0u; } tap[q][k] = v; } }
    float xc[2][16];
#pragma unroll
    for (int q = 0; q < 8; ++q) {
        f32x4 acc = *(const LAS f32x4*)(pv + 256 + 8 * q + 4 * hi);
#pragma unroll
        for (int k = 0; k < 4; ++k) acc += *(const LAS f32x4*)(pv + k * 64 + 8 * q + 4 * hi) * unpack4(tap[q][k]);
#pragma unroll
        for (int j = 0; j < 4; ++j) xc[q >> 2][4 * (q & 3) + j] = acc[j];
    }
    bf16x8 xb[4];
#pragma unroll
    for (int ks = 0; ks < 4; ++ks) { const int mt = ks >> 1, r0 = 8 * (ks & 1);
        u32x4 p; p.x = pk2(xc[mt][r0], xc[mt][r0 + 1]); p.y = pk2(xc[mt][r0 + 2], xc[mt][r0 + 3]); p.z = pk2(xc[mt][r0 + 4], xc[mt][r0 + 5]); p.w = pk2(xc[mt][r0 + 6], xc[mt][r0 + 7]);
        xb[ks] = __builtin_bit_cast(bf16x8, p); }
    float* acum = (float*)(ws + WS_X) + (size_t)unit * 4096; float* bcum = rg_bcum_ptr(a, unit);
    const size_t sbase = ((size_t)(b * NCH + gc) * 2) * DLRU + head * 64;
    if (QMASK & 1) { rg1_quarter<0, 0>(xc, xb, gwl, pv, acum, bcum, SUMA, SUMB, lane, sbase); asm volatile("" ::: "memory"); }
    if (QMASK & 2) { rg1_quarter<0, 1>(xc, xb, gwl, pv, acum, bcum, SUMA, SUMB, lane, sbase); asm volatile("" ::: "memory"); }
    if (QMASK & 4) { rg1_quarter<1, 0>(xc, xb, gwl, pv, acum, bcum, SUMA, SUMB, lane, sbase); asm volatile("" ::: "memory"); }
    if (QMASK & 8) { rg1_quarter<1, 1>(xc, xb, gwl, pv, acum, bcum, SUMA, SUMB, lane, sbase); asm volatile("" ::: "memory"); }
}
DI void rg1_phase(const Args& a, LAS unsigned char* lds, int tid, int lane, int wave) {
    unsigned char* ws = a.ws;
    const int head = blockIdx.x & 7, nbh = ((int)gridDim.x - head + 7) >> 3;
    const int wslot = (blockIdx.x >> 3) * NWAVES + wave, NWS = nbh * NWAVES;
    LAS unsigned char* gwl = lds; LAS float* pv = (LAS float*)(lds + 32768);
    {
        const bf16* GW = (const bf16*)(ws + WS_GW);
#pragma unroll
        for (int i = 0; i < 4; ++i) { const int idx16 = tid + 512 * i, dg = idx16 >> 9;
            *(LAS u32x4*)(gwl + idx16 * 16) = *(const u32x4*)(GW + (size_t)(dg * 8 + head) * 4096 + (idx16 & 511) * 8); }
        for (int t = tid; t < 704; t += 512) { const int c = t & 63; float v;
            if (t < 256) v = a.in[12][(t >> 6) * DLRU + head * 64 + c];
            else if (t < 320) v = a.in[13][head * 64 + c];
            else if (t < 448) v = -LOG2E * a.in[15][((t - 320) >> 6) * DLRU + head * 64 + c];
            else if (t < 576) v = -LOG2E * a.in[17][((t - 448) >> 6) * DLRU + head * 64 + c];
            else v = LOG2E * ((const float*)(ws + WS_SP8))[((t - 576) >> 6) * DLRU + head * 64 + c];
            pv[t] = v; }
        __syncthreads();
    }
    for (int cb = wslot; cb < 512; cb += NWS) rg1_unit<15>(a, gwl, pv, cb, head, lane);
    for (int qi = wslot; qi < 64; qi += NWS) { const int cb = 512 + (qi >> 2), qq = qi & 3;
        if (qq == 0) rg1_unit<1>(a, gwl, pv, cb, head, lane); else if (qq == 1) rg1_unit<2>(a, gwl, pv, cb, head, lane);
        else if (qq == 2) rg1_unit<4>(a, gwl, pv, cb, head, lane); else rg1_unit<8>(a, gwl, pv, cb, head, lane); }
    __syncthreads();
}
DI void rg_carry_phase(const Args& a, LAS unsigned char* lds, int wave, int lane) {
    unsigned char* ws = a.ws;
    const float* SUMA = (const float*)(ws + WS_SUMA); const float* SUMB = (const float*)(ws + WS_SUMB); float* HIN = (float*)(ws + WS_HIN);
    LAS float* sh = (LAS float*)lds;
    for (int it = blockIdx.x; it < 32; it += gridDim.x) {
        const int head = it & 7, d = (it >> 3) & 1, b = it >> 4;
        const int c = lane, seg = wave; const float* sa = SUMA + c; const float* sb = SUMB + c; float* ho = HIN + c;
        float av[33], bv[33];
#pragma unroll
        for (int i = 0; i < 33; ++i) { const int st = seg * 33 + i; const int gc = d == 0 ? (st + 256) % NCH : (NCH - 1 - st);
            const unsigned idx = (unsigned)(((b * NCH + gc) * 2 + d) * DLRU + head * 64); av[i] = sa[idx]; bv[i] = sb[idx]; }
        float A = 1.f, B = 0.f;
#pragma unroll
        for (int i = 0; i < 33; ++i) { B = av[i] * B + bv[i]; A = av[i] * A; }
        __syncthreads();
        sh[(seg * 64 + c) * 2] = A; sh[(seg * 64 + c) * 2 + 1] = B;
        __syncthreads();
        float h = 0.f;
        for (int s = 0; s < seg; ++s) h = sh[(s * 64 + c) * 2] * h + sh[(s * 64 + c) * 2 + 1];
#pragma unroll
        for (int i = 0; i < 33; ++i) { const int st = seg * 33 + i; const int gc = d == 0 ? (st + 256) % NCH : (NCH - 1 - st);
            const unsigned idx = (unsigned)(((b * NCH + gc) * 2 + d) * DLRU + head * 64); ho[idx] = h; h = av[i] * h + bv[i]; }
    }
    __syncthreads();
}
DI void rg3_phase(const Args& a, int wave, int lane_in) {
    unsigned char* ws = a.ws;
    const bf16* U = (const bf16*)(ws + WS_R1);
    const float* HIN = (const float*)(ws + WS_HIN);
    bf16* Y = (bf16*)(ws + WS_HB);
    const int gw = blockIdx.x * NWAVES + wave, NGW = gridDim.x * NWAVES;
    for (int hu = gw; hu < 2 * RG_UNITS; hu += NGW) {
        int lane_o = lane_in; asm volatile("" : "+v"(lane_o));
        const int lane = lane_o, tok = lane & 31, hi = lane >> 5;
        const int mt = hu & 1, unit = hu >> 1, head = unit & 7, cb = unit >> 3, gc = cb >> 1, b = cb & 1;
        const bool lat = gc < 256;
        const int row = (lat ? b * SEQ + gc * 32 : ML + b * CTX + (gc - 256) * 32) + tok;
        const float* acum = (const float*)(ws + WS_X) + (size_t)unit * 4096 + mt * 1024 + lane * 4; const float* bcum = rg_bcum_ptr(a, unit) + mt * 1024 + lane * 4;
        const float* hin = HIN + ((size_t)(b * NCH + gc) * 2) * DLRU + head * 64 + 32 * mt + 4 * hi;
        f32x4 A4[2][4], B4[2][4], H4[2][4];
#pragma unroll
        for (int d = 0; d < 2; ++d)
#pragma unroll
            for (int rq = 0; rq < 4; ++rq) { A4[d][rq] = *(const f32x4*)(acum + d * 2048 + rq * 256); B4[d][rq] = *(const f32x4*)(bcum + d * 2048 + rq * 256);
                H4[d][rq] = *(const f32x4*)(hin + d * DLRU + 8 * rq); }
        u32x2 gau[4];
#pragma unroll
        for (int rq = 0; rq < 4; ++rq) gau[rq] = *(const u32x2*)(U + (size_t)row * RCW + DLRU + head * 64 + 32 * mt + 8 * rq + 4 * hi);
#pragma unroll
        for (int rq = 0; rq < 4; ++rq) { const f32x4 ga = unpack4(gau[rq]); f32x4 y;
#pragma unroll
            for (int j = 0; j < 4; ++j) { const float h0 = __builtin_fmaf(A4[0][rq][j], H4[0][rq][j], B4[0][rq][j]), h1 = __builtin_fmaf(A4[1][rq][j], H4[1][rq][j], B4[1][rq][j]);
                y[j] = (h0 + __shfl_xor(h1, 31)) * gelu_tanh(ga[j]); }
            *(u32x2*)(Y + (size_t)row * DM + head * 64 + 32 * mt + 8 * rq + 4 * hi) = pack4(y); }
    }
}
DI void sc_phase(const Args& a, int wave, int lane) {
    unsigned char* ws = a.ws;
    const bf16* U = (const bf16*)(ws + WS_R1);
    bf16* Y = (bf16*)(ws + WS_HB);
    const float* convB = a.in[19];
    const int gw = blockIdx.x * NWAVES + wave, NGW = gridDim.x * NWAVES;
    f32x4 w[3][2];
#pragma unroll
    for (int k = 0; k < 3; ++k) { w[k][0] = *(const f32x4*)(convB + k * DLRU + 8 * lane); w[k][1] = *(const f32x4*)(convB + k * DLRU + 8 * lane + 4); }
    for (int tile = gw; tile < MT / 8; tile += NGW) {
        const int row0 = tile * 8;
        const int seq0 = row0 < ML ? (row0 & ~(SEQ - 1)) : ML + ((row0 - ML) & ~(CTX - 1)), seqlen = row0 < ML ? SEQ : CTX;
        const bf16* up = U + (size_t)row0 * RCW + 8 * lane;
        u32x4 cgr[10], vr[10], bgr[8];
#pragma unroll
        for (int i = 0; i < 10; ++i) { const int r = row0 - 1 + i; const bool ok = (r >= seq0) && (r < seq0 + seqlen); const bf16* q = up + (ptrdiff_t)(ok ? i - 1 : 0) * RCW;
            cgr[i] = *(const u32x4*)(q + 3 * DLRU); vr[i] = *(const u32x4*)(q + 4 * DLRU); if (!ok) { cgr[i] = (u32x4){0u, 0u, 0u, 0u}; } }
#pragma unroll
        for (int i = 0; i < 8; ++i) bgr[i] = *(const u32x4*)(up + (size_t)i * RCW + 2 * DLRU);
        f32x4 p[10][2];
#pragma unroll
        for (int i = 0; i < 10; ++i) { p[i][0] = unpack4((u32x2){cgr[i].x, cgr[i].y}) * unpack4((u32x2){vr[i].x, vr[i].y}); p[i][1] = unpack4((u32x2){cgr[i].z, cgr[i].w}) * unpack4((u32x2){vr[i].z, vr[i].w}); }
#pragma unroll
        for (int i = 0; i < 8; ++i) {
            const f32x4 o0 = unpack4((u32x2){bgr[i].x, bgr[i].y}) * (w[0][0] * p[i][0] + w[1][0] * p[i + 1][0] + w[2][0] * p[i + 2][0]);
            const f32x4 o1 = unpack4((u32x2){bgr[i].z, bgr[i].w}) * (w[0][1] * p[i][1] + w[1][1] * p[i + 1][1] + w[2][1] * p[i + 2][1]);
            const u32x2 q0 = pack4(o0), q1 = pack4(o1);
            *(u32x4*)(Y + (size_t)(row0 + i) * DM + DLRU + 8 * lane) = (u32x4){q0.x, q0.y, q1.x, q1.y}; }
    }
}

constexpr int ATT_TB = 64 * 144;
DI int att_nt(int u) { const int q64 = (u >> 2) & 127; const int lo = q64 - 2 < 0 ? 0 : q64 - 2, hi = q64 + 2 > 127 ? 127 : q64 + 2; return hi - lo + 1 + 4; }
DI void att_load(const bf16* KV, int u, int t, int srow, int sch, u32x4& kreg, u32x4& vreg) {
    const int hk = u & 3, q64 = (u >> 2) & 127, b = u >> 9;
    const int kt_lo = q64 - 2 < 0 ? 0 : q64 - 2, kt_hi = q64 + 2 > 127 ? 127 : q64 + 2, nwin = kt_hi - kt_lo + 1;
    const int rowk = (t < nwin) ? (b * SEQ + (kt_lo + t) * 64 + srow) : (ML + b * CTX + (t - nwin) * 64 + srow);
    const bf16* kp = KV + (size_t)rowk * 512 + hk * 64 + sch * 8; kreg = *(const u32x4*)kp; vreg = *(const u32x4*)(kp + 256);
}
DI void att_store(LAS unsigned char* base, int srow, int sch, const u32x4& kreg, const u32x4& vreg) {
    *(LAS u32x4*)(base + srow * 144 + sch * 16) = kreg;
    LAS bf16* vt = (LAS bf16*)(base + ATT_TB + (sch * 8) * 144 + srow * 2);
    vt[0 * 72] = (bf16)(vreg.x & 0xffffu); vt[1 * 72] = (bf16)(vreg.x >> 16); vt[2 * 72] = (bf16)(vreg.y & 0xffffu); vt[3 * 72] = (bf16)(vreg.y >> 16);
    vt[4 * 72] = (bf16)(vreg.z & 0xffffu); vt[5 * 72] = (bf16)(vreg.z >> 16); vt[6 * 72] = (bf16)(vreg.w & 0xffffu); vt[7 * 72] = (bf16)(vreg.w >> 16);
}
DI void att_tile(const LAS unsigned char* kb_, const bf16x8 (&qr)[4], float& m, float& l, f32x16 (&o)[2], bool edge, int kt, int qrow, int r32, int hi) {
    const LAS unsigned char* vb_ = kb_ + ATT_TB;
    f32x16 p[2];
#pragma unroll
    for (int i = 0; i < 16; ++i) { p[0][i] = 0.f; p[1][i] = 0.f; }
#pragma unroll
    for (int sub = 0; sub < 2; ++sub)
#pragma unroll
        for (int d0 = 0; d0 < 4; ++d0) { const bf16x8 kf = *(const LAS bf16x8*)(kb_ + (32 * sub + r32) * 144 + (16 * d0 + 8 * hi) * 2);
            p[sub] = __builtin_amdgcn_mfma_f32_32x32x16_bf16(kf, qr[d0], p[sub], 0, 0, 0); }
    if (edge) {
#pragma unroll
        for (int sub = 0; sub < 2; ++sub)
#pragma unroll
            for (int r = 0; r < 16; ++r) { const int kpos = kt * 64 + 32 * sub + (r & 3) + 8 * (r >> 2) + 4 * hi; const int df = kpos - qrow;
                if (df > 128 || df < -128) p[sub][r] = -1e30f; }
    }
    float mx = p[0][0];
#pragma unroll
    for (int r = 1; r < 16; ++r) mx = fmaxf(mx, p[0][r]);
#pragma unroll
    for (int r = 0; r < 16; ++r) mx = fmaxf(mx, p[1][r]);
    mx = fmaxf(mx, __shfl_xor(mx, 32));
    const float mnew = fmaxf(m, mx), sc = __builtin_amdgcn_exp2f(m - mnew); m = mnew;
    float ls = 0.f;
#pragma unroll
    for (int sub = 0; sub < 2; ++sub)
#pragma unroll
        for (int r = 0; r < 16; ++r) { const float e = __builtin_amdgcn_exp2f(p[sub][r] - m); p[sub][r] = e; ls += e; }
    l = l * sc + ls;
#pragma unroll
    for (int i = 0; i < 16; ++i) { o[0][i] *= sc; o[1][i] *= sc; }
    bf16x8 pb[4];
#pragma unroll
    for (int ks = 0; ks < 4; ++ks) { const int sub = ks >> 1, r0 = 8 * (ks & 1);
        u32x4 w; w.x = pk2(p[sub][r0], p[sub][r0 + 1]); w.y = pk2(p[sub][r0 + 2], p[sub][r0 + 3]); w.z = pk2(p[sub][r0 + 4], p[sub][r0 + 5]); w.w = pk2(p[sub][r0 + 6], p[sub][r0 + 7]);
        pb[ks] = __builtin_bit_cast(bf16x8, w); }
#pragma unroll
    for (int dt = 0; dt < 2; ++dt)
#pragma unroll
        for (int ks = 0; ks < 4; ++ks) { const LAS unsigned char* vp = vb_ + (32 * dt + r32) * 144 + (16 * ks + 4 * hi) * 2;
            const u32x2 lo = *(const LAS u32x2*)vp, hi2 = *(const LAS u32x2*)(vp + 16);
            u32x4 w; w.x = lo.x; w.y = lo.y; w.z = hi2.x; w.w = hi2.y;
            o[dt] = __builtin_amdgcn_mfma_f32_32x32x16_bf16(__builtin_bit_cast(bf16x8, w), pb[ks], o[dt], 0, 0, 0); }
}
DI void attn_phase(const Args& a, LAS unsigned char* lds, int tid, int lane, int wave) {
    unsigned char* ws = a.ws;
    const bf16* Q = (const bf16*)(ws + WS_Q); const bf16* KV = (const bf16*)(ws + WS_KV);
    bf16* O = (bf16*)(ws + WS_O);
    const float* sink = a.in[22];
    const int r32 = lane & 31, hi = lane >> 5, srow = tid >> 3, sch = tid & 7;
    const int G = gridDim.x, NU = NB * 128 * 4;
    const int u0 = blockIdx.x;
    if (u0 >= NU) return;
    for (int ubase = u0; ubase < NU; ubase += 4 * G) {
        const int c1 = att_nt(ubase);
        const int c2 = c1 + ((ubase + G < NU) ? att_nt(ubase + G) : 0);
        const int c3 = c2 + ((ubase + 2 * G < NU) ? att_nt(ubase + 2 * G) : 0);
        const int T = c3 + ((ubase + 3 * G < NU) ? att_nt(ubase + 3 * G) : 0);
#define ATT_DECODE(g, uu, tt) do { const int i_ = ((g) >= c1) + ((g) >= c2) + ((g) >= c3); uu = ubase + i_ * G; tt = (g) - (i_ == 0 ? 0 : (i_ == 1 ? c1 : (i_ == 2 ? c2 : c3))); } while (0)
        u32x4 k0, v0, k1, v1;
        { att_load(KV, ubase, 0, srow, sch, k0, v0); if (T > 1) { int uu, tt; ATT_DECODE(1, uu, tt); att_load(KV, uu, tt, srow, sch, k1, v1); } }
        int cu = ubase, ct = 0, cnt = c1;
        bf16x8 qr[4], qn[4];
        float m, l; f32x16 o[2];
#define ATT_QLOAD(dst, uu) do { const int hk_ = (uu) & 3, q64_ = ((uu) >> 2) & 127, b_ = (uu) >> 9; const int head_ = hk_ * 4 + (wave >> 1), qrow_ = q64_ * 64 + (wave & 1) * 32 + r32; \
            _Pragma("unroll") for (int d0 = 0; d0 < 4; ++d0) dst[d0] = *(const bf16x8*)(Q + (size_t)(b_ * SEQ + qrow_) * DM + head_ * 64 + 16 * d0 + 8 * hi); } while (0)
#define ATT_INIT(uu) do { const int head_ = ((uu) & 3) * 4 + (wave >> 1); m = sink[head_] * LOG2E; l = (hi == 0) ? 1.f : 0.f; \
            _Pragma("unroll") for (int i = 0; i < 16; ++i) { o[0][i] = 0.f; o[1][i] = 0.f; } } while (0)
        ATT_QLOAD(qr, cu); ATT_INIT(cu);
        att_store(lds, srow, sch, k0, v0);
        __syncthreads();
#define ATT_ITER(f, KL, VL, KS, VS, CB, SB) do { \
            if ((f) + 2 < T) { int uu_, tt_; ATT_DECODE((f) + 2, uu_, tt_); att_load(KV, uu_, tt_, srow, sch, KL, VL); } \
            const bool last_ = (ct == cnt - 1); const bool more_ = last_ && ((f) + 1 < T); \
            if (more_) ATT_QLOAD(qn, cu + G); \
            { const int q64_ = (cu >> 2) & 127; const int kt_lo_ = q64_ - 2 < 0 ? 0 : q64_ - 2; const int nwin_ = cnt - 4; const int kt_ = kt_lo_ + ct; \
              const bool edge_ = (ct < nwin_) && (kt_ == q64_ - 2 || kt_ == q64_ + 2); \
              att_tile(lds + (CB) * 2 * ATT_TB, qr, m, l, o, edge_, kt_, q64_ * 64 + (wave & 1) * 32 + r32, r32, hi); } \
            if ((f) + 1 < T) att_store(lds + (SB) * 2 * ATT_TB, srow, sch, KS, VS); \
            __syncthreads(); \
            if (last_) { const int hk_ = cu & 3, q64_ = (cu >> 2) & 127, b_ = cu >> 9; const int head_ = hk_ * 4 + (wave >> 1), qrow_ = q64_ * 64 + (wave & 1) * 32 + r32; \
                const float lt_ = l + __shfl_xor(l, 32), inv_ = 1.0f / lt_; bf16* op_ = O + (size_t)(b_ * SEQ + qrow_) * DM + head_ * 64; \
                _Pragma("unroll") for (int dt = 0; dt < 2; ++dt) _Pragma("unroll") for (int rq = 0; rq < 4; ++rq) { \
                    f32x4 v_ = {o[dt][4 * rq] * inv_, o[dt][4 * rq + 1] * inv_, o[dt][4 * rq + 2] * inv_, o[dt][4 * rq + 3] * inv_}; *(u32x2*)(op_ + 32 * dt + 8 * rq + 4 * hi) = pack4(v_); } \
                if (more_) { cu += G; ct = 0; cnt = att_nt(cu); _Pragma("unroll") for (int d0 = 0; d0 < 4; ++d0) qr[d0] = qn[d0]; ATT_INIT(cu); } } \
            else { ++ct; } } while (0)
        for (int f = 0; f < T; f += 2) {
            ATT_ITER(f, k0, v0, k1, v1, 0, 1);
            if (f + 1 < T) ATT_ITER(f + 1, k1, v1, k0, v0, 1, 0);
        }
#undef ATT_ITER
#undef ATT_QLOAD
#undef ATT_INIT
#undef ATT_DECODE
    }
}

#define XB_TMO      128
#define XB_XCNT(j)  (256  + 64 * (j))
#define XB_XSUB(j)  (1280 + 64 * (j))
#define XB_XGEN(j)  (2304 + 64 * (j))
#define XB_TOP      3328
#define XB_TOPGEN   3392
#define XCD_BAR_WORDS 3456
#define XB_SPIN_CAP (1u << 18)

__device__ __forceinline__ unsigned xb_ld(unsigned* p)              { return __hip_atomic_load(p, __ATOMIC_RELAXED, __HIP_MEMORY_SCOPE_AGENT); }
__device__ __forceinline__ unsigned xb_add(unsigned* p, unsigned v) { return __hip_atomic_fetch_add(p, v, __ATOMIC_RELAXED, __HIP_MEMORY_SCOPE_AGENT); }
__device__ __forceinline__ unsigned xb_xcc_id() { return (unsigned)__builtin_amdgcn_s_getreg((3 << 11) | 20) & 0xFu; }
#define XB_SPIN(cond, bar) do { unsigned _sp = 0; while (cond) { __builtin_amdgcn_s_sleep(1); \
    if ((++_sp & 255u) == 0u) { if (xb_ld(&(bar)[XB_TMO])) break; if (_sp > XB_SPIN_CAP) { atomicAdd(&(bar)[XB_TMO], 1u); break; } } } } while (0)

struct XcdBarrier {
    unsigned* bar; unsigned x;
    volatile LAS unsigned* st;
};

__device__ __forceinline__ XcdBarrier xcd_barrier_post(unsigned* bar, volatile LAS unsigned* st) {
    XcdBarrier b; b.bar = bar; b.x = xb_xcc_id(); b.st = st;
    if (threadIdx.x == 0) (void)xb_add(&bar[XB_XCNT(b.x)], 1u);
    return b;
}
__device__ __forceinline__ void xcd_barrier_complete(unsigned* bar, unsigned x, unsigned& nloc, unsigned& nx) {
    const unsigned G = gridDim.x * gridDim.y * gridDim.z;
    unsigned sum, cnt, mine, sp = 0u;
    for (;;) {
        sum = 0u; cnt = 0u; mine = 0u;
#pragma unroll
        for (unsigned j = 0; j < 16; ++j) { const unsigned c = xb_ld(&bar[XB_XCNT(j)]); sum += c; cnt += (c > 0u) ? 1u : 0u; mine = (j == x) ? c : mine; }
        if (sum == G) break;
        __builtin_amdgcn_s_sleep(1);
        if ((++sp & 255u) == 0u) { if (xb_ld(&bar[XB_TMO])) break; if (sp > XB_SPIN_CAP) { atomicAdd(&bar[XB_TMO], 1u); break; } }
    }
    nloc = mine > 0u ? mine : 1u; nx = cnt > 0u ? cnt : 1u;
}

__device__ __forceinline__ void xcd_barrier(const XcdBarrier& b) {
    asm volatile("s_waitcnt vmcnt(0)" ::: "memory");
    __syncthreads();
    if (threadIdx.x == 0) {
        unsigned* bar = b.bar;
        __builtin_amdgcn_s_waitcnt(0);
        unsigned nloc = b.st[0], nx = b.st[1];
        if (nloc == 0u) { xcd_barrier_complete(bar, b.x, nloc, nx); b.st[0] = nloc; b.st[1] = nx; }
        const unsigned old = xb_add(&bar[XB_XSUB(b.x)], 1u);
        const unsigned gen = old / nloc;
        if (old + 1u == (gen + 1u) * nloc) {
            __builtin_amdgcn_fence(__ATOMIC_RELEASE, "agent");
            asm volatile("s_waitcnt vmcnt(0)" ::: "memory");
            const unsigned og = xb_add(&bar[XB_TOP], 1u);
            const unsigned tg = og / nx;
            if (og + 1u == (tg + 1u) * nx) xb_add(&bar[XB_TOPGEN], 1u);
            else XB_SPIN(xb_ld(&bar[XB_TOPGEN]) == tg, bar);
            __builtin_amdgcn_fence(__ATOMIC_ACQUIRE, "agent");
            xb_add(&bar[XB_XGEN(b.x)], 1u);
            asm volatile("s_waitcnt vmcnt(0)" ::: "memory");
        } else {
            XB_SPIN(xb_ld(&bar[XB_XGEN(b.x)]) == gen, bar);
            __builtin_amdgcn_fence(__ATOMIC_ACQUIRE, "agent");
            asm volatile("s_waitcnt vmcnt(0)" ::: "memory");
        }
    }
    __syncthreads();
}

DI void static_unit(int L, int nM, int nN, pg8::Unit& u) {
    const int nwg = nM * nN; int wgid = L; { const int q = nwg / pg8::NXCD, r = nwg % pg8::NXCD, xcd = wgid % pg8::NXCD, off = wgid / pg8::NXCD; wgid = (xcd < r ? xcd * (q + 1) : r * (q + 1) + (xcd - r) * q) + off; }
    const int nig = pg8::WGM * nN, gid = wgid / nig, fm = gid * pg8::WGM, gsz = (nM - fm) < pg8::WGM ? (nM - fm) : pg8::WGM;
    u.pm = fm + ((wgid % nig) % gsz); u.pn = (wgid % nig) / gsz;
}
constexpr int FIN_NN = 2 * DFF / 256, FIN_CTX_UNITS = 2 * FIN_NN, FIN_LAT_UNITS = 64 * FIN_NN;
struct CtxFirstOrder {
    int G, c, lane; unsigned* cnt;
    DI bool next(int i, pg8::Unit& u) const {
        const int L = i * G + c; if (L >= FIN_CTX_UNITS + FIN_LAT_UNITS) return false;
        if (L < FIN_CTX_UNITS) { u.pm = 64 + L / FIN_NN; u.pn = L % FIN_NN; } else static_unit(L - FIN_CTX_UNITS, 64, FIN_NN, u);
        return true;
    }
    DI void a_ready(const pg8::Unit&) const {}
    DI void done(const pg8::Unit& u) const { if (u.pm >= 64) { __threadfence(); if (lane == 0) __hip_atomic_fetch_add(cnt, 1u, __ATOMIC_RELAXED, __HIP_MEMORY_SCOPE_AGENT); } }
};
struct OneUnit {
    int pm, pn;
    DI bool next(int i, pg8::Unit& u) const { if (i) return false; u.pm = pm; u.pn = pn; return true; }
    DI void a_ready(const pg8::Unit&) const {}
    DI void done(const pg8::Unit&) const {}
};
struct EpiPartial {
    static constexpr bool PERM = false, AFTER_DRAIN = false;
    float* P;
    DI void operator()(const f32x4 (&acc)[2][2][4][2], const pg8::Unit& u, int wr, int wc, int fr, int fq) const {
        const int col0 = u.pn * 256 + wc * 32 + 4 * fq;
#pragma unroll
        for (int ai = 0; ai < 2; ++ai)
#pragma unroll
            for (int m = 0; m < 4; ++m) { float* op = P + (size_t)(u.pm * 256 + ai * 128 + wr * 64 + m * 16 + fr) * DM + col0;
#pragma unroll
                for (int bj = 0; bj < 2; ++bj)
#pragma unroll
                    for (int n = 0; n < 2; ++n) *(f32x4*)(op + bj * 128 + n * 16) = acc[ai][bj][m][n]; }
    }
};
DI void ctx_ffn_finish(const Args& a, int wave, int lane) {
    unsigned char* ws = a.ws;
    const int rc = blockIdx.x * NWAVES + wave;
    if (rc >= MC || blockIdx.x * NWAVES >= MC + NWAVES) return;
    const float* P = (const float*)(ws + WS_PART) + (size_t)rc * DM; float* X = (float*)(ws + WS_X) + (size_t)(ML + rc) * DM;
    const float* gate = (const float*)(ws + WS_MOD) + (size_t)2 * 6144 + 5 * 1024; const float* gm = (const float*)(ws + WS_GM) + 3072 + 2 * 1024;
    bf16* hb = (bf16*)(ws + WS_HB) + (size_t)(ML + rc) * DM; float* ssp = (float*)(ws + WS_SSP) + (size_t)(ML + rc) * 16;
    float ss = 0.f;
#pragma unroll
    for (int j = 0; j < 4; ++j) { const int c = 4 * (lane + 64 * j);
        const f32x4 p0 = *(const f32x4*)(P + c), p1 = *(const f32x4*)(P + (size_t)MC * DM + c), p2 = *(const f32x4*)(P + (size_t)2 * MC * DM + c), p3 = *(const f32x4*)(P + (size_t)3 * MC * DM + c);
        const f32x4 xn = *(const f32x4*)(X + c) + *(const f32x4*)(gate + c) * (((p0 + p1) + p2) + p3);
        *(f32x4*)(X + c) = xn; ss += (xn[0] * xn[0] + xn[1] * xn[1]) + (xn[2] * xn[2] + xn[3] * xn[3]);
        *(u32x2*)(hb + c) = pack4(xn * *(const f32x4*)(gm + c)); }
    ss = wave_sum(ss);
    if (lane < 16) ssp[lane] = lane == 0 ? ss : 0.f;
}

constexpr int N_PHASES = 18;
__global__ void __launch_bounds__(NWAVES * 64, 2) fwd_kernel(Args a) {
    extern __shared__ __attribute__((aligned(16))) unsigned char lds_raw[];
    LAS unsigned char* lds = (LAS unsigned char*)lds_raw;
    cg::grid_group grid = cg::this_grid();
    const int tid = threadIdx.x, lane = tid & 63, wave = __builtin_amdgcn_readfirstlane(tid >> 6);
    unsigned char* ws = a.ws;
    const int lo = a.ph_lo, hi = a.ph_hi, G = gridDim.x, bx = blockIdx.x;
#ifndef PHASE_MASK
#define PHASE_MASK 0x3ffff
#endif
#define IN(k) (((PHASE_MASK >> (k)) & 1) && lo <= (k) && (k) < hi)
    {
        if (tid < 64) ((LAS unsigned*)(lds + 131072))[tid] = 0u;
        __syncthreads();
    }
    XcdBarrier bar = xcd_barrier_post((unsigned*)(ws + WS_CTL), (volatile LAS unsigned*)(lds + 131072 + 64));
    if (a.ph_lo < 0) grid.sync();
#define GSYNC() xcd_barrier(bar)
#define SEAM(k) do { if (IN(k) && (k) + 1 < hi) GSYNC(); } while (0)
#ifndef RPT_MASK
#define RPT_MASK 0
#endif
#ifndef RPT_N
#define RPT_N 1
#endif
#ifndef EXTRA_SYNCS
#define EXTRA_SYNCS 0
#endif
#define PHASE(k, ...) do { if (IN(k)) { __VA_ARGS__; if ((RPT_MASK >> (k)) & 1) { for (int rp_ = 0; rp_ < RPT_N; ++rp_) { GSYNC(); __VA_ARGS__; } } } SEAM(k); } while (0)
    bf16* HB = (bf16*)(ws + WS_HB); float* X = (float*)(ws + WS_X);
    bf16* U = (bf16*)(ws + WS_R1); bf16* FH = (bf16*)(ws + WS_R1);
    const float* MOD = (const float*)(ws + WS_MOD); const float* GM = (const float*)(ws + WS_GM); const float* BV = (const float*)(ws + WS_BV); float* SSP = (float*)(ws + WS_SSP);
    const float* xin = a.in[0]; const float* ctxin = a.in[2];

    PHASE(0, prologue(a, lds, tid, lane, wave););
    PHASE(1, norm_mod_phase(xin, ctxin, MT, a.in[6], MOD, 0, 1, HB, wave, lane); aux_phase(a, tid, wave, lane););
    PHASE(2, pg8::Gemm g{HB, (const bf16*)(ws + WS_WRCIN), MT, RCW, DM}; pg8::StaticOrder S; S.init(MT, RCW, G, bx);
        EpiStore E{U, RCW}; pg8::gemm_phase<EpiStore, pg8::StaticOrder, true, true>(lds, g, S, E););
    PHASE(3, rg1_phase(a, lds, tid, lane, wave););
    PHASE(4, rg_carry_phase(a, lds, wave, lane); sc_phase(a, wave, lane););
    PHASE(5, rg3_phase(a, wave, lane););
    PHASE(6, pg8::Gemm g{HB, (const bf16*)(ws + WS_WRCOUT), MT, DM, DM}; pg8::StaticOrder S; S.init(MT, DM, G, bx);
        EpiResid E{xin, ctxin, X, MOD + 2 * 1024, (bf16*)a.out, GM, SSP}; pg8::gemm_phase<EpiResid, pg8::StaticOrder, true, true>(lds, g, S, E););
    PHASE(8, pg8::Gemm g{(const bf16*)a.out, (const bf16*)(ws + WS_WFIN0), MT, 2 * DFF, DM, 0}; CtxFirstOrder S{G, bx, lane, (unsigned*)(ws + WS_CTL) + CTL_CTXCNT};
        rstd_table(lds, SSP, S, tid); EpiSwiGLU E{FH, DFF, lds, BV}; pg8::gemm_phase<EpiSwiGLU, CtxFirstOrder, true, true>(lds, g, S, E);
        {
            const int nfull = (FIN_CTX_UNITS + FIN_LAT_UNITS) % G, su = bx - nfull;
            if (nfull != 0 && G - nfull >= 32 && su >= 0 && su < 32) {
                if (tid == 0) { unsigned* cnt = (unsigned*)(ws + WS_CTL) + CTL_CTXCNT; unsigned sp = 0;
                    while (__hip_atomic_load(cnt, __ATOMIC_RELAXED, __HIP_MEMORY_SCOPE_AGENT) < 8u * FIN_CTX_UNITS) { __builtin_amdgcn_s_sleep(2); if (++sp > (1u << 22)) break; }
                    __builtin_amdgcn_fence(__ATOMIC_ACQUIRE, "agent"); asm volatile("s_waitcnt vmcnt(0)" ::: "memory"); }
                __syncthreads();
                const int sl = su & 3, cu_ = su >> 2, k0 = sl < 2 ? sl * 768 : 1536 + (sl - 2) * 640, klen = sl < 2 ? 768 : 640;
                pg8::Gemm g2{FH + (size_t)ML * DFF + k0, (const bf16*)(ws + WS_WFOUT0) + k0, MC, DM, klen, DFF}; OneUnit S2{cu_ >> 2, cu_ & 3};
                EpiPartial E2{(float*)(ws + WS_PART) + (size_t)sl * MC * DM}; pg8::gemm_phase<EpiPartial, OneUnit, true, true>(lds, g2, S2, E2);
            }
        });
    PHASE(9, const int nfull9 = (FIN_CTX_UNITS + FIN_LAT_UNITS) % G; const bool split9 = nfull9 != 0 && G - nfull9 >= 32;
        if (split9) { ctx_ffn_finish(a, wave, lane);
            pg8::Gemm g{FH, (const bf16*)(ws + WS_WFOUT0), ML, DM, DFF, 0}; pg8::StaticOrder S; S.init(ML, DM, G, bx);
            EpiResid E{X, X + (size_t)ML * DM, X, MOD + 5 * 1024, HB, GM + 3072, SSP}; pg8::gemm_phase<EpiResid, pg8::StaticOrder, true, true>(lds, g, S, E); }
        else { pg8::Gemm g{FH, (const bf16*)(ws + WS_WFOUT0), MT, DM, DFF, 0}; pg8::StaticOrder S; S.init(MT, DM, G, bx);
            EpiResid E{X, X + (size_t)ML * DM, X, MOD + 5 * 1024, HB, GM + 3072, SSP}; pg8::gemm_phase<EpiResid, pg8::StaticOrder, true, true>(lds, g, S, E); });
    const float* MOD1 = MOD + 3 * 6144;
    PHASE(11, pg8::Gemm g{HB, (const bf16*)(ws + WS_WQKV), MT, NQKV, DM}; pg8::StaticOrder S; S.init(MT, NQKV, G, bx);
        EpiQKV E{(bf16*)(ws + WS_Q), (bf16*)(ws + WS_KV), (const float*)(ws + WS_ROPEC), (const float*)(ws + WS_ROPES), lds, BV + 3 * 2 * DFF}; rstd_table(lds, SSP, S, tid);
        pg8::gemm_phase<EpiQKV, pg8::StaticOrder, true, true>(lds, g, S, E););
    PHASE(12, attn_phase(a, lds, tid, lane, wave););
    PHASE(13, pg8::Gemm g{(const bf16*)(ws + WS_O), (const bf16*)(ws + WS_WAOUT), ML, DM, DM}; pg8::StaticOrder S; S.init(ML, DM, G, bx);
        EpiResid E{X, X + (size_t)ML * DM, X, MOD1 + 2 * 1024, HB, GM + 2 * 3072, SSP}; pg8::gemm_phase<EpiResid, pg8::StaticOrder, true, true>(lds, g, S, E););
    PHASE(15, pg8::Gemm g{HB, (const bf16*)(ws + WS_WFIN1), ML, 2 * DFF, DM}; pg8::StaticOrder S; S.init(ML, 2 * DFF, G, bx);
        rstd_table(lds, SSP, S, tid); EpiSwiGLU E{FH, DFF, lds, BV + 2 * 3 * 2 * DFF}; pg8::gemm_phase<EpiSwiGLU, pg8::StaticOrder, true, true>(lds, g, S, E););
    PHASE(16, pg8::Gemm g{FH, (const bf16*)(ws + WS_WFOUT1), ML, DM, DFF}; pg8::StaticOrder S; S.init(ML, DM, G, bx);
        EpiResid E{X, X + (size_t)ML * DM, X, MOD1 + 5 * 1024, nullptr, nullptr, nullptr}; pg8::gemm_phase<EpiResid, pg8::StaticOrder, true, true>(lds, g, S, E););
    PHASE(17, final_norm_phase(X, a.in[8], a.out, wave, lane););
    for (int es_ = 0; es_ < EXTRA_SYNCS; ++es_) GSYNC();
#undef IN
#undef SEAM
}

#ifndef MK_MULTI
#define MK_MULTI 0
#endif
extern "C" void kernel_launch(void* const* d_in, const int* in_sizes, int n_in, void* d_out, int out_size, void* d_ws, size_t ws_size, hipStream_t stream) {
    static int grid = 0;
    if (grid == 0) {
        if (n_in != 24 || out_size != ML * DM || ws_size < WS_END) { fprintf(stderr, "kernel_launch: unexpected shapes n_in %d out %d ws %zu\n", n_in, out_size, ws_size); grid = -1; return; }
        int dev = 0, cus = 0, per_cu = 0;
        hipGetDevice(&dev); hipDeviceGetAttribute(&cus, hipDeviceAttributeMultiprocessorCount, dev);
        if (hipFuncSetAttribute((const void*)fwd_kernel, hipFuncAttributeMaxDynamicSharedMemorySize, LDS_BYTES) != hipSuccess) { fprintf(stderr, "kernel_launch: hipFuncSetAttribute failed\n"); grid = -1; return; }
        if (hipOccupancyMaxActiveBlocksPerMultiprocessor(&per_cu, (const void*)fwd_kernel, NWAVES * 64, LDS_BYTES) != hipSuccess || per_cu < 1) { fprintf(stderr, "kernel_launch: occupancy query says %d\n", per_cu); per_cu = 1; }
        (void)hipGetLastError();
        grid = cus * 1;
    }
    if (grid < 0) return;
    Args a{};
    for (int i = 0; i < 24; ++i) a.in[i] = (const float*)d_in[i];
    a.out = (float*)d_out; a.ws = (unsigned char*)d_ws;
#if MK_MULTI
    for (int p = 0; p < N_PHASES; ++p) { a.ph_lo = p; a.ph_hi = p + 1; hipLaunchKernelGGL(fwd_kernel, dim3(grid), dim3(NWAVES * 64), LDS_BYTES, stream, a); }
#else
    a.ph_lo = 0; a.ph_hi = N_PHASES;
    if (hipMemsetAsync((char*)d_ws + WS_CTL, 0, CTL_BYTES, stream) != hipSuccess) { fprintf(stderr, "kernel_launch: memset failed\n"); return; }
    void* args[] = {&a};
    hipError_t e = hipLaunchCooperativeKernel((const void*)fwd_kernel, dim3(grid), dim3(NWAVES * 64), args, LDS_BYTES, stream);
    if (e != hipSuccess) fprintf(stderr, "kernel_launch: cooperative launch failed: %s (grid %d)\n", hipGetErrorString(e), grid);
#endif
}
```

```cpp
#include <hip/hip_runtime.h>
#include <hip/hip_cooperative_groups.h>
#include <cstdio>
#include <cstdint>
namespace cg = cooperative_groups;
namespace pg8 {
#define PG8_LAS __attribute__((address_space(3)))
typedef unsigned short bf16_t;
typedef short bf16x8 __attribute__((ext_vector_type(8)));
typedef float f32x4 __attribute__((ext_vector_type(4)));
typedef unsigned u32x4 __attribute__((ext_vector_type(4)));
constexpr int BM = 256, BK = 64, HALF = 128, HTB = HALF * BK * 2  , STAGE_BYTES = 8 * HTB, NXCD = 8, WGM = 8;

__host__ __device__ __forceinline__ int lds_byte(int r, int c) { const int st = (r >> 4) * 2 + (c >> 5), rr = r & 15, cc = c & 31, ob = rr * 64 + cc * 2; return st * 1024 + (ob ^ (((ob >> 9) & 1) << 5)); }
__host__ __device__ __forceinline__ void stage_rc(int b, int& R, int& C) { const int st = b / 1024, sb = b % 1024, swz = sb ^ (((sb >> 9) & 1) << 5); R = (st >> 1) * 16 + swz / 64; C = (st & 1) * 32 + (swz % 64) / 2; }
__host__ __device__ __forceinline__ int perm32(int rho) { const int n = rho >> 4, i = rho & 15; return 8 * (i >> 2) + 4 * n + (i & 3); }

struct Unit { int pm, pn, ord; };
struct Gemm { const bf16_t* A; const bf16_t* Bt; int M, N, K, ld; };

struct StaticOrder {
    int nM, nN, nwg, G, c;
    __host__ __device__ void init(int M, int N, int G_, int c_) { nM = M / BM; nN = N / BM; nwg = nM * nN; G = G_; c = c_; }
    __host__ __device__ bool next(int i, Unit& u) const {
        const long L = (long)i * G + c; if (L >= nwg) return false;
        int wgid = (int)L; { const int q = nwg / NXCD, r = nwg % NXCD, xcd = wgid % NXCD, off = wgid / NXCD; wgid = (xcd < r ? xcd * (q + 1) : r * (q + 1) + (xcd - r) * q) + off; }
        const int nig = WGM * nN, gid = wgid / nig, fm = gid * WGM, gsz = (nM - fm) < WGM ? (nM - fm) : WGM;
        u.pm = fm + ((wgid % nig) % gsz); u.pn = (wgid % nig) / gsz; return true;
    }
    __device__ __forceinline__ void a_ready(const Unit&) const {}
    __device__ __forceinline__ void done(const Unit&) const {}
};
template <class Epi, class Sched, bool ALIGN_EPI = false, bool SP2 = false>
__device__ __forceinline__ void gemm_phase(PG8_LAS unsigned char* lds, const Gemm g, const Sched& S, const Epi& E) {
    const int tid = threadIdx.x, wid = __builtin_amdgcn_readfirstlane(tid >> 6), lane = tid & 63, wr = wid >> 2, wc = wid & 3, fr = lane & 15, fq = lane >> 4;
    const int nt = g.K / BK, K = g.ld ? g.ld : g.K;
    unsigned voffA[2], voffB[2];
#pragma unroll
    for (int i = 0; i < 2; ++i) { int R, C; stage_rc(tid * 16 + i * 8192, R, C); const int Rb = Epi::PERM ? ((R & ~31) + perm32(R & 31)) : R;
        voffA[i] = (unsigned)(R * K + C) * 2u; voffB[i] = (unsigned)(Rb * K + C) * 2u; }
    const size_t kstep = (size_t)(BK * 2);
    const size_t hstep = (size_t)HALF * K * 2;
    const size_t tstep = 2 * hstep;
    const unsigned ldsw = (unsigned)wid * 1024u;
    const int aoff = lds_byte(wr * 64 + fr, fq * 8), boff = lds_byte(wc * 32 + fr, fq * 8);
#define PG8_SA(b, h) (((b) * 2 + (h)) * HTB)
#define PG8_SB(b, h) ((4 + (b) * 2 + (h)) * HTB)
#define PG8_STAGE(bufoff, gbase, voff) do { _Pragma("unroll") for (int _i = 0; _i < 2; ++_i) \
        __builtin_amdgcn_global_load_lds((const unsigned*)((const char*)(gbase) + (voff)[_i]), (PG8_LAS unsigned*)(lds + (bufoff) + ldsw + _i * 8192), 16, 0, 0); } while (0)
#define PG8_LDA(dst, b, h) do { _Pragma("unroll") for (int m = 0; m < 4; ++m) _Pragma("unroll") for (int k = 0; k < 2; ++k) dst[m][k] = *(const PG8_LAS bf16x8*)(lds + PG8_SA(b, h) + aoff + m * 2048 + k * 1024); } while (0)
#define PG8_LDB(dst, b, h) do { _Pragma("unroll") for (int n = 0; n < 2; ++n) _Pragma("unroll") for (int k = 0; k < 2; ++k) dst[n][k] = *(const PG8_LAS bf16x8*)(lds + PG8_SB(b, h) + boff + n * 2048 + k * 1024); } while (0)
#define PG8_MMA(ai, bj, At, Bt) do { __builtin_amdgcn_s_setprio(1); _Pragma("unroll") for (int m = 0; m < 4; ++m) _Pragma("unroll") for (int n = 0; n < 2; ++n) _Pragma("unroll") for (int k = 0; k < 2; ++k) \
        acc[ai][bj][m][n] = __builtin_amdgcn_mfma_f32_16x16x32_bf16(Bt[n][k], At[m][k], acc[ai][bj][m][n], 0, 0, 0); __builtin_amdgcn_s_setprio(0); } while (0)
#define PG8_WAIT_V(n) asm volatile("s_waitcnt vmcnt(" #n ")" ::: "memory")
#define PG8_WAIT_L(n) asm volatile("s_waitcnt lgkmcnt(" #n ")" ::: "memory")
#define PG8_BAR __builtin_amdgcn_s_barrier()
#define PG8_SCHED __builtin_amdgcn_sched_barrier(0)
    Unit cur, nxt; int ui = 0;
    if (!S.next(0, cur)) return; cur.ord = 0;
    f32x4 acc[2][2][4][2];
#pragma unroll
    for (int a = 0; a < 2; ++a)
#pragma unroll
        for (int b = 0; b < 2; ++b)
#pragma unroll
            for (int m = 0; m < 4; ++m)
#pragma unroll
                for (int n = 0; n < 2; ++n) acc[a][b][m][n] = (f32x4){0.f, 0.f, 0.f, 0.f};
    bf16x8 At[4][2], B0[2][2], B1[2][2];
    const char* cA = (const char*)g.A + (size_t)cur.pm * tstep; const char* cB = (const char*)g.Bt + (size_t)cur.pn * tstep;
    S.a_ready(cur);
    if constexpr (SP2) {
        PG8_STAGE(PG8_SB(0, 0), cB, voffB); PG8_STAGE(PG8_SB(0, 1), cB + hstep, voffB); PG8_STAGE(PG8_SA(0, 0), cA, voffA); PG8_STAGE(PG8_SA(0, 1), cA + hstep, voffA);
        if (wr == 1) PG8_BAR;
        PG8_WAIT_V(2); PG8_BAR;
        PG8_STAGE(PG8_SB(1, 0), cB + kstep, voffB); PG8_STAGE(PG8_SA(1, 0), cA + kstep, voffA); PG8_STAGE(PG8_SB(1, 1), cB + hstep + kstep, voffB);
        PG8_WAIT_V(6); PG8_BAR;
    } else {
        PG8_STAGE(PG8_SB(0, 0), cB, voffB); PG8_STAGE(PG8_SA(0, 0), cA, voffA); PG8_STAGE(PG8_SB(0, 1), cB + hstep, voffB); PG8_STAGE(PG8_SA(0, 1), cA + hstep, voffA);
        if (wr == 1) PG8_BAR;
        PG8_WAIT_V(4); PG8_BAR;
        PG8_STAGE(PG8_SB(1, 0), cB + kstep, voffB); PG8_STAGE(PG8_SA(1, 0), cA + kstep, voffA); PG8_STAGE(PG8_SB(1, 1), cB + hstep + kstep, voffB);
        PG8_WAIT_V(6); PG8_BAR;
    }
    for (;;) {
        const bool has_next = S.next(ui + 1, nxt); nxt.ord = ui + 1;
        const char* nA = has_next ? (const char*)g.A + (size_t)nxt.pm * tstep : cA; const char* nB = has_next ? (const char*)g.Bt + (size_t)nxt.pn * tstep : cB;
        for (int t = 0; t < nt; t += 2) {
            const bool last = (t == nt - 2);
            const char* a1 = cA + (size_t)(t + 1) * kstep;
            const char* a2 = last ? nA : cA + (size_t)(t + 2) * kstep; const char* b2 = last ? nB : cB + (size_t)(t + 2) * kstep;
            const char* a3 = a2 + kstep; const char* b3 = b2 + kstep;
            if (last && has_next) S.a_ready(nxt);
            if constexpr (SP2) {
            PG8_LDB(B0, 0, 0); PG8_LDB(B1, 0, 1); PG8_SCHED; PG8_LDA(At, 0, 0); PG8_STAGE(PG8_SA(1, 1), a1 + hstep, voffA);
            PG8_WAIT_V(8); PG8_WAIT_L(0); PG8_BAR; PG8_MMA(0, 0, At, B0); PG8_MMA(0, 1, At, B1); PG8_BAR; PG8_SCHED;
            PG8_LDA(At, 0, 1); PG8_STAGE(PG8_SB(0, 0), b2, voffB); PG8_STAGE(PG8_SB(0, 1), b2 + hstep, voffB); PG8_STAGE(PG8_SA(0, 0), a2, voffA);
            PG8_WAIT_V(8); PG8_WAIT_L(0); PG8_BAR; PG8_MMA(1, 0, At, B0); PG8_MMA(1, 1, At, B1); PG8_BAR; PG8_SCHED;
            PG8_LDB(B0, 1, 0); PG8_LDB(B1, 1, 1); PG8_SCHED; PG8_LDA(At, 1, 0); PG8_STAGE(PG8_SA(0, 1), a2 + hstep, voffA);
            PG8_WAIT_V(8); PG8_WAIT_L(0); PG8_BAR; PG8_MMA(0, 0, At, B0); PG8_MMA(0, 1, At, B1); PG8_BAR; PG8_SCHED;
            PG8_LDA(At, 1, 1); PG8_STAGE(PG8_SB(1, 0), b3, voffB); PG8_STAGE(PG8_SB(1, 1), b3 + hstep, voffB); PG8_STAGE(PG8_SA(1, 0), a3, voffA);
            PG8_WAIT_V(8); PG8_WAIT_L(0); PG8_BAR; PG8_MMA(1, 0, At, B0); PG8_MMA(1, 1, At, B1); PG8_BAR; PG8_SCHED;
            } else {
            PG8_LDB(B0, 0, 0); PG8_SCHED; PG8_LDA(At, 0, 0); PG8_STAGE(PG8_SA(1, 1), a1 + hstep, voffA);
            PG8_WAIT_L(8); PG8_BAR; PG8_WAIT_L(0); PG8_MMA(0, 0, At, B0); PG8_BAR; PG8_SCHED;
            PG8_LDB(B1, 0, 1); PG8_STAGE(PG8_SB(0, 0), b2, voffB);
            PG8_BAR; PG8_WAIT_L(0); PG8_MMA(0, 1, At, B1); PG8_BAR;
            PG8_LDA(At, 0, 1); PG8_STAGE(PG8_SA(0, 0), a2, voffA);
            PG8_BAR; PG8_WAIT_L(0); PG8_MMA(1, 0, At, B0); PG8_BAR; PG8_SCHED;
            PG8_STAGE(PG8_SB(0, 1), b2 + hstep, voffB);
            PG8_WAIT_V(6); PG8_BAR; PG8_MMA(1, 1, At, B1); PG8_BAR;
            PG8_LDB(B0, 1, 0); PG8_SCHED; PG8_LDA(At, 1, 0); PG8_STAGE(PG8_SA(0, 1), a2 + hstep, voffA);
            PG8_WAIT_L(8); PG8_BAR; PG8_WAIT_L(0); PG8_MMA(0, 0, At, B0); PG8_BAR; PG8_SCHED;
            PG8_LDB(B1, 1, 1); PG8_STAGE(PG8_SB(1, 0), b3, voffB);
            PG8_BAR; PG8_WAIT_L(0); PG8_MMA(0, 1, At, B1); PG8_BAR;
            PG8_LDA(At, 1, 1); PG8_STAGE(PG8_SA(1, 0), a3, voffA);
            PG8_BAR; PG8_WAIT_L(0); PG8_MMA(1, 0, At, B0); PG8_BAR; PG8_SCHED;
            PG8_STAGE(PG8_SB(1, 1), b3 + hstep, voffB);
            PG8_WAIT_V(6); PG8_BAR; PG8_MMA(1, 1, At, B1); PG8_BAR;
            }
        }
        if constexpr (ALIGN_EPI) { if (wr == 0) PG8_BAR; }
        if constexpr (!Epi::AFTER_DRAIN) { E(acc, cur, wr, wc, fr, fq); S.done(cur); }
        if (!has_next) break;
#pragma unroll
        for (int a = 0; a < 2; ++a)
#pragma unroll
            for (int b = 0; b < 2; ++b)
#pragma unroll
                for (int m = 0; m < 4; ++m)
#pragma unroll
                    for (int n = 0; n < 2; ++n) acc[a][b][m][n] = (f32x4){0.f, 0.f, 0.f, 0.f};
        cur = nxt; cA = nA; cB = nB; ++ui;
        if constexpr (ALIGN_EPI) { if (wr == 1) PG8_BAR; }
    }
    PG8_WAIT_V(0);
    if constexpr (!ALIGN_EPI) { if (wr == 0) PG8_BAR; }
    PG8_BAR;
    if constexpr (Epi::AFTER_DRAIN) { E.fused(acc, cur, wr, wc, fr, fq, lds, wid, lane); S.done(cur); }
#undef PG8_SA
#undef PG8_SB
#undef PG8_STAGE
#undef PG8_LDA
#undef PG8_LDB
#undef PG8_MMA
#undef PG8_WAIT_V
#undef PG8_WAIT_L
#undef PG8_BAR
#undef PG8_SCHED
}
}

#define DI __device__ __forceinline__
#define LAS __attribute__((address_space(3)))
typedef unsigned short bf16;
typedef pg8::f32x4 f32x4;
typedef pg8::bf16x8 bf16x8;
typedef pg8::u32x4 u32x4;
typedef unsigned u32x2 __attribute__((ext_vector_type(2)));
typedef float f32x16 __attribute__((ext_vector_type(16)));
typedef float f32x2_t __attribute__((ext_vector_type(2)));
typedef __bf16 bf16x2_t __attribute__((ext_vector_type(2)));

constexpr int DM = 1024, NB = 2, SEQ = 8192, CTX = 256;
constexpr int ML = NB * SEQ, MC = NB * CTX, MT = ML + MC;
constexpr int DFF = 2816, RCW = 2560, NQKV = 1536, DLRU = 512;
constexpr int NCH = 264;
constexpr int NWAVES = 8;
constexpr float LOG2E = 1.4426950408889634f;
constexpr float QSCALE = 0.125f * LOG2E;

constexpr size_t MiB = 1u << 20;
constexpr size_t WS_WRCIN = 0, WS_WRCOUT = 5 * MiB, WS_WFIN0 = 7 * MiB, WS_WFIN1 = 18 * MiB, WS_WFOUT0 = 29 * MiB, WS_WFOUT1 = 29 * MiB + 5632 * 1024,
                 WS_WQKV = 40 * MiB, WS_WAOUT = 43 * MiB;
constexpr size_t WS_SMALL = 45 * MiB;
constexpr size_t WS_GW = WS_SMALL, WS_MOD = WS_SMALL + 256 * 1024, WS_ROPEC = WS_SMALL + 512 * 1024, WS_ROPES = WS_ROPEC + 8192, WS_SP8 = WS_ROPES + 8192,
                 WS_SUMA = WS_SMALL + 1 * MiB, WS_SUMB = WS_SMALL + 3 * MiB + 256 * 1024, WS_HIN = WS_SMALL + 5 * MiB + 512 * 1024;
constexpr size_t WS_HB = 53 * MiB;
constexpr size_t WS_X = 86 * MiB;
constexpr size_t WS_R1 = 152 * MiB;
constexpr size_t WS_Q = WS_R1, WS_KV = WS_R1 + 33 * MiB, WS_O = WS_KV + 17 * MiB;
constexpr size_t WS_SSP = 244 * MiB;
constexpr size_t WS_BV = 246 * MiB, WS_GM = 247 * MiB;
constexpr size_t WS_BTAIL = 235 * MiB;
constexpr size_t WS_CTL = 243 * MiB, CTL_BYTES = 65536;
constexpr size_t WS_PART = 248 * MiB;
constexpr size_t WS_END = 256 * MiB;
constexpr int CTL_CTXCNT = 4096;
static_assert(WS_O + (size_t)ML * DM * 2 <= WS_CTL && WS_R1 + (size_t)MT * DFF * 2 <= WS_CTL, "ws map");
static_assert(WS_SUMB - WS_SUMA >= (size_t)NB * NCH * 2 * DLRU * 4 && WS_HIN + (size_t)NB * NCH * 2 * DLRU * 4 <= WS_HB, "ws small map");

constexpr int LDS_BYTES = 147456;

struct Args { const float* in[24]; float* out; unsigned char* ws; int ph_lo, ph_hi; };

DI unsigned pk2(float lo, float hi) { f32x2_t v = {lo, hi}; bf16x2_t b = __builtin_convertvector(v, bf16x2_t); return __builtin_bit_cast(unsigned, b); }
DI float bflo(unsigned u) { return __uint_as_float(u << 16); }
DI float bfhi(unsigned u) { return __uint_as_float(u & 0xffff0000u); }
DI f32x4 unpack4(u32x2 u) { return (f32x4){bflo(u.x), bfhi(u.x), bflo(u.y), bfhi(u.y)}; }
DI u32x2 pack4(f32x4 v) { u32x2 r; r.x = pk2(v[0], v[1]); r.y = pk2(v[2], v[3]); return r; }
DI float wave_sum(float v) {
#pragma unroll
    for (int o = 1; o < 64; o <<= 1) v += __shfl_xor(v, o);
    return v;
}
DI float fast_exp(float x) { return __builtin_amdgcn_exp2f(x * LOG2E); }
DI float sigmoidf_(float x) { return __builtin_amdgcn_rcpf(1.f + fast_exp(-x)); }
DI float siluf_(float x) { return x * sigmoidf_(x); }
DI float gelu_tanh(float x) { const float u = 0.7978845608028654f * (x + 0.044715f * x * x * x); return x * __builtin_amdgcn_rcpf(1.f + fast_exp(-2.f * u)); }
DI int bsel(int row) { return row < SEQ ? 0 : (row < ML ? 1 : 2); }

struct EpiStore {
    static constexpr bool PERM = true, AFTER_DRAIN = false;
    bf16* O; int ldc;
    DI void operator()(const f32x4 (&acc)[2][2][4][2], const pg8::Unit& u, int wr, int wc, int fr, int fq) const {
        const int row0 = u.pm * 256 + wr * 64 + fr, col0 = u.pn * 256 + wc * 32 + 8 * fq;
#pragma unroll
        for (int ai = 0; ai < 2; ++ai)
#pragma unroll
            for (int m = 0; m < 4; ++m) { bf16* rowp = O + (size_t)(row0 + ai * 128 + m * 16) * ldc + col0;
#pragma unroll
                for (int bj = 0; bj < 2; ++bj) { const f32x4 v0 = acc[ai][bj][m][0], v1 = acc[ai][bj][m][1];
                    u32x4 w; w.x = pk2(v0[0], v0[1]); w.y = pk2(v0[2], v0[3]); w.z = pk2(v1[0], v1[1]); w.w = pk2(v1[2], v1[3]);
                    *(u32x4*)(rowp + bj * 128) = w; } }
    }
};
constexpr int RS_TAB_OFF = 132096, RS_TAB_UNITS = 12;
template <class Sched> DI void rstd_table(LAS unsigned char* lds, const float* ssp, const Sched& S, int tid) {
    LAS float* tab = (LAS float*)(lds + RS_TAB_OFF);
    pg8::Unit u;
    for (int i = 0; i < RS_TAB_UNITS && S.next(i, u); ++i) {
        const int rr = tid >> 1, hf = tid & 1; const f32x4* q = (const f32x4*)(ssp + (size_t)(u.pm * 256 + rr) * 16 + hf * 8); const f32x4 a = q[0], b = q[1];
        float s = ((a[0] + a[1]) + (a[2] + a[3])) + ((b[0] + b[1]) + (b[2] + b[3]));
        s += __shfl_xor(s, 1);
        if (hf == 0) tab[i * 256 + rr] = 1.0f / sqrtf(s * (1.f / DM) + 1e-6f);
    }
    __syncthreads();
}
DI float row_rstd(LAS unsigned char* lds, int ord, int rin) { return ((const LAS float*)(lds + RS_TAB_OFF))[ord * 256 + rin]; }
struct EpiSwiGLU {
    static constexpr bool PERM = true, AFTER_DRAIN = false;
    bf16* O; int ldc; LAS unsigned char* lds; const float* bias;
    DI void operator()(const f32x4 (&acc)[2][2][4][2], const pg8::Unit& u, int wr, int wc, int fr, int fq) const {
        const int row0 = u.pm * 256 + wr * 64 + fr, col0 = u.pn * 128 + wc * 32 + 8 * fq;
        const int bs = u.pm < 32 ? 0 : (u.pm < 64 ? 1 : 2);
        const float* bp = bias + bs * (2 * DFF) + u.pn * 256 + wc * 32 + 8 * fq;
        f32x4 bv[2][2];
#pragma unroll
        for (int bj = 0; bj < 2; ++bj)
#pragma unroll
            for (int n = 0; n < 2; ++n) bv[bj][n] = *(const f32x4*)(bp + bj * 128 + 4 * n);
#pragma unroll
        for (int ai = 0; ai < 2; ++ai)
#pragma unroll
            for (int m = 0; m < 4; ++m) { const int r = row0 + ai * 128 + m * 16; bf16* rowp = O + (size_t)r * ldc + col0;
                const float rs = row_rstd(lds, u.ord, wr * 64 + fr + ai * 128 + m * 16);
                float v[8];
#pragma unroll
                for (int n = 0; n < 2; ++n)
#pragma unroll
                    for (int j = 0; j < 4; ++j) v[n * 4 + j] = siluf_(__builtin_fmaf(acc[ai][0][m][n][j], rs, bv[0][n][j])) * __builtin_fmaf(acc[ai][1][m][n][j], rs, bv[1][n][j]);
                u32x4 w; w.x = pk2(v[0], v[1]); w.y = pk2(v[2], v[3]); w.z = pk2(v[4], v[5]); w.w = pk2(v[6], v[7]);
                *(u32x4*)rowp = w; }
    }
};
struct EpiResid {
    static constexpr bool PERM = false, AFTER_DRAIN = false;
    const float* baseL; const float* baseC;
    float* X; const float* gate;
    bf16* HBn; const float* gm; float* ssp;
    DI void operator()(const f32x4 (&acc)[2][2][4][2], const pg8::Unit& u, int wr, int wc, int fr, int fq) const {
        const int bs = u.pm < 32 ? 0 : (u.pm < 64 ? 1 : 2);
        const int col0 = u.pn * 256 + wc * 32 + 4 * fq;
        const float* gp = gate + bs * 6144 + col0;
        f32x4 gv[2][2], gmv[2][2];
#pragma unroll
        for (int bj = 0; bj < 2; ++bj)
#pragma unroll
            for (int n = 0; n < 2; ++n) { gv[bj][n] = *(const f32x4*)(gp + bj * 128 + n * 16); if (HBn) gmv[bj][n] = *(const f32x4*)(gm + bs * 1024 + col0 + bj * 128 + n * 16); }
#pragma unroll
        for (int ai = 0; ai < 2; ++ai)
#pragma unroll
            for (int m = 0; m < 4; ++m) { const int r = u.pm * 256 + ai * 128 + wr * 64 + m * 16 + fr;
                const float* bp = (r < ML ? baseL + (size_t)r * DM : baseC + (size_t)(r - ML) * DM) + col0;
                float* op = X + (size_t)r * DM + col0;
                float ss = 0.f;
#pragma unroll
                for (int bj = 0; bj < 2; ++bj)
#pragma unroll
                    for (int n = 0; n < 2; ++n) { const f32x4 b4 = *(const f32x4*)(bp + bj * 128 + n * 16);
                        const f32x4 xn = b4 + gv[bj][n] * acc[ai][bj][m][n];
                        *(f32x4*)(op + bj * 128 + n * 16) = xn;
                        if (HBn) { ss += (xn[0] * xn[0] + xn[1] * xn[1]) + (xn[2] * xn[2] + xn[3] * xn[3]);
                            *(u32x2*)(HBn + (size_t)r * DM + col0 + bj * 128 + n * 16) = pack4(xn * gmv[bj][n]); } }
                if (HBn) { ss += __shfl_xor(ss, 16); ss += __shfl_xor(ss, 32); if (fq == 0) ssp[(size_t)r * 16 + u.pn * 4 + wc] = ss; } }
    }
};
struct EpiQKV {
    static constexpr bool PERM = false, AFTER_DRAIN = false;
    bf16 *Q, *KV; const float *ropec, *ropes; LAS unsigned char* lds; const float* bias;
    DI void operator()(const f32x4 (&acc)[2][2][4][2], const pg8::Unit& u, int wr, int wc, int fr, int fq) const {
        const bool rope_on = (u.pm < 64) && (u.pn < 5);
        const float scale = u.pn < 4 ? QSCALE : 1.0f;
        bf16* dst = u.pn < 4 ? Q + u.pn * 256 : KV + (u.pn - 4) * 256; const int ld = u.pn < 4 ? DM : 512;
        const int ax = wc & 1, cc = wc * 32 + 4 * fq;
        const int bs = u.pm < 32 ? 0 : (u.pm < 64 ? 1 : 2);
        const float* bp = bias + bs * NQKV + u.pn * 256 + cc;
        f32x4 bv[2][2];
#pragma unroll
        for (int bj = 0; bj < 2; ++bj)
#pragma unroll
            for (int n = 0; n < 2; ++n) bv[bj][n] = *(const f32x4*)(bp + bj * 128 + n * 16);
#pragma unroll
        for (int ai = 0; ai < 2; ++ai)
#pragma unroll
            for (int m = 0; m < 4; ++m) { const int r = u.pm * 256 + ai * 128 + wr * 64 + m * 16 + fr;
                const float rs = row_rstd(lds, u.ord, ai * 128 + wr * 64 + m * 16 + fr);
                const int s = r & (SEQ - 1); const int pos = ax ? (s & 63) : (s >> 6);
                f32x4 c4 = (f32x4){1.f, 1.f, 1.f, 1.f}, s4 = (f32x4){0.f, 0.f, 0.f, 0.f};
                if (rope_on) { c4 = *(const f32x4*)(ropec + pos * 16 + 4 * fq); s4 = *(const f32x4*)(ropes + pos * 16 + 4 * fq); }
                bf16* p = dst + (size_t)r * ld + cc;
#pragma unroll
                for (int bj = 0; bj < 2; ++bj) { const f32x4 x1 = acc[ai][bj][m][0] * rs + bv[bj][0], x2 = acc[ai][bj][m][1] * rs + bv[bj][1];
                    const f32x4 o1 = (x1 * c4 - x2 * s4) * scale, o2 = (x2 * c4 + x1 * s4) * scale;
                    *(u32x2*)(p + bj * 128) = pack4(o1); *(u32x2*)(p + bj * 128 + 16) = pack4(o2); } }
    }
};

DI void transpose_item(const float* W, int ldN, bf16* WT, int K, int k0, int src_n0, int dst_n0, LAS float* scr, int lane) {
    float tv[32];
#pragma unroll
    for (int i = 0; i < 32; ++i) tv[i] = W[(size_t)(k0 + 2 * i + (lane >> 5)) * ldN + src_n0 + (lane & 31)];
#pragma unroll
    for (int i = 0; i < 32; ++i) scr[(2 * i + (lane >> 5)) * 33 + (lane & 31)] = tv[i];
    asm volatile("s_waitcnt lgkmcnt(0)" ::: "memory");
    const int c = lane & 7;
#pragma unroll
    for (int j = 0; j < 4; ++j) { const int n = (lane >> 3) + 8 * j; const LAS float* s = scr + (8 * c) * 33 + n;
        u32x4 o; o.x = pk2(s[0 * 33], s[1 * 33]); o.y = pk2(s[2 * 33], s[3 * 33]); o.z = pk2(s[4 * 33], s[5 * 33]); o.w = pk2(s[6 * 33], s[7 * 33]);
        *(u32x4*)(WT + (size_t)(dst_n0 + n) * K + k0 + 8 * c) = o; }
    asm volatile("s_waitcnt lgkmcnt(0)" ::: "memory");
}
DI void mat_item(int r, const float* W, int K, int N, bf16* WT, bool remap, LAS float* scr, int lane) {
    const int nblk = N / 32, kb = r / nblk, nb = r % nblk; const int dst_n0 = 32 * nb; int src_n0 = dst_n0;
    if (remap) { const int pn = dst_n0 >> 8, w = dst_n0 & 255; src_n0 = (w < 128) ? 128 * pn + w : DFF + 128 * pn + (w - 128); }
    transpose_item(W, N, WT, K, 64 * kb, src_n0, dst_n0, scr, lane);
}
DI void prologue(const Args& a, LAS unsigned char* lds, int tid, int lane, int wave) {
    unsigned char* ws = a.ws;
    {
        LAS float* scr = (LAS float*)(lds + wave * 16384);
        const int gw = blockIdx.x * NWAVES + wave, NGW = gridDim.x * NWAVES;
        constexpr int I0 = 16 * 80, I1 = 16 * 32, I2 = 16 * 176, I4 = 44 * 32, I6 = 16 * 48, I7 = 16 * 32;
        constexpr int NITEMS = I0 + I1 + 2 * I2 + 2 * I4 + I6 + I7;
        for (int it = gw; it < NITEMS; it += NGW) {
            int r = it;
            if (r < I0) { mat_item(r, a.in[11], 1024, RCW, (bf16*)(ws + WS_WRCIN), false, scr, lane); continue; } r -= I0;
            if (r < I1) { mat_item(r, a.in[20], 1024, 1024, (bf16*)(ws + WS_WRCOUT), false, scr, lane); continue; } r -= I1;
            if (r < I2) { mat_item(r, a.in[9], 1024, 2 * DFF, (bf16*)(ws + WS_WFIN0), true, scr, lane); continue; } r -= I2;
            if (r < I2) { mat_item(r, a.in[9] + (size_t)1024 * 2 * DFF, 1024, 2 * DFF, (bf16*)(ws + WS_WFIN1), true, scr, lane); continue; } r -= I2;
            if (r < I4) { mat_item(r, a.in[10], DFF, 1024, (bf16*)(ws + WS_WFOUT0), false, scr, lane); continue; } r -= I4;
            if (r < I4) { mat_item(r, a.in[10] + (size_t)DFF * 1024, DFF, 1024, (bf16*)(ws + WS_WFOUT1), false, scr, lane); continue; } r -= I4;
            if (r < I6) { mat_item(r, a.in[21], 1024, NQKV, (bf16*)(ws + WS_WQKV), false, scr, lane); continue; } r -= I6;
            mat_item(r, a.in[23], 1024, 1024, (bf16*)(ws + WS_WAOUT), false, scr, lane);
        }
    }
    {
        const int gt = blockIdx.x * 512 + tid, NT = gridDim.x * 512;
        bf16* GW = (bf16*)(ws + WS_GW);
        for (int idx = gt; idx < 131072; idx += NT) {
            const int j = idx & 7, ln = (idx >> 3) & 63, ks = (idx >> 9) & 3, mt = (idx >> 11) & 1, head = (idx >> 12) & 7, dg = idx >> 15;
            const int hi = ln >> 5, m = ln & 31;
            const int cin = 32 * (ks >> 1) + 16 * (ks & 1) + 8 * (j >> 2) + 4 * hi + (j & 3), cout = 32 * mt + m;
            const int d = dg >> 1; const float* src = (dg & 1) ? a.in[16] : a.in[14];
            const float v = src[((size_t)(d * 8 + head) * 64 + cin) * 64 + cout];
            GW[idx] = (bf16)(pk2(v, 0.f) & 0xffffu);
        }
        float* sp8 = (float*)(ws + WS_SP8);
        for (int idx = gt; idx < 2 * DLRU; idx += NT) sp8[idx] = -8.0f * log1pf(expf(-a.in[18][idx]));
        float* rc = (float*)(ws + WS_ROPEC); float* rs = (float*)(ws + WS_ROPES);
        for (int idx = gt; idx < 2048; idx += NT) {
            const int pos = idx >> 4, f = idx & 15;
            const float inv = (float)exp2(-(double)f * (13.287712379549449 / 16.0));
            const float ang = (float)pos * inv;
            double x = (double)ang; const double n = rint(x * 0.15915494309189535); x -= n * 6.283185307179586476925;
            const double x2 = x * x; double cs = 1.0, sn = 1.0;
            { double t = 1.0, s = 1.0;
              for (int i = 1; i <= 14; ++i) { t *= -x2 / (double)((2 * i - 1) * (2 * i)); s += t; } cs = s; }
            { double t = 1.0, s = 1.0;
              for (int i = 1; i <= 14; ++i) { t *= -x2 / (double)((2 * i) * (2 * i + 1)); s += t; } sn = s * x; }
            rc[idx] = (float)cs; rs[idx] = (float)sn;
        }
    }
    {
        LAS float* red = (LAS float*)lds;
        float* MOD = (float*)(ws + WS_MOD);
        for (int it = blockIdx.x; it < 192; it += gridDim.x) {
            __syncthreads();
            const int l = it / 96, n0 = (it % 96) * 64, cl = lane & 15, ksub = lane >> 4;
            f32x4 a0 = {0.f, 0.f, 0.f, 0.f}, a1 = a0, a2 = a0;
            const float* wbase = a.in[4] + (size_t)l * 1024 * 6144 + n0 + 4 * cl;
#pragma unroll 16
            for (int i = 0; i < 32; ++i) { const int k = 128 * wave + 4 * i + ksub;
                const f32x4 w = *(const f32x4*)(wbase + (size_t)k * 6144);
                const float s0 = siluf_(a.in[1][k]), s1 = siluf_(a.in[1][1024 + k]), s2 = siluf_(a.in[3][k]);
                a0 += w * s0; a1 += w * s1; a2 += w * s2; }
#pragma unroll
            for (int j = 0; j < 4; ++j) { a0[j] += __shfl_xor(a0[j], 16); a0[j] += __shfl_xor(a0[j], 32); a1[j] += __shfl_xor(a1[j], 16); a1[j] += __shfl_xor(a1[j], 32); a2[j] += __shfl_xor(a2[j], 16); a2[j] += __shfl_xor(a2[j], 32); }
            if (ksub == 0) {
#pragma unroll
                for (int j = 0; j < 4; ++j) { red[(wave * 3 + 0) * 64 + 4 * cl + j] = a0[j]; red[(wave * 3 + 1) * 64 + 4 * cl + j] = a1[j]; red[(wave * 3 + 2) * 64 + 4 * cl + j] = a2[j]; } }
            __syncthreads();
            if (tid < 192) { const int bs = tid >> 6, col = tid & 63; float s = a.in[5][l * 6144 + n0 + col];
#pragma unroll
                for (int w = 0; w < 8; ++w) s += red[(w * 3 + bs) * 64 + col];
                MOD[(size_t)(l * 3 + bs) * 6144 + n0 + col] = s; }
        }
        __syncthreads();
    }
}

DI void norm_mod_phase(const float* srcL, const float* srcC, int nrows, const float* g, const float* mod, int shk, int sck, bf16* dst, int wave, int lane) {
    const int gw = blockIdx.x * NWAVES + wave, NGW = gridDim.x * NWAVES;
    for (int row = gw; row < nrows; row += NGW) {
        const float* src = row < ML ? srcL + (size_t)row * DM : srcC + (size_t)(row - ML) * DM;
        const float* mb = mod + bsel(row) * 6144;
        const f32x4* x4 = (const f32x4*)src + lane;
        f32x4 v[4]; float ss = 0.f;
#pragma unroll
        for (int j = 0; j < 4; ++j) { v[j] = x4[64 * j]; ss += (v[j][0] * v[j][0] + v[j][1] * v[j][1]) + (v[j][2] * v[j][2] + v[j][3] * v[j][3]); }
        const float rstd = 1.0f / sqrtf(wave_sum(ss) * (1.f / DM) + 1e-6f);
        u32x2* o = (u32x2*)(dst + (size_t)row * DM) + lane;
#pragma unroll
        for (int j = 0; j < 4; ++j) { const f32x4 gg = ((const f32x4*)g)[lane + 64 * j], sc = ((const f32x4*)(mb + sck * 1024))[lane + 64 * j], sh = ((const f32x4*)(mb + shk * 1024))[lane + 64 * j];
            const f32x4 y = (v[j] * rstd * gg) * (sc + 1.0f) + sh; o[64 * j] = pack4(y); }
    }
}
DI void final_norm_phase(const float* X, const float* g, float* out, int wave, int lane) {
    const int gw = blockIdx.x * NWAVES + wave, NGW = gridDim.x * NWAVES;
    for (int row = gw; row < ML; row += NGW) {
        const f32x4* x4 = (const f32x4*)(X + (size_t)row * DM) + lane;
        f32x4 v[4]; float ss = 0.f;
#pragma unroll
        for (int j = 0; j < 4; ++j) { v[j] = x4[64 * j]; ss += (v[j][0] * v[j][0] + v[j][1] * v[j][1]) + (v[j][2] * v[j][2] + v[j][3] * v[j][3]); }
        const float rstd = 1.0f / sqrtf(wave_sum(ss) * (1.f / DM) + 1e-6f);
        f32x4* o = (f32x4*)(out + (size_t)row * DM) + lane;
#pragma unroll
        for (int j = 0; j < 4; ++j) o[64 * j] = v[j] * rstd * ((const f32x4*)g)[lane + 64 * j];
    }
}

DI void aux_phase(const Args& a, int tid, int wave, int lane) {
    unsigned char* ws = a.ws;
    const float* MOD = (const float*)(ws + WS_MOD);
    float* GM = (float*)(ws + WS_GM); float* BV = (float*)(ws + WS_BV);
    const int gt = blockIdx.x * 512 + tid, NT = gridDim.x * 512;
    for (int idx = gt; idx < 9 * 1024; idx += NT) { const int c = idx & 1023, bs = (idx >> 10) % 3, which = idx / 3072;
        const float g = which == 0 ? a.in[7][c] : (which == 1 ? a.in[6][DM + c] : a.in[7][DM + c]);
        const float sc = MOD[(size_t)((which == 0 ? 0 : 1) * 3 + bs) * 6144 + (which == 1 ? 1 : 4) * 1024 + c];
        GM[idx] = g * (1.0f + sc); }
    const int gw = blockIdx.x * NWAVES + wave, NGW = gridDim.x * NWAVES;
    for (int it = gw; it < 2 * DFF + NQKV + 2 * DFF; it += NGW) {
        int which, n; if (it < 2 * DFF) { which = 0; n = it; } else if (it < 2 * DFF + NQKV) { which = 1; n = it - 2 * DFF; } else { which = 2; n = it - 2 * DFF - NQKV; }
        const bf16* Bt = (const bf16*)(ws + (which == 0 ? WS_WFIN0 : (which == 1 ? WS_WQKV : WS_WFIN1))) + (size_t)n * DM + 16 * lane;
        const int N = which == 1 ? NQKV : 2 * DFF;
        const float* shb = MOD + (size_t)((which == 0 ? 0 : 1) * 3) * 6144 + (which == 1 ? 0 : 3) * 1024 + 16 * lane;
        const u32x4 w0 = *(const u32x4*)Bt, w1 = *(const u32x4*)(Bt + 8);
        const f32x4 wv[4] = {unpack4((u32x2){w0.x, w0.y}), unpack4((u32x2){w0.z, w0.w}), unpack4((u32x2){w1.x, w1.y}), unpack4((u32x2){w1.z, w1.w})};
        float acc[3];
#pragma unroll
        for (int bs = 0; bs < 3; ++bs) { float s_ = 0.f;
#pragma unroll
            for (int q = 0; q < 4; ++q) { const f32x4 sh = *(const f32x4*)(shb + bs * 6144 + 4 * q); s_ += (wv[q][0] * sh[0] + wv[q][1] * sh[1]) + (wv[q][2] * sh[2] + wv[q][3] * sh[3]); }
            acc[bs] = wave_sum(s_); }
        if (lane == 0) { float* o = BV + (size_t)which * 3 * (2 * DFF) + n; o[0] = acc[0]; o[N] = acc[1]; o[2 * N] = acc[2]; }
    }
}

constexpr int RG_UNITS = NB * NCH * 8;
typedef _Float16 f16x4_t __attribute__((ext_vector_type(4)));
DI u32x2 pack4h(f32x4 v) { f16x4_t h = __builtin_convertvector(v, f16x4_t); return __builtin_bit_cast(u32x2, h); }
DI f32x4 unpack4h(u32x2 u) { return __builtin_convertvector(__builtin_bit_cast(f16x4_t, u), f32x4); }
DI unsigned short* rg_acum_ptr(const Args& a, int unit) { return (unsigned short*)(a.ws + WS_X) + (size_t)unit * 4096; }
DI unsigned short* rg_bcum_ptr(const Args& a, int unit) { return (unsigned short*)a.out + (size_t)unit * 4096; }
template <int CTRL, int RMASK> DI float dppf(float oldv, float v) {
    return __builtin_bit_cast(float, __builtin_amdgcn_update_dpp(__builtin_bit_cast(int, oldv), __builtin_bit_cast(int, v), CTRL, RMASK, 0xf, false));
}
#define RG_SCAN_STEP(CTRL, RMASK) do { _Pragma("unroll") for (int r = 0; r < 16; ++r) { const float am = aR[r], bm = aI[r]; \
        const float ap = dppf<CTRL, RMASK>(1.0f, am), bp = dppf<CTRL, RMASK>(0.0f, bm); aR[r] = am * ap; aI[r] = __builtin_fmaf(am, bp, bm); } } while (0)
template <int D, int MT_> DI void rg1_quarter(const float (&xc)[2][16], const bf16x8 (&xb)[4], const LAS unsigned char* gwl, const LAS float* pv,
                                              unsigned short* acum, unsigned short* bcum, float* SUMA, float* SUMB, int lane, size_t sbase) {
    const int hi = lane >> 5;
    f32x16 aR, aI;
#pragma unroll
    for (int i = 0; i < 16; ++i) { aR[i] = 0.f; aI[i] = 0.f; }
#pragma unroll
    for (int ks = 0; ks < 4; ++ks) {
        const bf16x8 wr_ = *(const LAS bf16x8*)(gwl + ((((D * 2 + 0) * 2 + MT_) * 4 + ks) * 64 + lane) * 16);
        const bf16x8 wi_ = *(const LAS bf16x8*)(gwl + ((((D * 2 + 1) * 2 + MT_) * 4 + ks) * 64 + lane) * 16);
        aR = __builtin_amdgcn_mfma_f32_32x32x16_bf16(wr_, xb[ks], aR, 0, 0, 0);
        aI = __builtin_amdgcn_mfma_f32_32x32x16_bf16(wi_, xb[ks], aI, 0, 0, 0);
    }
#pragma unroll
    for (int rq = 0; rq < 4; ++rq) {
        const int c0 = 32 * MT_ + 8 * rq + 4 * hi;
        const f32x4 rb4 = *(const LAS f32x4*)(pv + 320 + D * 64 + c0), ib4 = *(const LAS f32x4*)(pv + 448 + D * 64 + c0), lm4 = *(const LAS f32x4*)(pv + 576 + D * 64 + c0);
#pragma unroll
        for (int j = 0; j < 4; ++j) { const int r = 4 * rq + j;
            const float rr = __builtin_amdgcn_rcpf(1.0f + __builtin_amdgcn_exp2f(__builtin_fmaf(aR[r], -LOG2E, rb4[j])));
            const float ii = __builtin_amdgcn_rcpf(1.0f + __builtin_amdgcn_exp2f(__builtin_fmaf(aI[r], -LOG2E, ib4[j])));
            const float av = __builtin_amdgcn_exp2f(rr * lm4[j]);
            const float mult = __builtin_amdgcn_sqrtf(fmaxf(__builtin_fmaf(-av, av, 1.0f), 1e-12f));
            aR[r] = av; aI[r] = mult * ii * xc[MT_][r]; }
    }
    if (D == 1) {
#pragma unroll
        for (int r = 0; r < 16; ++r) { aR[r] = __shfl_xor(aR[r], 31); aI[r] = __shfl_xor(aI[r], 31); }
    }
    RG_SCAN_STEP(0x111, 0xf);
    RG_SCAN_STEP(0x112, 0xf);
    RG_SCAN_STEP(0x114, 0xf);
    RG_SCAN_STEP(0x118, 0xf);
    RG_SCAN_STEP(0x142, 0xa);
#pragma unroll
    for (int rq = 0; rq < 4; ++rq) {
        *(u32x2*)(acum + ((D * 2 + MT_) * 4 + rq) * 256 + lane * 4) = pack4h((f32x4){aR[4 * rq], aR[4 * rq + 1], aR[4 * rq + 2], aR[4 * rq + 3]});
        *(u32x2*)(bcum + ((D * 2 + MT_) * 4 + rq) * 256 + lane * 4) = pack4h((f32x4){aI[4 * rq], aI[4 * rq + 1], aI[4 * rq + 2], aI[4 * rq + 3]});
    }
    if ((lane & 31) == 31) {
#pragma unroll
        for (int rq = 0; rq < 4; ++rq) { const int c0 = 32 * MT_ + 8 * rq + 4 * hi;
            *(f32x4*)(SUMA + sbase + D * DLRU + c0) = (f32x4){aR[4 * rq], aR[4 * rq + 1], aR[4 * rq + 2], aR[4 * rq + 3]};
            *(f32x4*)(SUMB + sbase + D * DLRU + c0) = (f32x4){aI[4 * rq], aI[4 * rq + 1], aI[4 * rq + 2], aI[4 * rq + 3]}; }
    }
}
template <int QMASK> DI void rg1_unit(const Args& a, const LAS unsigned char* gwl, const LAS float* pv, int cb, int head, int lane_in) {
    unsigned char* ws = a.ws;
    const bf16* U = (const bf16*)(ws + WS_R1);
    float* SUMA = (float*)(ws + WS_SUMA); float* SUMB = (float*)(ws + WS_SUMB);
    int lane_o = lane_in; asm volatile("" : "+v"(lane_o));
    const int lane = lane_o, tok = lane & 31, hi = lane >> 5;
    const int gc = cb >> 1, b = cb & 1, unit = cb * 8 + head;
    const bool lat = gc < 256;
    const int ts0 = lat ? gc * 32 : (gc - 256) * 32, len = lat ? SEQ : CTX, rowbase = lat ? b * SEQ : ML + b * CTX;
    const int ts = ts0 + tok;
    u32x2 tap[8][4];
#pragma unroll
    for (int k = 0; k < 4; ++k) { const int tt = ts - 2 + k; const bool ok = (tt >= 0) && (tt < len); const int ttc = ok ? tt : ts;
        const bf16* up = U + (size_t)(rowbase + ttc) * RCW + head * 64 + 4 * hi;
#pragma unroll
        for (int q = 0; q < 8; ++q) { u32x2 v = *(const u32x2*)(up + 8 * q); if (!ok) { v.x = 0u; v.y = 0u; } tap[q][k] = v; } }
    float xc[2][16];
#pragma unroll
    for (int q = 0; q < 8; ++q) {
        f32x4 acc = *(const LAS f32x4*)(pv + 256 + 8 * q + 4 * hi);
#pragma unroll
        for (int k = 0; k < 4; ++k) acc += *(const LAS f32x4*)(pv + k * 64 + 8 * q + 4 * hi) * unpack4(tap[q][k]);
#pragma unroll
        for (int j = 0; j < 4; ++j) xc[q >> 2][4 * (q & 3) + j] = acc[j];
    }
    bf16x8 xb[4];
#pragma unroll
    for (int ks = 0; ks < 4; ++ks) { const int mt = ks >> 1, r0 = 8 * (ks & 1);
        u32x4 p; p.x = pk2(xc[mt][r0], xc[mt][r0 + 1]); p.y = pk2(xc[mt][r0 + 2], xc[mt][r0 + 3]); p.z = pk2(xc[mt][r0 + 4], xc[mt][r0 + 5]); p.w = pk2(xc[mt][r0 + 6], xc[mt][r0 + 7]);
        xb[ks] = __builtin_bit_cast(bf16x8, p); }
    unsigned short* acum = rg_acum_ptr(a, unit); unsigned short* bcum = rg_bcum_ptr(a, unit);
    const size_t sbase = ((size_t)(b * NCH + gc) * 2) * DLRU + head * 64;
    if (QMASK & 1) { rg1_quarter<0, 0>(xc, xb, gwl, pv, acum, bcum, SUMA, SUMB, lane, sbase); asm volatile("" ::: "memory"); }
    if (QMASK & 2) { rg1_quarter<0, 1>(xc, xb, gwl, pv, acum, bcum, SUMA, SUMB, lane, sbase); asm volatile("" ::: "memory"); }
    if (QMASK & 4) { rg1_quarter<1, 0>(xc, xb, gwl, pv, acum, bcum, SUMA, SUMB, lane, sbase); asm volatile("" ::: "memory"); }
    if (QMASK & 8) { rg1_quarter<1, 1>(xc, xb, gwl, pv, acum, bcum, SUMA, SUMB, lane, sbase); asm volatile("" ::: "memory"); }
}
DI void rg1_phase(const Args& a, LAS unsigned char* lds, int tid, int lane, int wave) {
    unsigned char* ws = a.ws;
    const int head = blockIdx.x & 7, nbh = ((int)gridDim.x - head + 7) >> 3;
    const int wslot = (blockIdx.x >> 3) * NWAVES + wave, NWS = nbh * NWAVES;
    LAS unsigned char* gwl = lds; LAS float* pv = (LAS float*)(lds + 32768);
    {
        const bf16* GW = (const bf16*)(ws + WS_GW);
#pragma unroll
        for (int i = 0; i < 4; ++i) { const int idx16 = tid + 512 * i, dg = idx16 >> 9;
            *(LAS u32x4*)(gwl + idx16 * 16) = *(const u32x4*)(GW + (size_t)(dg * 8 + head) * 4096 + (idx16 & 511) * 8); }
        for (int t = tid; t < 704; t += 512) { const int c = t & 63; float v;
            if (t < 256) v = a.in[12][(t >> 6) * DLRU + head * 64 + c];
            else if (t < 320) v = a.in[13][head * 64 + c];
            else if (t < 448) v = -LOG2E * a.in[15][((t - 320) >> 6) * DLRU + head * 64 + c];
            else if (t < 576) v = -LOG2E * a.in[17][((t - 448) >> 6) * DLRU + head * 64 + c];
            else v = LOG2E * ((const float*)(ws + WS_SP8))[((t - 576) >> 6) * DLRU + head * 64 + c];
            pv[t] = v; }
        __syncthreads();
    }
    for (int cb = wslot; cb < 512; cb += NWS) rg1_unit<15>(a, gwl, pv, cb, head, lane);
    for (int qi = wslot; qi < 64; qi += NWS) { const int cb = 512 + (qi >> 2), qq = qi & 3;
        if (qq == 0) rg1_unit<1>(a, gwl, pv, cb, head, lane); else if (qq == 1) rg1_unit<2>(a, gwl, pv, cb, head, lane);
        else if (qq == 2) rg1_unit<4>(a, gwl, pv, cb, head, lane); else rg1_unit<8>(a, gwl, pv, cb, head, lane); }
    __syncthreads();
}
DI void rg_carry_phase(const Args& a, LAS unsigned char* lds, int wave, int lane) {
    unsigned char* ws = a.ws;
    const float* SUMA = (const float*)(ws + WS_SUMA); const float* SUMB = (const float*)(ws + WS_SUMB); float* HIN = (float*)(ws + WS_HIN);
    LAS float* sh = (LAS float*)lds;
    for (int it = blockIdx.x; it < 32; it += gridDim.x) {
        const int head = it & 7, d = (it >> 3) & 1, b = it >> 4;
        const int c = lane, seg = wave; const float* sa = SUMA + c; const float* sb = SUMB + c; float* ho = HIN + c;
        float av[33], bv[33];
#pragma unroll
        for (int i = 0; i < 33; ++i) { const int st = seg * 33 + i; const int gc = d == 0 ? (st + 256) % NCH : (NCH - 1 - st);
            const unsigned idx = (unsigned)(((b * NCH + gc) * 2 + d) * DLRU + head * 64); av[i] = sa[idx]; bv[i] = sb[idx]; }
        float A = 1.f, B = 0.f;
#pragma unroll
        for (int i = 0; i < 33; ++i) { B = av[i] * B + bv[i]; A = av[i] * A; }
        __syncthreads();
        sh[(seg * 64 + c) * 2] = A; sh[(seg * 64 + c) * 2 + 1] = B;
        __syncthreads();
        float h = 0.f;
        for (int s = 0; s < seg; ++s) h = sh[(s * 64 + c) * 2] * h + sh[(s * 64 + c) * 2 + 1];
#pragma unroll
        for (int i = 0; i < 33; ++i) { const int st = seg * 33 + i; const int gc = d == 0 ? (st + 256) % NCH : (NCH - 1 - st);
            const unsigned idx = (unsigned)(((b * NCH + gc) * 2 + d) * DLRU + head * 64); ho[idx] = h; h = av[i] * h + bv[i]; }
    }
    __syncthreads();
}
DI void rg3_phase(const Args& a, int wave, int lane_in) {
    unsigned char* ws = a.ws;
    const bf16* U = (const bf16*)(ws + WS_R1);
    const float* HIN = (const float*)(ws + WS_HIN);
    bf16* Y = (bf16*)(ws + WS_HB);
    const int gw = blockIdx.x * NWAVES + wave, NGW = gridDim.x * NWAVES;
    for (int hu = gw; hu < 2 * RG_UNITS; hu += NGW) {
        int lane_o = lane_in; asm volatile("" : "+v"(lane_o));
        const int lane = lane_o, tok = lane & 31, hi = lane >> 5;
        const int mt = hu & 1, unit = hu >> 1, head = unit & 7, cb = unit >> 3, gc = cb >> 1, b = cb & 1;
        const bool lat = gc < 256;
        const int row = (lat ? b * SEQ + gc * 32 : ML + b * CTX + (gc - 256) * 32) + tok;
        const unsigned short* acum = rg_acum_ptr(a, unit) + mt * 1024 + lane * 4; const unsigned short* bcum = rg_bcum_ptr(a, unit) + mt * 1024 + lane * 4;
        const float* hin = HIN + ((size_t)(b * NCH + gc) * 2) * DLRU + head * 64 + 32 * mt + 4 * hi;
        f32x4 A4[2][4], B4[2][4], H4[2][4];
#pragma unroll
        for (int d = 0; d < 2; ++d)
#pragma unroll
            for (int rq = 0; rq < 4; ++rq) { A4[d][rq] = unpack4h(*(const u32x2*)(acum + d * 2048 + rq * 256)); B4[d][rq] = unpack4h(*(const u32x2*)(bcum + d * 2048 + rq * 256));
                H4[d][rq] = *(const f32x4*)(hin + d * DLRU + 8 * rq); }
        u32x2 gau[4];
#pragma unroll
        for (int rq = 0; rq < 4; ++rq) gau[rq] = *(const u32x2*)(U + (size_t)row * RCW + DLRU + head * 64 + 32 * mt + 8 * rq + 4 * hi);
#pragma unroll
        for (int rq = 0; rq < 4; ++rq) { const f32x4 ga = unpack4(gau[rq]); f32x4 y;
#pragma unroll
            for (int j = 0; j < 4; ++j) { const float h0 = __builtin_fmaf(A4[0][rq][j], H4[0][rq][j], B4[0][rq][j]), h1 = __builtin_fmaf(A4[1][rq][j], H4[1][rq][j], B4[1][rq][j]);
                y[j] = (h0 + __shfl_xor(h1, 31)) * gelu_tanh(ga[j]); }
            *(u32x2*)(Y + (size_t)row * DM + head * 64 + 32 * mt + 8 * rq + 4 * hi) = pack4(y); }
    }
}
DI void sc_phase(const Args& a, int wave, int lane) {
    unsigned char* ws = a.ws;
    const bf16* U = (const bf16*)(ws + WS_R1);
    bf16* Y = (bf16*)(ws + WS_HB);
    const float* convB = a.in[19];
    const int gw = blockIdx.x * NWAVES + wave, NGW = gridDim.x * NWAVES;
    f32x4 w[3][2];
#pragma unroll
    for (int k = 0; k < 3; ++k) { w[k][0] = *(const f32x4*)(convB + k * DLRU + 8 * lane); w[k][1] = *(const f32x4*)(convB + k * DLRU + 8 * lane + 4); }
    for (int tile = gw; tile < MT / 8; tile += NGW) {
        const int row0 = tile * 8;
        const int seq0 = row0 < ML ? (row0 & ~(SEQ - 1)) : ML + ((row0 - ML) & ~(CTX - 1)), seqlen = row0 < ML ? SEQ : CTX;
        const bf16* up = U + (size_t)row0 * RCW + 8 * lane;
        u32x4 cgr[10], vr[10], bgr[8];
#pragma unroll
        for (int i = 0; i < 10; ++i) { const int r = row0 - 1 + i; const bool ok = (r >= seq0) && (r < seq0 + seqlen); const bf16* q = up + (ptrdiff_t)(ok ? i - 1 : 0) * RCW;
            cgr[i] = *(const u32x4*)(q + 3 * DLRU); vr[i] = *(const u32x4*)(q + 4 * DLRU); if (!ok) { cgr[i] = (u32x4){0u, 0u, 0u, 0u}; } }
#pragma unroll
        for (int i = 0; i < 8; ++i) bgr[i] = *(const u32x4*)(up + (size_t)i * RCW + 2 * DLRU);
        f32x4 p[10][2];
#pragma unroll
        for (int i = 0; i < 10; ++i) { p[i][0] = unpack4((u32x2){cgr[i].x, cgr[i].y}) * unpack4((u32x2){vr[i].x, vr[i].y}); p[i][1] = unpack4((u32x2){cgr[i].z, cgr[i].w}) * unpack4((u32x2){vr[i].z, vr[i].w}); }
#pragma unroll
        for (int i = 0; i < 8; ++i) {
            const f32x4 o0 = unpack4((u32x2){bgr[i].x, bgr[i].y}) * (w[0][0] * p[i][0] + w[1][0] * p[i + 1][0] + w[2][0] * p[i + 2][0]);
            const f32x4 o1 = unpack4((u32x2){bgr[i].z, bgr[i].w}) * (w[0][1] * p[i][1] + w[1][1] * p[i + 1][1] + w[2][1] * p[i + 2][1]);
            const u32x2 q0 = pack4(o0), q1 = pack4(o1);
            *(u32x4*)(Y + (size_t)(row0 + i) * DM + DLRU + 8 * lane) = (u32x4){q0.x, q0.y, q1.x, q1.y}; }
    }
}

constexpr int ATT_TB = 64 * 144;
DI int att_nt(int u) { const int q64 = (u >> 2) & 127; const int lo = q64 - 2 < 0 ? 0 : q64 - 2, hi = q64 + 2 > 127 ? 127 : q64 + 2; return hi - lo + 1 + 4; }
DI void att_load(const bf16* KV, int u, int t, int srow, int sch, u32x4& kreg, u32x4& vreg) {
    const int hk = u & 3, q64 = (u >> 2) & 127, b = u >> 9;
    const int kt_lo = q64 - 2 < 0 ? 0 : q64 - 2, kt_hi = q64 + 2 > 127 ? 127 : q64 + 2, nwin = kt_hi - kt_lo + 1;
    const int rowk = (t < nwin) ? (b * SEQ + (kt_lo + t) * 64 + srow) : (ML + b * CTX + (t - nwin) * 64 + srow);
    const bf16* kp = KV + (size_t)rowk * 512 + hk * 64 + sch * 8; kreg = *(const u32x4*)kp; vreg = *(const u32x4*)(kp + 256);
}
DI void att_store(LAS unsigned char* base, int srow, int sch, const u32x4& kreg, const u32x4& vreg) {
    *(LAS u32x4*)(base + srow * 144 + sch * 16) = kreg;
    LAS bf16* vt = (LAS bf16*)(base + ATT_TB + (sch * 8) * 144 + srow * 2);
    vt[0 * 72] = (bf16)(vreg.x & 0xffffu); vt[1 * 72] = (bf16)(vreg.x >> 16); vt[2 * 72] = (bf16)(vreg.y & 0xffffu); vt[3 * 72] = (bf16)(vreg.y >> 16);
    vt[4 * 72] = (bf16)(vreg.z & 0xffffu); vt[5 * 72] = (bf16)(vreg.z >> 16); vt[6 * 72] = (bf16)(vreg.w & 0xffffu); vt[7 * 72] = (bf16)(vreg.w >> 16);
}
DI void att_tile(const LAS unsigned char* kb_, const bf16x8 (&qr)[4], float& m, float& l, f32x16 (&o)[2], bool edge, int kt, int qrow, int r32, int hi) {
    const LAS unsigned char* vb_ = kb_ + ATT_TB;
    f32x16 p[2];
#pragma unroll
    for (int i = 0; i < 16; ++i) { p[0][i] = 0.f; p[1][i] = 0.f; }
#pragma unroll
    for (int sub = 0; sub < 2; ++sub)
#pragma unroll
        for (int d0 = 0; d0 < 4; ++d0) { const bf16x8 kf = *(const LAS bf16x8*)(kb_ + (32 * sub + r32) * 144 + (16 * d0 + 8 * hi) * 2);
            p[sub] = __builtin_amdgcn_mfma_f32_32x32x16_bf16(kf, qr[d0], p[sub], 0, 0, 0); }
    if (edge) {
#pragma unroll
        for (int sub = 0; sub < 2; ++sub)
#pragma unroll
            for (int r = 0; r < 16; ++r) { const int kpos = kt * 64 + 32 * sub + (r & 3) + 8 * (r >> 2) + 4 * hi; const int df = kpos - qrow;
                if (df > 128 || df < -128) p[sub][r] = -1e30f; }
    }
    float mx = p[0][0];
#pragma unroll
    for (int r = 1; r < 16; ++r) mx = fmaxf(mx, p[0][r]);
#pragma unroll
    for (int r = 0; r < 16; ++r) mx = fmaxf(mx, p[1][r]);
    mx = fmaxf(mx, __shfl_xor(mx, 32));
    const float mnew = fmaxf(m, mx), sc = __builtin_amdgcn_exp2f(m - mnew); m = mnew;
    float ls = 0.f;
#pragma unroll
    for (int sub = 0; sub < 2; ++sub)
#pragma unroll
        for (int r = 0; r < 16; ++r) { const float e = __builtin_amdgcn_exp2f(p[sub][r] - m); p[sub][r] = e; ls += e; }
    l = l * sc + ls;
#pragma unroll
    for (int i = 0; i < 16; ++i) { o[0][i] *= sc; o[1][i] *= sc; }
    bf16x8 pb[4];
#pragma unroll
    for (int ks = 0; ks < 4; ++ks) { const int sub = ks >> 1, r0 = 8 * (ks & 1);
        u32x4 w; w.x = pk2(p[sub][r0], p[sub][r0 + 1]); w.y = pk2(p[sub][r0 + 2], p[sub][r0 + 3]); w.z = pk2(p[sub][r0 + 4], p[sub][r0 + 5]); w.w = pk2(p[sub][r0 + 6], p[sub][r0 + 7]);
        pb[ks] = __builtin_bit_cast(bf16x8, w); }
#pragma unroll
    for (int dt = 0; dt < 2; ++dt)
#pragma unroll
        for (int ks = 0; ks < 4; ++ks) { const LAS unsigned char* vp = vb_ + (32 * dt + r32) * 144 + (16 * ks + 4 * hi) * 2;
            const u32x2 lo = *(const LAS u32x2*)vp, hi2 = *(const LAS u32x2*)(vp + 16);
            u32x4 w; w.x = lo.x; w.y = lo.y; w.z = hi2.x; w.w = hi2.y;
            o[dt] = __builtin_amdgcn_mfma_f32_32x32x16_bf16(__builtin_bit_cast(bf16x8, w), pb[ks], o[dt], 0, 0, 0); }
}
DI void attn_phase(const Args& a, LAS unsigned char* lds, int tid, int lane, int wave) {
    unsigned char* ws = a.ws;
    const bf16* Q = (const bf16*)(ws + WS_Q); const bf16* KV = (const bf16*)(ws + WS_KV);
    bf16* O = (bf16*)(ws + WS_O);
    const float* sink = a.in[22];
    const int r32 = lane & 31, hi = lane >> 5, srow = tid >> 3, sch = tid & 7;
    const int G = gridDim.x, NU = NB * 128 * 4;
    const int u0 = blockIdx.x;
    if (u0 >= NU) return;
    for (int ubase = u0; ubase < NU; ubase += 4 * G) {
        const int c1 = att_nt(ubase);
        const int c2 = c1 + ((ubase + G < NU) ? att_nt(ubase + G) : 0);
        const int c3 = c2 + ((ubase + 2 * G < NU) ? att_nt(ubase + 2 * G) : 0);
        const int T = c3 + ((ubase + 3 * G < NU) ? att_nt(ubase + 3 * G) : 0);
#define ATT_DECODE(g, uu, tt) do { const int i_ = ((g) >= c1) + ((g) >= c2) + ((g) >= c3); uu = ubase + i_ * G; tt = (g) - (i_ == 0 ? 0 : (i_ == 1 ? c1 : (i_ == 2 ? c2 : c3))); } while (0)
        u32x4 k0, v0, k1, v1;
        { att_load(KV, ubase, 0, srow, sch, k0, v0); if (T > 1) { int uu, tt; ATT_DECODE(1, uu, tt); att_load(KV, uu, tt, srow, sch, k1, v1); } }
        int cu = ubase, ct = 0, cnt = c1;
        bf16x8 qr[4], qn[4];
        float m, l; f32x16 o[2];
#define ATT_QLOAD(dst, uu) do { const int hk_ = (uu) & 3, q64_ = ((uu) >> 2) & 127, b_ = (uu) >> 9; const int head_ = hk_ * 4 + (wave >> 1), qrow_ = q64_ * 64 + (wave & 1) * 32 + r32; \
            _Pragma("unroll") for (int d0 = 0; d0 < 4; ++d0) dst[d0] = *(const bf16x8*)(Q + (size_t)(b_ * SEQ + qrow_) * DM + head_ * 64 + 16 * d0 + 8 * hi); } while (0)
#define ATT_INIT(uu) do { const int head_ = ((uu) & 3) * 4 + (wave >> 1); m = sink[head_] * LOG2E; l = (hi == 0) ? 1.f : 0.f; \
            _Pragma("unroll") for (int i = 0; i < 16; ++i) { o[0][i] = 0.f; o[1][i] = 0.f; } } while (0)
        ATT_QLOAD(qr, cu); ATT_INIT(cu);
        att_store(lds, srow, sch, k0, v0);
        __syncthreads();
#define ATT_ITER(f, KL, VL, KS, VS, CB, SB) do { \
            if ((f) + 2 < T) { int uu_, tt_; ATT_DECODE((f) + 2, uu_, tt_); att_load(KV, uu_, tt_, srow, sch, KL, VL); } \
            const bool last_ = (ct == cnt - 1); const bool more_ = last_ && ((f) + 1 < T); \
            if (more_) ATT_QLOAD(qn, cu + G); \
            { const int q64_ = (cu >> 2) & 127; const int kt_lo_ = q64_ - 2 < 0 ? 0 : q64_ - 2; const int nwin_ = cnt - 4; const int kt_ = kt_lo_ + ct; \
              const bool edge_ = (ct < nwin_) && (kt_ == q64_ - 2 || kt_ == q64_ + 2); \
              att_tile(lds + (CB) * 2 * ATT_TB, qr, m, l, o, edge_, kt_, q64_ * 64 + (wave & 1) * 32 + r32, r32, hi); } \
            if ((f) + 1 < T) att_store(lds + (SB) * 2 * ATT_TB, srow, sch, KS, VS); \
            __syncthreads(); \
            if (last_) { const int hk_ = cu & 3, q64_ = (cu >> 2) & 127, b_ = cu >> 9; const int head_ = hk_ * 4 + (wave >> 1), qrow_ = q64_ * 64 + (wave & 1) * 32 + r32; \
                const float lt_ = l + __shfl_xor(l, 32), inv_ = 1.0f / lt_; bf16* op_ = O + (size_t)(b_ * SEQ + qrow_) * DM + head_ * 64; \
                _Pragma("unroll") for (int dt = 0; dt < 2; ++dt) _Pragma("unroll") for (int rq = 0; rq < 4; ++rq) { \
                    f32x4 v_ = {o[dt][4 * rq] * inv_, o[dt][4 * rq + 1] * inv_, o[dt][4 * rq + 2] * inv_, o[dt][4 * rq + 3] * inv_}; *(u32x2*)(op_ + 32 * dt + 8 * rq + 4 * hi) = pack4(v_); } \
                if (more_) { cu += G; ct = 0; cnt = att_nt(cu); _Pragma("unroll") for (int d0 = 0; d0 < 4; ++d0) qr[d0] = qn[d0]; ATT_INIT(cu); } } \
            else { ++ct; } } while (0)
        for (int f = 0; f < T; f += 2) {
            ATT_ITER(f, k0, v0, k1, v1, 0, 1);
            if (f + 1 < T) ATT_ITER(f + 1, k1, v1, k0, v0, 1, 0);
        }
#undef ATT_ITER
#undef ATT_QLOAD
#undef ATT_INIT
#undef ATT_DECODE
    }
}

#define XB_TMO      128
#define XB_XCNT(j)  (256  + 64 * (j))
#define XB_XSUB(j)  (1280 + 64 * (j))
#define XB_XGEN(j)  (2304 + 64 * (j))
#define XB_TOP      3328
#define XB_TOPGEN   3392
#define XCD_BAR_WORDS 3456
#define XB_SPIN_CAP (1u << 18)

__device__ __forceinline__ unsigned xb_ld(unsigned* p)              { return __hip_atomic_load(p, __ATOMIC_RELAXED, __HIP_MEMORY_SCOPE_AGENT); }
__device__ __forceinline__ unsigned xb_add(unsigned* p, unsigned v) { return __hip_atomic_fetch_add(p, v, __ATOMIC_RELAXED, __HIP_MEMORY_SCOPE_AGENT); }
__device__ __forceinline__ unsigned xb_xcc_id() { return (unsigned)__builtin_amdgcn_s_getreg((3 << 11) | 20) & 0xFu; }
#define XB_SPIN(cond, bar) do { unsigned _sp = 0; while (cond) { __builtin_amdgcn_s_sleep(1); \
    if ((++_sp & 255u) == 0u) { if (xb_ld(&(bar)[XB_TMO])) break; if (_sp > XB_SPIN_CAP) { atomicAdd(&(bar)[XB_TMO], 1u); break; } } } } while (0)

struct XcdBarrier {
    unsigned* bar; unsigned x;
    volatile LAS unsigned* st;
};

__device__ __forceinline__ XcdBarrier xcd_barrier_post(unsigned* bar, volatile LAS unsigned* st) {
    XcdBarrier b; b.bar = bar; b.x = xb_xcc_id(); b.st = st;
    if (threadIdx.x == 0) (void)xb_add(&bar[XB_XCNT(b.x)], 1u);
    return b;
}
__device__ __forceinline__ void xcd_barrier_complete(unsigned* bar, unsigned x, unsigned& nloc, unsigned& nx) {
    const unsigned G = gridDim.x * gridDim.y * gridDim.z;
    unsigned sum, cnt, mine, sp = 0u;
    for (;;) {
        sum = 0u; cnt = 0u; mine = 0u;
#pragma unroll
        for (unsigned j = 0; j < 16; ++j) { const unsigned c = xb_ld(&bar[XB_XCNT(j)]); sum += c; cnt += (c > 0u) ? 1u : 0u; mine = (j == x) ? c : mine; }
        if (sum == G) break;
        __builtin_amdgcn_s_sleep(1);
        if ((++sp & 255u) == 0u) { if (xb_ld(&bar[XB_TMO])) break; if (sp > XB_SPIN_CAP) { atomicAdd(&bar[XB_TMO], 1u); break; } }
    }
    nloc = mine > 0u ? mine : 1u; nx = cnt > 0u ? cnt : 1u;
}

__device__ __forceinline__ void xcd_barrier(const XcdBarrier& b) {
    asm volatile("s_waitcnt vmcnt(0)" ::: "memory");
    __syncthreads();
    if (threadIdx.x == 0) {
        unsigned* bar = b.bar;
        __builtin_amdgcn_s_waitcnt(0);
        unsigned nloc = b.st[0], nx = b.st[1];
        if (nloc == 0u) { xcd_barrier_complete(bar, b.x, nloc, nx); b.st[0] = nloc; b.st[1] = nx; }
        const unsigned old = xb_add(&bar[XB_XSUB(b.x)], 1u);
        const unsigned gen = old / nloc;
        if (old + 1u == (gen + 1u) * nloc) {
            __builtin_amdgcn_fence(__ATOMIC_RELEASE, "agent");
            asm volatile("s_waitcnt vmcnt(0)" ::: "memory");
            const unsigned og = xb_add(&bar[XB_TOP], 1u);
            const unsigned tg = og / nx;
            if (og + 1u == (tg + 1u) * nx) xb_add(&bar[XB_TOPGEN], 1u);
            else XB_SPIN(xb_ld(&bar[XB_TOPGEN]) == tg, bar);
            __builtin_amdgcn_fence(__ATOMIC_ACQUIRE, "agent");
            xb_add(&bar[XB_XGEN(b.x)], 1u);
            asm volatile("s_waitcnt vmcnt(0)" ::: "memory");
        } else {
            XB_SPIN(xb_ld(&bar[XB_XGEN(b.x)]) == gen, bar);
            __builtin_amdgcn_fence(__ATOMIC_ACQUIRE, "agent");
            asm volatile("s_waitcnt vmcnt(0)" ::: "memory");
        }
    }
    __syncthreads();
}

DI void static_unit(int L, int nM, int nN, pg8::Unit& u) {
    const int nwg = nM * nN; int wgid = L; { const int q = nwg / pg8::NXCD, r = nwg % pg8::NXCD, xcd = wgid % pg8::NXCD, off = wgid / pg8::NXCD; wgid = (xcd < r ? xcd * (q + 1) : r * (q + 1) + (xcd - r) * q) + off; }
    const int nig = pg8::WGM * nN, gid = wgid / nig, fm = gid * pg8::WGM, gsz = (nM - fm) < pg8::WGM ? (nM - fm) : pg8::WGM;
    u.pm = fm + ((wgid % nig) % gsz); u.pn = (wgid % nig) / gsz;
}
constexpr int FIN_NN = 2 * DFF / 256, FIN_CTX_UNITS = 2 * FIN_NN, FIN_LAT_UNITS = 64 * FIN_NN;
struct CtxFirstOrder {
    int G, c, lane; unsigned* cnt;
    DI bool next(int i, pg8::Unit& u) const {
        const int L = i * G + c; if (L >= FIN_CTX_UNITS + FIN_LAT_UNITS) return false;
        if (L < FIN_CTX_UNITS) { u.pm = 64 + L / FIN_NN; u.pn = L % FIN_NN; } else static_unit(L - FIN_CTX_UNITS, 64, FIN_NN, u);
        return true;
    }
    DI void a_ready(const pg8::Unit&) const {}
    DI void done(const pg8::Unit& u) const { if (u.pm >= 64) { __threadfence(); if (lane == 0) __hip_atomic_fetch_add(cnt, 1u, __ATOMIC_RELAXED, __HIP_MEMORY_SCOPE_AGENT); } }
};
struct OneUnit {
    int pm, pn;
    DI bool next(int i, pg8::Unit& u) const { if (i) return false; u.pm = pm; u.pn = pn; return true; }
    DI void a_ready(const pg8::Unit&) const {}
    DI void done(const pg8::Unit&) const {}
};
struct EpiPartial {
    static constexpr bool PERM = false, AFTER_DRAIN = false;
    float* P;
    DI void operator()(const f32x4 (&acc)[2][2][4][2], const pg8::Unit& u, int wr, int wc, int fr, int fq) const {
        const int col0 = u.pn * 256 + wc * 32 + 4 * fq;
#pragma unroll
        for (int ai = 0; ai < 2; ++ai)
#pragma unroll
            for (int m = 0; m < 4; ++m) { float* op = P + (size_t)(u.pm * 256 + ai * 128 + wr * 64 + m * 16 + fr) * DM + col0;
#pragma unroll
                for (int bj = 0; bj < 2; ++bj)
#pragma unroll
                    for (int n = 0; n < 2; ++n) *(f32x4*)(op + bj * 128 + n * 16) = acc[ai][bj][m][n]; }
    }
};
DI void ctx_finish_row(const Args& a, int rc, int lane, const float* base, const float* gate, const float* gm, bf16* hbn) {
    unsigned char* ws = a.ws;
    const float* P = (const float*)(ws + WS_PART) + (size_t)rc * DM; float* X = (float*)(ws + WS_X) + (size_t)(ML + rc) * DM;
    const float* bp = base + (size_t)rc * DM; bf16* hb = hbn + (size_t)(ML + rc) * DM; float* ssp = (float*)(ws + WS_SSP) + (size_t)(ML + rc) * 16;
    float ss = 0.f;
#pragma unroll
    for (int j = 0; j < 4; ++j) { const int c = 4 * (lane + 64 * j);
        const f32x4 p0 = *(const f32x4*)(P + c), p1 = *(const f32x4*)(P + (size_t)MC * DM + c), p2 = *(const f32x4*)(P + (size_t)2 * MC * DM + c), p3 = *(const f32x4*)(P + (size_t)3 * MC * DM + c);
        const f32x4 xn = *(const f32x4*)(bp + c) + *(const f32x4*)(gate + c) * (((p0 + p1) + p2) + p3);
        *(f32x4*)(X + c) = xn; ss += (xn[0] * xn[0] + xn[1] * xn[1]) + (xn[2] * xn[2] + xn[3] * xn[3]);
        *(u32x2*)(hb + c) = pack4(xn * *(const f32x4*)(gm + c)); }
    ss = wave_sum(ss);
    if (lane < 16) ssp[lane] = lane == 0 ? ss : 0.f;
}
struct OneUnitCounted {
    int pm, pn, lane; unsigned* cnt;
    DI bool next(int i, pg8::Unit& u) const { if (i) return false; u.pm = pm; u.pn = pn; return true; }
    DI void a_ready(const pg8::Unit&) const {}
    DI void done(const pg8::Unit&) const { __threadfence(); if (lane == 0) __hip_atomic_fetch_add(cnt, 1u, __ATOMIC_RELAXED, __HIP_MEMORY_SCOPE_AGENT); }
};
DI void wait_count(unsigned* cnt, unsigned want, int tid) {
    if (tid == 0) { unsigned sp = 0;
        while (__hip_atomic_load(cnt, __ATOMIC_RELAXED, __HIP_MEMORY_SCOPE_AGENT) < want) { __builtin_amdgcn_s_sleep(2); if (++sp > (1u << 22)) break; }
        __builtin_amdgcn_fence(__ATOMIC_ACQUIRE, "agent"); asm volatile("s_waitcnt vmcnt(0)" ::: "memory"); }
    __syncthreads();
}

constexpr int N_PHASES = 18;
__global__ void __launch_bounds__(NWAVES * 64, 2) fwd_kernel(Args a) {
    extern __shared__ __attribute__((aligned(16))) unsigned char lds_raw[];
    LAS unsigned char* lds = (LAS unsigned char*)lds_raw;
    cg::grid_group grid = cg::this_grid();
    const int tid = threadIdx.x, lane = tid & 63, wave = __builtin_amdgcn_readfirstlane(tid >> 6);
    unsigned char* ws = a.ws;
    const int lo = a.ph_lo, hi = a.ph_hi, G = gridDim.x, bx = blockIdx.x;
#ifndef PHASE_MASK
#define PHASE_MASK 0x3ffff
#endif
#define IN(k) (((PHASE_MASK >> (k)) & 1) && lo <= (k) && (k) < hi)
    {
        if (tid < 64) ((LAS unsigned*)(lds + 131072))[tid] = 0u;
        __syncthreads();
    }
    XcdBarrier bar = xcd_barrier_post((unsigned*)(ws + WS_CTL), (volatile LAS unsigned*)(lds + 131072 + 64));
    if (a.ph_lo < 0) grid.sync();
#define GSYNC() xcd_barrier(bar)
#define SEAM(k) do { if (IN(k) && (k) + 1 < hi) GSYNC(); } while (0)
#ifndef RPT_MASK
#define RPT_MASK 0
#endif
#ifndef RPT_N
#define RPT_N 1
#endif
#ifndef EXTRA_SYNCS
#define EXTRA_SYNCS 0
#endif
#define PHASE(k, ...) do { if (IN(k)) { _Pragma("nounroll") for (int rp_ = 0; rp_ <= ((((RPT_MASK) >> (k)) & 1) ? (RPT_N) : 0); ++rp_) { if (rp_) GSYNC(); __VA_ARGS__; } } SEAM(k); } while (0)
    bf16* HB = (bf16*)(ws + WS_HB); float* X = (float*)(ws + WS_X);
    bf16* U = (bf16*)(ws + WS_R1); bf16* FH = (bf16*)(ws + WS_R1);
    const float* MOD = (const float*)(ws + WS_MOD); const float* GM = (const float*)(ws + WS_GM); const float* BV = (const float*)(ws + WS_BV); float* SSP = (float*)(ws + WS_SSP);
    const float* xin = a.in[0]; const float* ctxin = a.in[2];

    PHASE(0, prologue(a, lds, tid, lane, wave););
    PHASE(1, norm_mod_phase(xin, ctxin, MT, a.in[6], MOD, 0, 1, HB, wave, lane); aux_phase(a, tid, wave, lane););
    PHASE(2, pg8::Gemm g{HB, (const bf16*)(ws + WS_WRCIN), MT, RCW, DM}; pg8::StaticOrder S; S.init(MT, RCW, G, bx);
        EpiStore E{U, RCW}; pg8::gemm_phase<EpiStore, pg8::StaticOrder, true, true>(lds, g, S, E););
    PHASE(3, rg1_phase(a, lds, tid, lane, wave););
    PHASE(4, rg_carry_phase(a, lds, wave, lane); sc_phase(a, wave, lane););
    PHASE(5, rg3_phase(a, wave, lane););
    PHASE(6, const bool split6 = (G == 256);
        if (split6) {
            { pg8::Gemm g{HB, (const bf16*)(ws + WS_WRCOUT), ML, DM, DM, 0}; pg8::StaticOrder S; S.init(ML, DM, G, bx);
              EpiResid E{xin, ctxin, X, MOD + 2 * 1024, (bf16*)a.out, GM, SSP}; pg8::gemm_phase<EpiResid, pg8::StaticOrder, true, true>(lds, g, S, E); }
            unsigned* cnt6 = (unsigned*)(ws + WS_CTL) + CTL_CTXCNT + 64;
            if (bx < 32) { const int sl = bx & 3, cu_ = bx >> 2;
                pg8::Gemm g2{HB + (size_t)ML * DM + sl * 256, (const bf16*)(ws + WS_WRCOUT) + sl * 256, MC, DM, 256, DM}; OneUnitCounted S2{cu_ >> 2, cu_ & 3, lane, cnt6};
                EpiPartial E2{(float*)(ws + WS_PART) + (size_t)sl * MC * DM}; pg8::gemm_phase<EpiPartial, OneUnitCounted, true, true>(lds, g2, S2, E2); }
            else if (bx < 96) { wait_count(cnt6, 8u * 32u, tid);
                ctx_finish_row(a, (bx - 32) * NWAVES + wave, lane, ctxin, MOD + (size_t)2 * 6144 + 2 * 1024, GM + 2 * 1024, (bf16*)a.out); }
        } else { pg8::Gemm g{HB, (const bf16*)(ws + WS_WRCOUT), MT, DM, DM, 0}; pg8::StaticOrder S; S.init(MT, DM, G, bx);
            EpiResid E{xin, ctxin, X, MOD + 2 * 1024, (bf16*)a.out, GM, SSP}; pg8::gemm_phase<EpiResid, pg8::StaticOrder, true, true>(lds, g, S, E); });
    PHASE(8, pg8::Gemm g{(const bf16*)a.out, (const bf16*)(ws + WS_WFIN0), MT, 2 * DFF, DM, 0}; CtxFirstOrder S{G, bx, lane, (unsigned*)(ws + WS_CTL) + CTL_CTXCNT};
        rstd_table(lds, SSP, S, tid); EpiSwiGLU E{FH, DFF, lds, BV}; pg8::gemm_phase<EpiSwiGLU, CtxFirstOrder, true, true>(lds, g, S, E);
        {
            const int nfull = (FIN_CTX_UNITS + FIN_LAT_UNITS) % G, su = bx - nfull;
            if (nfull != 0 && G - nfull >= 32 && su >= 0 && su < 32) {
                wait_count((unsigned*)(ws + WS_CTL) + CTL_CTXCNT, 8u * FIN_CTX_UNITS, tid);
                const int sl = su & 3, cu_ = su >> 2, k0 = sl < 2 ? sl * 768 : 1536 + (sl - 2) * 640, klen = sl < 2 ? 768 : 640;
                pg8::Gemm g2{FH + (size_t)ML * DFF + k0, (const bf16*)(ws + WS_WFOUT0) + k0, MC, DM, klen, DFF}; OneUnit S2{cu_ >> 2, cu_ & 3};
                EpiPartial E2{(float*)(ws + WS_PART) + (size_t)sl * MC * DM}; pg8::gemm_phase<EpiPartial, OneUnit, true, true>(lds, g2, S2, E2);
            }
        });
    PHASE(9, const int nfull9 = (FIN_CTX_UNITS + FIN_LAT_UNITS) % G; const bool split9 = nfull9 != 0 && G - nfull9 >= 32;
        if (split9) { { const int rc = bx * NWAVES + wave; if (rc < MC) ctx_finish_row(a, rc, lane, X + (size_t)ML * DM, MOD + (size_t)2 * 6144 + 5 * 1024, GM + 3072 + 2 * 1024, HB); }
            pg8::Gemm g{FH, (const bf16*)(ws + WS_WFOUT0), ML, DM, DFF, 0}; pg8::StaticOrder S; S.init(ML, DM, G, bx);
            EpiResid E{X, X + (size_t)ML * DM, X, MOD + 5 * 1024, HB, GM + 3072, SSP}; pg8::gemm_phase<EpiResid, pg8::StaticOrder, true, true>(lds, g, S, E); }
        else { pg8::Gemm g{FH, (const bf16*)(ws + WS_WFOUT0), MT, DM, DFF, 0}; pg8::StaticOrder S; S.init(MT, DM, G, bx);
            EpiResid E{X, X + (size_t)ML * DM, X, MOD + 5 * 1024, HB, GM + 3072, SSP}; pg8::gemm_phase<EpiResid, pg8::StaticOrder, true, true>(lds, g, S, E); });
    const float* MOD1 = MOD + 3 * 6144;
    PHASE(11, pg8::Gemm g{HB, (const bf16*)(ws + WS_WQKV), MT, NQKV, DM}; pg8::StaticOrder S; S.init(MT, NQKV, G, bx);
        EpiQKV E{(bf16*)(ws + WS_Q), (bf16*)(ws + WS_KV), (const float*)(ws + WS_ROPEC), (const float*)(ws + WS_ROPES), lds, BV + 3 * 2 * DFF}; rstd_table(lds, SSP, S, tid);
        pg8::gemm_phase<EpiQKV, pg8::StaticOrder, true, true>(lds, g, S, E););
    PHASE(12, attn_phase(a, lds, tid, lane, wave););
    PHASE(13, pg8::Gemm g{(const bf16*)(ws + WS_O), (const bf16*)(ws + WS_WAOUT), ML, DM, DM}; pg8::StaticOrder S; S.init(ML, DM, G, bx);
        EpiResid E{X, X + (size_t)ML * DM, X, MOD1 + 2 * 1024, HB, GM + 2 * 3072, SSP}; pg8::gemm_phase<EpiResid, pg8::StaticOrder, true, true>(lds, g, S, E););
    PHASE(15, pg8::Gemm g{HB, (const bf16*)(ws + WS_WFIN1), ML, 2 * DFF, DM}; pg8::StaticOrder S; S.init(ML, 2 * DFF, G, bx);
        rstd_table(lds, SSP, S, tid); EpiSwiGLU E{FH, DFF, lds, BV + 2 * 3 * 2 * DFF}; pg8::gemm_phase<EpiSwiGLU, pg8::StaticOrder, true, true>(lds, g, S, E););
    PHASE(16, pg8::Gemm g{FH, (const bf16*)(ws + WS_WFOUT1), ML, DM, DFF}; pg8::StaticOrder S; S.init(ML, DM, G, bx);
        EpiResid E{X, X + (size_t)ML * DM, X, MOD1 + 5 * 1024, nullptr, nullptr, nullptr}; pg8::gemm_phase<EpiResid, pg8::StaticOrder, true, true>(lds, g, S, E););
    PHASE(17, final_norm_phase(X, a.in[8], a.out, wave, lane););
    for (int es_ = 0; es_ < EXTRA_SYNCS; ++es_) GSYNC();
#undef IN
#undef SEAM
}

#ifndef MK_MULTI
#define MK_MULTI 0
#endif
extern "C" void kernel_launch(void* const* d_in, const int* in_sizes, int n_in, void* d_out, int out_size, void* d_ws, size_t ws_size, hipStream_t stream) {
    static int grid = 0;
    if (grid == 0) {
        if (n_in != 24 || out_size != ML * DM || ws_size < WS_END) { fprintf(stderr, "kernel_launch: unexpected shapes n_in %d out %d ws %zu\n", n_in, out_size, ws_size); grid = -1; return; }
        int dev = 0, cus = 0, per_cu = 0;
        hipGetDevice(&dev); hipDeviceGetAttribute(&cus, hipDeviceAttributeMultiprocessorCount, dev);
        if (hipFuncSetAttribute((const void*)fwd_kernel, hipFuncAttributeMaxDynamicSharedMemorySize, LDS_BYTES) != hipSuccess) { fprintf(stderr, "kernel_launch: hipFuncSetAttribute failed\n"); grid = -1; return; }
        if (hipOccupancyMaxActiveBlocksPerMultiprocessor(&per_cu, (const void*)fwd_kernel, NWAVES * 64, LDS_BYTES) != hipSuccess || per_cu < 1) { fprintf(stderr, "kernel_launch: occupancy query says %d\n", per_cu); per_cu = 1; }
        (void)hipGetLastError();
        grid = cus * 1;
    }
    if (grid < 0) return;
    Args a{};
    for (int i = 0; i < 24; ++i) a.in[i] = (const float*)d_in[i];
    a.out = (float*)d_out; a.ws = (unsigned char*)d_ws;
#if MK_MULTI
    for (int p = 0; p < N_PHASES; ++p) { a.ph_lo = p; a.ph_hi = p + 1; hipLaunchKernelGGL(fwd_kernel, dim3(grid), dim3(NWAVES * 64), LDS_BYTES, stream, a); }
#else
    a.ph_lo = 0; a.ph_hi = N_PHASES;
    if (hipMemsetAsync((char*)d_ws + WS_CTL, 0, CTL_BYTES, stream) != hipSuccess) { fprintf(stderr, "kernel_launch: memset failed\n"); return; }
    void* args[] = {&a};
    hipError_t e = hipLaunchCooperativeKernel((const void*)fwd_kernel, dim3(grid), dim3(NWAVES * 64), args, LDS_BYTES, stream);
    if (e != hipSuccess) fprintf(stderr, "kernel_launch: cooperative launch failed: %s (grid %d)\n", hipGetErrorString(e), grid);
#endif
}
```

```cpp
#include <hip/hip_runtime.h>
#include <hip/hip_cooperative_groups.h>
#include <cstdio>
#include <cstdint>
namespace cg = cooperative_groups;
namespace pg8 {
#define PG8_LAS __attribute__((address_space(3)))
typedef unsigned short bf16_t;
typedef short bf16x8 __attribute__((ext_vector_type(8)));
typedef float f32x4 __attribute__((ext_vector_type(4)));
typedef unsigned u32x4 __attribute__((ext_vector_type(4)));
constexpr int BM = 256, BK = 64, HALF = 128, HTB = HALF * BK * 2  , STAGE_BYTES = 8 * HTB, NXCD = 8, WGM = 8;

__host__ __device__ __forceinline__ int lds_byte(int r, int c) { const int st = (r >> 4) * 2 + (c >> 5), rr = r & 15, cc = c & 31, ob = rr * 64 + cc * 2; return st * 1024 + (ob ^ (((ob >> 9) & 1) << 5)); }
__host__ __device__ __forceinline__ void stage_rc(int b, int& R, int& C) { const int st = b / 1024, sb = b % 1024, swz = sb ^ (((sb >> 9) & 1) << 5); R = (st >> 1) * 16 + swz / 64; C = (st & 1) * 32 + (swz % 64) / 2; }
__host__ __device__ __forceinline__ int perm32(int rho) { const int n = rho >> 4, i = rho & 15; return 8 * (i >> 2) + 4 * n + (i & 3); }

struct Unit { int pm, pn, ord; };
struct Gemm { const bf16_t* A; const bf16_t* Bt; int M, N, K, ld; };

struct StaticOrder {
    int nM, nN, nwg, G, c;
    __host__ __device__ void init(int M, int N, int G_, int c_) { nM = M / BM; nN = N / BM; nwg = nM * nN; G = G_; c = c_; }
    __host__ __device__ bool next(int i, Unit& u) const {
        const long L = (long)i * G + c; if (L >= nwg) return false;
        int wgid = (int)L; { const int q = nwg / NXCD, r = nwg % NXCD, xcd = wgid % NXCD, off = wgid / NXCD; wgid = (xcd < r ? xcd * (q + 1) : r * (q + 1) + (xcd - r) * q) + off; }
        const int nig = WGM * nN, gid = wgid / nig, fm = gid * WGM, gsz = (nM - fm) < WGM ? (nM - fm) : WGM;
        u.pm = fm + ((wgid % nig) % gsz); u.pn = (wgid % nig) / gsz; return true;
    }
    __device__ __forceinline__ void a_ready(const Unit&) const {}
    __device__ __forceinline__ void done(const Unit&) const {}
};
template <class Epi, class Sched, bool ALIGN_EPI = false, bool SP2 = false>
__device__ __forceinline__ void gemm_phase(PG8_LAS unsigned char* lds, const Gemm g, const Sched& S, const Epi& E) {
    const int tid = threadIdx.x, wid = __builtin_amdgcn_readfirstlane(tid >> 6), lane = tid & 63, wr = wid >> 2, wc = wid & 3, fr = lane & 15, fq = lane >> 4;
    const int nt = g.K / BK, K = g.ld ? g.ld : g.K;
    unsigned voffA[2], voffB[2];
#pragma unroll
    for (int i = 0; i < 2; ++i) { int R, C; stage_rc(tid * 16 + i * 8192, R, C); const int Rb = Epi::PERM ? ((R & ~31) + perm32(R & 31)) : R;
        voffA[i] = (unsigned)(R * K + C) * 2u; voffB[i] = (unsigned)(Rb * K + C) * 2u; }
    const size_t kstep = (size_t)(BK * 2);
    const size_t hstep = (size_t)HALF * K * 2;
    const size_t tstep = 2 * hstep;
    const unsigned ldsw = (unsigned)wid * 1024u;
    const int aoff = lds_byte(wr * 64 + fr, fq * 8), boff = lds_byte(wc * 32 + fr, fq * 8);
#define PG8_SA(b, h) (((b) * 2 + (h)) * HTB)
#define PG8_SB(b, h) ((4 + (b) * 2 + (h)) * HTB)
#define PG8_STAGE(bufoff, gbase, voff) do { _Pragma("unroll") for (int _i = 0; _i < 2; ++_i) \
        __builtin_amdgcn_global_load_lds((const unsigned*)((const char*)(gbase) + (voff)[_i]), (PG8_LAS unsigned*)(lds + (bufoff) + ldsw + _i * 8192), 16, 0, 0); } while (0)
#define PG8_LDA(dst, b, h) do { _Pragma("unroll") for (int m = 0; m < 4; ++m) _Pragma("unroll") for (int k = 0; k < 2; ++k) dst[m][k] = *(const PG8_LAS bf16x8*)(lds + PG8_SA(b, h) + aoff + m * 2048 + k * 1024); } while (0)
#define PG8_LDB(dst, b, h) do { _Pragma("unroll") for (int n = 0; n < 2; ++n) _Pragma("unroll") for (int k = 0; k < 2; ++k) dst[n][k] = *(const PG8_LAS bf16x8*)(lds + PG8_SB(b, h) + boff + n * 2048 + k * 1024); } while (0)
#define PG8_MMA(ai, bj, At, Bt) do { __builtin_amdgcn_s_setprio(1); _Pragma("unroll") for (int m = 0; m < 4; ++m) _Pragma("unroll") for (int n = 0; n < 2; ++n) _Pragma("unroll") for (int k = 0; k < 2; ++k) \
        acc[ai][bj][m][n] = __builtin_amdgcn_mfma_f32_16x16x32_bf16(Bt[n][k], At[m][k], acc[ai][bj][m][n], 0, 0, 0); __builtin_amdgcn_s_setprio(0); } while (0)
#define PG8_WAIT_V(n) asm volatile("s_waitcnt vmcnt(" #n ")" ::: "memory")
#define PG8_WAIT_L(n) asm volatile("s_waitcnt lgkmcnt(" #n ")" ::: "memory")
#define PG8_BAR __builtin_amdgcn_s_barrier()
#define PG8_SCHED __builtin_amdgcn_sched_barrier(0)
    Unit cur, nxt; int ui = 0;
    if (!S.next(0, cur)) return; cur.ord = 0;
    f32x4 acc[2][2][4][2];
#pragma unroll
    for (int a = 0; a < 2; ++a)
#pragma unroll
        for (int b = 0; b < 2; ++b)
#pragma unroll
            for (int m = 0; m < 4; ++m)
#pragma unroll
                for (int n = 0; n < 2; ++n) acc[a][b][m][n] = (f32x4){0.f, 0.f, 0.f, 0.f};
    bf16x8 At[4][2], B0[2][2], B1[2][2];
    const char* cA = (const char*)g.A + (size_t)cur.pm * tstep; const char* cB = (const char*)g.Bt + (size_t)cur.pn * tstep;
    S.a_ready(cur);
    if constexpr (SP2) {
        PG8_STAGE(PG8_SB(0, 0), cB, voffB); PG8_STAGE(PG8_SB(0, 1), cB + hstep, voffB); PG8_STAGE(PG8_SA(0, 0), cA, voffA); PG8_STAGE(PG8_SA(0, 1), cA + hstep, voffA);
        if (wr == 1) PG8_BAR;
        PG8_WAIT_V(2); PG8_BAR;
        PG8_STAGE(PG8_SB(1, 0), cB + kstep, voffB); PG8_STAGE(PG8_SA(1, 0), cA + kstep, voffA); PG8_STAGE(PG8_SB(1, 1), cB + hstep + kstep, voffB);
        PG8_WAIT_V(6); PG8_BAR;
    } else {
        PG8_STAGE(PG8_SB(0, 0), cB, voffB); PG8_STAGE(PG8_SA(0, 0), cA, voffA); PG8_STAGE(PG8_SB(0, 1), cB + hstep, voffB); PG8_STAGE(PG8_SA(0, 1), cA + hstep, voffA);
        if (wr == 1) PG8_BAR;
        PG8_WAIT_V(4); PG8_BAR;
        PG8_STAGE(PG8_SB(1, 0), cB + kstep, voffB); PG8_STAGE(PG8_SA(1, 0), cA + kstep, voffA); PG8_STAGE(PG8_SB(1, 1), cB + hstep + kstep, voffB);
        PG8_WAIT_V(6); PG8_BAR;
    }
    for (;;) {
        const bool has_next = S.next(ui + 1, nxt); nxt.ord = ui + 1;
        const char* nA = has_next ? (const char*)g.A + (size_t)nxt.pm * tstep : cA; const char* nB = has_next ? (const char*)g.Bt + (size_t)nxt.pn * tstep : cB;
        for (int t = 0; t < nt; t += 2) {
            const bool last = (t == nt - 2);
            const char* a1 = cA + (size_t)(t + 1) * kstep;
            const char* a2 = last ? nA : cA + (size_t)(t + 2) * kstep; const char* b2 = last ? nB : cB + (size_t)(t + 2) * kstep;
            const char* a3 = a2 + kstep; const char* b3 = b2 + kstep;
            if (last && has_next) S.a_ready(nxt);
            if constexpr (SP2) {
            PG8_LDB(B0, 0, 0); PG8_LDB(B1, 0, 1); PG8_SCHED; PG8_LDA(At, 0, 0); PG8_STAGE(PG8_SA(1, 1), a1 + hstep, voffA);
            PG8_WAIT_V(8); PG8_WAIT_L(0); PG8_BAR; PG8_MMA(0, 0, At, B0); PG8_MMA(0, 1, At, B1); PG8_BAR; PG8_SCHED;
            PG8_LDA(At, 0, 1); PG8_STAGE(PG8_SB(0, 0), b2, voffB); PG8_STAGE(PG8_SB(0, 1), b2 + hstep, voffB); PG8_STAGE(PG8_SA(0, 0), a2, voffA);
            PG8_WAIT_V(8); PG8_WAIT_L(0); PG8_BAR; PG8_MMA(1, 0, At, B0); PG8_MMA(1, 1, At, B1); PG8_BAR; PG8_SCHED;
            PG8_LDB(B0, 1, 0); PG8_LDB(B1, 1, 1); PG8_SCHED; PG8_LDA(At, 1, 0); PG8_STAGE(PG8_SA(0, 1), a2 + hstep, voffA);
            PG8_WAIT_V(8); PG8_WAIT_L(0); PG8_BAR; PG8_MMA(0, 0, At, B0); PG8_MMA(0, 1, At, B1); PG8_BAR; PG8_SCHED;
            PG8_LDA(At, 1, 1); PG8_STAGE(PG8_SB(1, 0), b3, voffB); PG8_STAGE(PG8_SB(1, 1), b3 + hstep, voffB); PG8_STAGE(PG8_SA(1, 0), a3, voffA);
            PG8_WAIT_V(8); PG8_WAIT_L(0); PG8_BAR; PG8_MMA(1, 0, At, B0); PG8_MMA(1, 1, At, B1); PG8_BAR; PG8_SCHED;
            } else {
            PG8_LDB(B0, 0, 0); PG8_SCHED; PG8_LDA(At, 0, 0); PG8_STAGE(PG8_SA(1, 1), a1 + hstep, voffA);
            PG8_WAIT_L(8); PG8_BAR; PG8_WAIT_L(0); PG8_MMA(0, 0, At, B0); PG8_BAR; PG8_SCHED;
            PG8_LDB(B1, 0, 1); PG8_STAGE(PG8_SB(0, 0), b2, voffB);
            PG8_BAR; PG8_WAIT_L(0); PG8_MMA(0, 1, At, B1); PG8_BAR;
            PG8_LDA(At, 0, 1); PG8_STAGE(PG8_SA(0, 0), a2, voffA);
            PG8_BAR; PG8_WAIT_L(0); PG8_MMA(1, 0, At, B0); PG8_BAR; PG8_SCHED;
            PG8_STAGE(PG8_SB(0, 1), b2 + hstep, voffB);
            PG8_WAIT_V(6); PG8_BAR; PG8_MMA(1, 1, At, B1); PG8_BAR;
            PG8_LDB(B0, 1, 0); PG8_SCHED; PG8_LDA(At, 1, 0); PG8_STAGE(PG8_SA(0, 1), a2 + hstep, voffA);
            PG8_WAIT_L(8); PG8_BAR; PG8_WAIT_L(0); PG8_MMA(0, 0, At, B0); PG8_BAR; PG8_SCHED;
            PG8_LDB(B1, 1, 1); PG8_STAGE(PG8_SB(1, 0), b3, voffB);
            PG8_BAR; PG8_WAIT_L(0); PG8_MMA(0, 1, At, B1); PG8_BAR;
            PG8_LDA(At, 1, 1); PG8_STAGE(PG8_SA(1, 0), a3, voffA);
            PG8_BAR; PG8_WAIT_L(0); PG8_MMA(1, 0, At, B0); PG8_BAR; PG8_SCHED;
            PG8_STAGE(PG8_SB(1, 1), b3 + hstep, voffB);
            PG8_WAIT_V(6); PG8_BAR; PG8_MMA(1, 1, At, B1); PG8_BAR;
            }
        }
        if constexpr (ALIGN_EPI) { if (wr == 0) PG8_BAR; }
        if constexpr (!Epi::AFTER_DRAIN) { E(acc, cur, wr, wc, fr, fq); S.done(cur); }
        if (!has_next) break;
#pragma unroll
        for (int a = 0; a < 2; ++a)
#pragma unroll
            for (int b = 0; b < 2; ++b)
#pragma unroll
                for (int m = 0; m < 4; ++m)
#pragma unroll
                    for (int n = 0; n < 2; ++n) acc[a][b][m][n] = (f32x4){0.f, 0.f, 0.f, 0.f};
        cur = nxt; cA = nA; cB = nB; ++ui;
        if constexpr (ALIGN_EPI) { if (wr == 1) PG8_BAR; }
    }
    PG8_WAIT_V(0);
    if constexpr (!ALIGN_EPI) { if (wr == 0) PG8_BAR; }
    PG8_BAR;
    if constexpr (Epi::AFTER_DRAIN) { E.fused(acc, cur, wr, wc, fr, fq, lds, wid, lane); S.done(cur); }
#undef PG8_SA
#undef PG8_SB
#undef PG8_STAGE
#undef PG8_LDA
#undef PG8_LDB
#undef PG8_MMA
#undef PG8_WAIT_V
#undef PG8_WAIT_L
#undef PG8_BAR
#undef PG8_SCHED
}
}

#define DI __device__ __forceinline__
#define LAS __attribute__((address_space(3)))
typedef unsigned short bf16;
typedef pg8::f32x4 f32x4;
typedef pg8::bf16x8 bf16x8;
typedef pg8::u32x4 u32x4;
typedef unsigned u32x2 __attribute__((ext_vector_type(2)));
typedef float f32x16 __attribute__((ext_vector_type(16)));
typedef float f32x2_t __attribute__((ext_vector_type(2)));
typedef __bf16 bf16x2_t __attribute__((ext_vector_type(2)));

constexpr int DM = 1024, NB = 2, SEQ = 8192, CTX = 256;
constexpr int ML = NB * SEQ, MC = NB * CTX, MT = ML + MC;
constexpr int DFF = 2816, RCW = 2560, NQKV = 1536, DLRU = 512;
constexpr int NCH = 264;
constexpr int NWAVES = 8;
constexpr float LOG2E = 1.4426950408889634f;
constexpr float QSCALE = 0.125f * LOG2E;

constexpr size_t MiB = 1u << 20;
constexpr size_t WS_WRCIN = 0, WS_WRCOUT = 5 * MiB, WS_WFIN0 = 7 * MiB, WS_WFIN1 = 18 * MiB, WS_WFOUT0 = 29 * MiB, WS_WFOUT1 = 29 * MiB + 5632 * 1024,
                 WS_WQKV = 40 * MiB, WS_WAOUT = 43 * MiB;
constexpr size_t WS_SMALL = 45 * MiB;
constexpr size_t WS_GW = WS_SMALL, WS_MOD = WS_SMALL + 256 * 1024, WS_ROPEC = WS_SMALL + 512 * 1024, WS_ROPES = WS_ROPEC + 8192, WS_SP8 = WS_ROPES + 8192,
                 WS_SUMA = WS_SMALL + 1 * MiB, WS_SUMB = WS_SMALL + 3 * MiB + 256 * 1024, WS_HIN = WS_SMALL + 5 * MiB + 512 * 1024;
constexpr size_t WS_HB = 53 * MiB;
constexpr size_t WS_X = 86 * MiB;
constexpr size_t WS_R1 = 152 * MiB;
constexpr size_t WS_Q = WS_R1, WS_KV = WS_R1 + 33 * MiB, WS_O = WS_KV + 17 * MiB;
constexpr size_t WS_SSP = 244 * MiB;
constexpr size_t WS_BV = 246 * MiB, WS_GM = 247 * MiB;
constexpr size_t WS_BTAIL = 235 * MiB;
constexpr size_t WS_CTL = 243 * MiB, CTL_BYTES = 65536;
constexpr size_t WS_PART = 248 * MiB;
constexpr size_t WS_END = 256 * MiB;
constexpr int CTL_CTXCNT = 4096;
static_assert(WS_O + (size_t)ML * DM * 2 <= WS_CTL && WS_R1 + (size_t)MT * DFF * 2 <= WS_CTL, "ws map");
static_assert(WS_SUMB - WS_SUMA >= (size_t)NB * NCH * 2 * DLRU * 4 && WS_HIN + (size_t)NB * NCH * 2 * DLRU * 4 <= WS_HB, "ws small map");

constexpr int LDS_BYTES = 147456;

struct Args { const float* in[24]; float* out; unsigned char* ws; int ph_lo, ph_hi; };

DI unsigned pk2(float lo, float hi) { f32x2_t v = {lo, hi}; bf16x2_t b = __builtin_convertvector(v, bf16x2_t); return __builtin_bit_cast(unsigned, b); }
DI float bflo(unsigned u) { return __uint_as_float(u << 16); }
DI float bfhi(unsigned u) { return __uint_as_float(u & 0xffff0000u); }
DI f32x4 unpack4(u32x2 u) { return (f32x4){bflo(u.x), bfhi(u.x), bflo(u.y), bfhi(u.y)}; }
DI u32x2 pack4(f32x4 v) { u32x2 r; r.x = pk2(v[0], v[1]); r.y = pk2(v[2], v[3]); return r; }
DI float wave_sum(float v) {
#pragma unroll
    for (int o = 1; o < 64; o <<= 1) v += __shfl_xor(v, o);
    return v;
}
DI float fast_exp(float x) { return __builtin_amdgcn_exp2f(x * LOG2E); }
DI float sigmoidf_(float x) { return __builtin_amdgcn_rcpf(1.f + fast_exp(-x)); }
DI float siluf_(float x) { return x * sigmoidf_(x); }
DI float gelu_tanh(float x) { const float u = 0.7978845608028654f * (x + 0.044715f * x * x * x); return x * __builtin_amdgcn_rcpf(1.f + fast_exp(-2.f * u)); }
DI int bsel(int row) { return row < SEQ ? 0 : (row < ML ? 1 : 2); }

struct EpiStore {
    static constexpr bool PERM = true, AFTER_DRAIN = false;
    bf16* O; int ldc;
    DI void operator()(const f32x4 (&acc)[2][2][4][2], const pg8::Unit& u, int wr, int wc, int fr, int fq) const {
        const int row0 = u.pm * 256 + wr * 64 + fr, col0 = u.pn * 256 + wc * 32 + 8 * fq;
#pragma unroll
        for (int ai = 0; ai < 2; ++ai)
#pragma unroll
            for (int m = 0; m < 4; ++m) { bf16* rowp = O + (size_t)(row0 + ai * 128 + m * 16) * ldc + col0;
#pragma unroll
                for (int bj = 0; bj < 2; ++bj) { const f32x4 v0 = acc[ai][bj][m][0], v1 = acc[ai][bj][m][1];
                    u32x4 w; w.x = pk2(v0[0], v0[1]); w.y = pk2(v0[2], v0[3]); w.z = pk2(v1[0], v1[1]); w.w = pk2(v1[2], v1[3]);
                    *(u32x4*)(rowp + bj * 128) = w; } }
    }
};
constexpr int RS_TAB_OFF = 132096, RS_TAB_UNITS = 12;
template <class Sched> DI void rstd_table(LAS unsigned char* lds, const float* ssp, const Sched& S, int tid) {
    LAS float* tab = (LAS float*)(lds + RS_TAB_OFF);
    pg8::Unit u;
    for (int i = 0; i < RS_TAB_UNITS && S.next(i, u); ++i) {
        const int rr = tid >> 1, hf = tid & 1; const f32x4* q = (const f32x4*)(ssp + (size_t)(u.pm * 256 + rr) * 16 + hf * 8); const f32x4 a = q[0], b = q[1];
        float s = ((a[0] + a[1]) + (a[2] + a[3])) + ((b[0] + b[1]) + (b[2] + b[3]));
        s += __shfl_xor(s, 1);
        if (hf == 0) tab[i * 256 + rr] = 1.0f / sqrtf(s * (1.f / DM) + 1e-6f);
    }
    __syncthreads();
}
DI float row_rstd(LAS unsigned char* lds, int ord, int rin) { return ((const LAS float*)(lds + RS_TAB_OFF))[ord * 256 + rin]; }
struct EpiSwiGLU {
    static constexpr bool PERM = true, AFTER_DRAIN = false;
    bf16* O; int ldc; LAS unsigned char* lds; const float* bias;
    DI void operator()(const f32x4 (&acc)[2][2][4][2], const pg8::Unit& u, int wr, int wc, int fr, int fq) const {
        const int row0 = u.pm * 256 + wr * 64 + fr, col0 = u.pn * 128 + wc * 32 + 8 * fq;
        const int bs = u.pm < 32 ? 0 : (u.pm < 64 ? 1 : 2);
        const float* bp = bias + bs * (2 * DFF) + u.pn * 256 + wc * 32 + 8 * fq;
        f32x4 bv[2][2];
#pragma unroll
        for (int bj = 0; bj < 2; ++bj)
#pragma unroll
            for (int n = 0; n < 2; ++n) bv[bj][n] = *(const f32x4*)(bp + bj * 128 + 4 * n);
#pragma unroll
        for (int ai = 0; ai < 2; ++ai)
#pragma unroll
            for (int m = 0; m < 4; ++m) { const int r = row0 + ai * 128 + m * 16; bf16* rowp = O + (size_t)r * ldc + col0;
                const float rs = row_rstd(lds, u.ord, wr * 64 + fr + ai * 128 + m * 16);
                float v[8];
#pragma unroll
                for (int n = 0; n < 2; ++n)
#pragma unroll
                    for (int j = 0; j < 4; ++j) v[n * 4 + j] = siluf_(__builtin_fmaf(acc[ai][0][m][n][j], rs, bv[0][n][j])) * __builtin_fmaf(acc[ai][1][m][n][j], rs, bv[1][n][j]);
                u32x4 w; w.x = pk2(v[0], v[1]); w.y = pk2(v[2], v[3]); w.z = pk2(v[4], v[5]); w.w = pk2(v[6], v[7]);
                *(u32x4*)rowp = w; }
    }
};
struct EpiResid {
    static constexpr bool PERM = false, AFTER_DRAIN = false;
    const float* baseL; const float* baseC;
    float* X; const float* gate;
    bf16* HBn; const float* gm; float* ssp;
    DI void operator()(const f32x4 (&acc)[2][2][4][2], const pg8::Unit& u, int wr, int wc, int fr, int fq) const {
        const int bs = u.pm < 32 ? 0 : (u.pm < 64 ? 1 : 2);
        const int col0 = u.pn * 256 + wc * 32 + 4 * fq;
        const float* gp = gate + bs * 6144 + col0;
        f32x4 gv[2][2], gmv[2][2];
#pragma unroll
        for (int bj = 0; bj < 2; ++bj)
#pragma unroll
            for (int n = 0; n < 2; ++n) { gv[bj][n] = *(const f32x4*)(gp + bj * 128 + n * 16); if (HBn) gmv[bj][n] = *(const f32x4*)(gm + bs * 1024 + col0 + bj * 128 + n * 16); }
#pragma unroll
        for (int ai = 0; ai < 2; ++ai)
#pragma unroll
            for (int m = 0; m < 4; ++m) { const int r = u.pm * 256 + ai * 128 + wr * 64 + m * 16 + fr;
                const float* bp = (r < ML ? baseL + (size_t)r * DM : baseC + (size_t)(r - ML) * DM) + col0;
                float* op = X + (size_t)r * DM + col0;
                float ss = 0.f;
#pragma unroll
                for (int bj = 0; bj < 2; ++bj)
#pragma unroll
                    for (int n = 0; n < 2; ++n) { const f32x4 b4 = *(const f32x4*)(bp + bj * 128 + n * 16);
                        const f32x4 xn = b4 + gv[bj][n] * acc[ai][bj][m][n];
                        *(f32x4*)(op + bj * 128 + n * 16) = xn;
                        if (HBn) { ss += (xn[0] * xn[0] + xn[1] * xn[1]) + (xn[2] * xn[2] + xn[3] * xn[3]);
                            *(u32x2*)(HBn + (size_t)r * DM + col0 + bj * 128 + n * 16) = pack4(xn * gmv[bj][n]); } }
                if (HBn) { ss += __shfl_xor(ss, 16); ss += __shfl_xor(ss, 32); if (fq == 0) ssp[(size_t)r * 16 + u.pn * 4 + wc] = ss; } }
    }
};
struct EpiQKV {
    static constexpr bool PERM = false, AFTER_DRAIN = false;
    bf16 *Q, *KV; const float *ropec, *ropes; LAS unsigned char* lds; const float* bias;
    DI void operator()(const f32x4 (&acc)[2][2][4][2], const pg8::Unit& u, int wr, int wc, int fr, int fq) const {
        const bool rope_on = (u.pm < 64) && (u.pn < 5);
        const float scale = u.pn < 4 ? QSCALE : 1.0f;
        bf16* dst = u.pn < 4 ? Q + u.pn * 256 : KV + (u.pn - 4) * 256; const int ld = u.pn < 4 ? DM : 512;
        const int ax = wc & 1, cc = wc * 32 + 4 * fq;
        const int bs = u.pm < 32 ? 0 : (u.pm < 64 ? 1 : 2);
        const float* bp = bias + bs * NQKV + u.pn * 256 + cc;
        f32x4 bv[2][2];
#pragma unroll
        for (int bj = 0; bj < 2; ++bj)
#pragma unroll
            for (int n = 0; n < 2; ++n) bv[bj][n] = *(const f32x4*)(bp + bj * 128 + n * 16);
#pragma unroll
        for (int ai = 0; ai < 2; ++ai)
#pragma unroll
            for (int m = 0; m < 4; ++m) { const int r = u.pm * 256 + ai * 128 + wr * 64 + m * 16 + fr;
                const float rs = row_rstd(lds, u.ord, ai * 128 + wr * 64 + m * 16 + fr);
                const int s = r & (SEQ - 1); const int pos = ax ? (s & 63) : (s >> 6);
                f32x4 c4 = (f32x4){1.f, 1.f, 1.f, 1.f}, s4 = (f32x4){0.f, 0.f, 0.f, 0.f};
                if (rope_on) { c4 = *(const f32x4*)(ropec + pos * 16 + 4 * fq); s4 = *(const f32x4*)(ropes + pos * 16 + 4 * fq); }
                bf16* p = dst + (size_t)r * ld + cc;
#pragma unroll
                for (int bj = 0; bj < 2; ++bj) { const f32x4 x1 = acc[ai][bj][m][0] * rs + bv[bj][0], x2 = acc[ai][bj][m][1] * rs + bv[bj][1];
                    const f32x4 o1 = (x1 * c4 - x2 * s4) * scale, o2 = (x2 * c4 + x1 * s4) * scale;
                    *(u32x2*)(p + bj * 128) = pack4(o1); *(u32x2*)(p + bj * 128 + 16) = pack4(o2); } }
    }
};

DI void transpose_item(const float* W, int ldN, bf16* WT, int K, int k0, int src_n0, int dst_n0, LAS float* scr, int lane) {
    float tv[32];
#pragma unroll
    for (int i = 0; i < 32; ++i) tv[i] = W[(size_t)(k0 + 2 * i + (lane >> 5)) * ldN + src_n0 + (lane & 31)];
#pragma unroll
    for (int i = 0; i < 32; ++i) scr[(2 * i + (lane >> 5)) * 33 + (lane & 31)] = tv[i];
    asm volatile("s_waitcnt lgkmcnt(0)" ::: "memory");
    const int c = lane & 7;
#pragma unroll
    for (int j = 0; j < 4; ++j) { const int n = (lane >> 3) + 8 * j; const LAS float* s = scr + (8 * c) * 33 + n;
        u32x4 o; o.x = pk2(s[0 * 33], s[1 * 33]); o.y = pk2(s[2 * 33], s[3 * 33]); o.z = pk2(s[4 * 33], s[5 * 33]); o.w = pk2(s[6 * 33], s[7 * 33]);
        *(u32x4*)(WT + (size_t)(dst_n0 + n) * K + k0 + 8 * c) = o; }
    asm volatile("s_waitcnt lgkmcnt(0)" ::: "memory");
}
DI void mat_item(int r, const float* W, int K, int N, bf16* WT, bool remap, LAS float* scr, int lane) {
    const int nblk = N / 32, kb = r / nblk, nb = r % nblk; const int dst_n0 = 32 * nb; int src_n0 = dst_n0;
    if (remap) { const int pn = dst_n0 >> 8, w = dst_n0 & 255; src_n0 = (w < 128) ? 128 * pn + w : DFF + 128 * pn + (w - 128); }
    transpose_item(W, N, WT, K, 64 * kb, src_n0, dst_n0, scr, lane);
}
DI void prologue(const Args& a, LAS unsigned char* lds, int tid, int lane, int wave) {
    unsigned char* ws = a.ws;
    {
        LAS float* scr = (LAS float*)(lds + wave * 16384);
        const int gw = blockIdx.x * NWAVES + wave, NGW = gridDim.x * NWAVES;
        constexpr int I0 = 16 * 80, I1 = 16 * 32, I2 = 16 * 176, I4 = 44 * 32, I6 = 16 * 48, I7 = 16 * 32;
        constexpr int NITEMS = I0 + I1 + 2 * I2 + 2 * I4 + I6 + I7;
        for (int it = gw; it < NITEMS; it += NGW) {
            int r = it;
            if (r < I0) { mat_item(r, a.in[11], 1024, RCW, (bf16*)(ws + WS_WRCIN), false, scr, lane); continue; } r -= I0;
            if (r < I1) { mat_item(r, a.in[20], 1024, 1024, (bf16*)(ws + WS_WRCOUT), false, scr, lane); continue; } r -= I1;
            if (r < I2) { mat_item(r, a.in[9], 1024, 2 * DFF, (bf16*)(ws + WS_WFIN0), true, scr, lane); continue; } r -= I2;
            if (r < I2) { mat_item(r, a.in[9] + (size_t)1024 * 2 * DFF, 1024, 2 * DFF, (bf16*)(ws + WS_WFIN1), true, scr, lane); continue; } r -= I2;
            if (r < I4) { mat_item(r, a.in[10], DFF, 1024, (bf16*)(ws + WS_WFOUT0), false, scr, lane); continue; } r -= I4;
            if (r < I4) { mat_item(r, a.in[10] + (size_t)DFF * 1024, DFF, 1024, (bf16*)(ws + WS_WFOUT1), false, scr, lane); continue; } r -= I4;
            if (r < I6) { mat_item(r, a.in[21], 1024, NQKV, (bf16*)(ws + WS_WQKV), false, scr, lane); continue; } r -= I6;
            mat_item(r, a.in[23], 1024, 1024, (bf16*)(ws + WS_WAOUT), false, scr, lane);
        }
    }
    {
        const int gt = blockIdx.x * 512 + tid, NT = gridDim.x * 512;
        bf16* GW = (bf16*)(ws + WS_GW);
        for (int idx = gt; idx < 131072; idx += NT) {
            const int j = idx & 7, ln = (idx >> 3) & 63, ks = (idx >> 9) & 3, mt = (idx >> 11) & 1, head = (idx >> 12) & 7, dg = idx >> 15;
            const int hi = ln >> 5, m = ln & 31;
            const int cin = 32 * (ks >> 1) + 16 * (ks & 1) + 8 * (j >> 2) + 4 * hi + (j & 3), cout = 32 * mt + m;
            const int d = dg >> 1; const float* src = (dg & 1) ? a.in[16] : a.in[14];
            const float v = src[((size_t)(d * 8 + head) * 64 + cin) * 64 + cout];
            GW[idx] = (bf16)(pk2(v, 0.f) & 0xffffu);
        }
        float* sp8 = (float*)(ws + WS_SP8);
        for (int idx = gt; idx < 2 * DLRU; idx += NT) sp8[idx] = -8.0f * log1pf(expf(-a.in[18][idx]));
        float* rc = (float*)(ws + WS_ROPEC); float* rs = (float*)(ws + WS_ROPES);
        for (int idx = gt; idx < 2048; idx += NT) {
            const int pos = idx >> 4, f = idx & 15;
            const float inv = (float)exp2(-(double)f * (13.287712379549449 / 16.0));
            const float ang = (float)pos * inv;
            double x = (double)ang; const double n = rint(x * 0.15915494309189535); x -= n * 6.283185307179586476925;
            const double x2 = x * x; double cs = 1.0, sn = 1.0;
            { double t = 1.0, s = 1.0;
              for (int i = 1; i <= 14; ++i) { t *= -x2 / (double)((2 * i - 1) * (2 * i)); s += t; } cs = s; }
            { double t = 1.0, s = 1.0;
              for (int i = 1; i <= 14; ++i) { t *= -x2 / (double)((2 * i) * (2 * i + 1)); s += t; } sn = s * x; }
            rc[idx] = (float)cs; rs[idx] = (float)sn;
        }
    }
    {
        LAS float* red = (LAS float*)lds;
        float* MOD = (float*)(ws + WS_MOD);
        for (int it = blockIdx.x; it < 192; it += gridDim.x) {
            __syncthreads();
            const int l = it / 96, n0 = (it % 96) * 64, cl = lane & 15, ksub = lane >> 4;
            f32x4 a0 = {0.f, 0.f, 0.f, 0.f}, a1 = a0, a2 = a0;
            const float* wbase = a.in[4] + (size_t)l * 1024 * 6144 + n0 + 4 * cl;
#pragma unroll 16
            for (int i = 0; i < 32; ++i) { const int k = 128 * wave + 4 * i + ksub;
                const f32x4 w = *(const f32x4*)(wbase + (size_t)k * 6144);
                const float s0 = siluf_(a.in[1][k]), s1 = siluf_(a.in[1][1024 + k]), s2 = siluf_(a.in[3][k]);
                a0 += w * s0; a1 += w * s1; a2 += w * s2; }
#pragma unroll
            for (int j = 0; j < 4; ++j) { a0[j] += __shfl_xor(a0[j], 16); a0[j] += __shfl_xor(a0[j], 32); a1[j] += __shfl_xor(a1[j], 16); a1[j] += __shfl_xor(a1[j], 32); a2[j] += __shfl_xor(a2[j], 16); a2[j] += __shfl_xor(a2[j], 32); }
            if (ksub == 0) {
#pragma unroll
                for (int j = 0; j < 4; ++j) { red[(wave * 3 + 0) * 64 + 4 * cl + j] = a0[j]; red[(wave * 3 + 1) * 64 + 4 * cl + j] = a1[j]; red[(wave * 3 + 2) * 64 + 4 * cl + j] = a2[j]; } }
            __syncthreads();
            if (tid < 192) { const int bs = tid >> 6, col = tid & 63; float s = a.in[5][l * 6144 + n0 + col];
#pragma unroll
                for (int w = 0; w < 8; ++w) s += red[(w * 3 + bs) * 64 + col];
                MOD[(size_t)(l * 3 + bs) * 6144 + n0 + col] = s; }
        }
        __syncthreads();
    }
}

DI void norm_mod_phase(const float* srcL, const float* srcC, int nrows, const float* g, const float* mod, int shk, int sck, bf16* dst, int wave, int lane) {
    const int gw = blockIdx.x * NWAVES + wave, NGW = gridDim.x * NWAVES;
    for (int row = gw; row < nrows; row += NGW) {
        const float* src = row < ML ? srcL + (size_t)row * DM : srcC + (size_t)(row - ML) * DM;
        const float* mb = mod + bsel(row) * 6144;
        const f32x4* x4 = (const f32x4*)src + lane;
        f32x4 v[4]; float ss = 0.f;
#pragma unroll
        for (int j = 0; j < 4; ++j) { v[j] = x4[64 * j]; ss += (v[j][0] * v[j][0] + v[j][1] * v[j][1]) + (v[j][2] * v[j][2] + v[j][3] * v[j][3]); }
        const float rstd = 1.0f / sqrtf(wave_sum(ss) * (1.f / DM) + 1e-6f);
        u32x2* o = (u32x2*)(dst + (size_t)row * DM) + lane;
#pragma unroll
        for (int j = 0; j < 4; ++j) { const f32x4 gg = ((const f32x4*)g)[lane + 64 * j], sc = ((const f32x4*)(mb + sck * 1024))[lane + 64 * j], sh = ((const f32x4*)(mb + shk * 1024))[lane + 64 * j];
            const f32x4 y = (v[j] * rstd * gg) * (sc + 1.0f) + sh; o[64 * j] = pack4(y); }
    }
}
DI void final_norm_phase(const float* X, const float* g, float* out, int wave, int lane) {
    const int gw = blockIdx.x * NWAVES + wave, NGW = gridDim.x * NWAVES;
    for (int row = gw; row < ML; row += NGW) {
        const f32x4* x4 = (const f32x4*)(X + (size_t)row * DM) + lane;
        f32x4 v[4]; float ss = 0.f;
#pragma unroll
        for (int j = 0; j < 4; ++j) { v[j] = x4[64 * j]; ss += (v[j][0] * v[j][0] + v[j][1] * v[j][1]) + (v[j][2] * v[j][2] + v[j][3] * v[j][3]); }
        const float rstd = 1.0f / sqrtf(wave_sum(ss) * (1.f / DM) + 1e-6f);
        f32x4* o = (f32x4*)(out + (size_t)row * DM) + lane;
#pragma unroll
        for (int j = 0; j < 4; ++j) o[64 * j] = v[j] * rstd * ((const f32x4*)g)[lane + 64 * j];
    }
}

DI void aux_phase(const Args& a, int tid, int wave, int lane, int brank, int nblk) {
    unsigned char* ws = a.ws;
    const float* MOD = (const float*)(ws + WS_MOD);
    float* GM = (float*)(ws + WS_GM); float* BV = (float*)(ws + WS_BV);
    const int gt = brank * 512 + tid, NT = nblk * 512;
    for (int idx = gt; idx < 9 * 1024; idx += NT) { const int c = idx & 1023, bs = (idx >> 10) % 3, which = idx / 3072;
        const float g = which == 0 ? a.in[7][c] : (which == 1 ? a.in[6][DM + c] : a.in[7][DM + c]);
        const float sc = MOD[(size_t)((which == 0 ? 0 : 1) * 3 + bs) * 6144 + (which == 1 ? 1 : 4) * 1024 + c];
        GM[idx] = g * (1.0f + sc); }
    const int gw = brank * NWAVES + wave, NGW = nblk * NWAVES;
    for (int it = gw; it < 2 * DFF + NQKV + 2 * DFF; it += NGW) {
        int which, n; if (it < 2 * DFF) { which = 0; n = it; } else if (it < 2 * DFF + NQKV) { which = 1; n = it - 2 * DFF; } else { which = 2; n = it - 2 * DFF - NQKV; }
        const bf16* Bt = (const bf16*)(ws + (which == 0 ? WS_WFIN0 : (which == 1 ? WS_WQKV : WS_WFIN1))) + (size_t)n * DM + 16 * lane;
        const int N = which == 1 ? NQKV : 2 * DFF;
        const float* shb = MOD + (size_t)((which == 0 ? 0 : 1) * 3) * 6144 + (which == 1 ? 0 : 3) * 1024 + 16 * lane;
        const u32x4 w0 = *(const u32x4*)Bt, w1 = *(const u32x4*)(Bt + 8);
        const f32x4 wv[4] = {unpack4((u32x2){w0.x, w0.y}), unpack4((u32x2){w0.z, w0.w}), unpack4((u32x2){w1.x, w1.y}), unpack4((u32x2){w1.z, w1.w})};
        float acc[3];
#pragma unroll
        for (int bs = 0; bs < 3; ++bs) { float s_ = 0.f;
#pragma unroll
            for (int q = 0; q < 4; ++q) { const f32x4 sh = *(const f32x4*)(shb + bs * 6144 + 4 * q); s_ += (wv[q][0] * sh[0] + wv[q][1] * sh[1]) + (wv[q][2] * sh[2] + wv[q][3] * sh[3]); }
            acc[bs] = wave_sum(s_); }
        if (lane == 0) { float* o = BV + (size_t)which * 3 * (2 * DFF) + n; o[0] = acc[0]; o[N] = acc[1]; o[2 * N] = acc[2]; }
    }
}

constexpr int RG_UNITS = NB * NCH * 8;
typedef _Float16 f16x4_t __attribute__((ext_vector_type(4)));
DI u32x2 pack4h(f32x4 v) { f16x4_t h = __builtin_convertvector(v, f16x4_t); return __builtin_bit_cast(u32x2, h); }
DI f32x4 unpack4h(u32x2 u) { return __builtin_convertvector(__builtin_bit_cast(f16x4_t, u), f32x4); }
DI unsigned short* rg_acum_ptr(const Args& a, int unit) { return (unsigned short*)(a.ws + WS_X) + (size_t)unit * 4096; }
DI unsigned short* rg_bcum_ptr(const Args& a, int unit) { return (unsigned short*)a.out + (size_t)unit * 4096; }
template <int CTRL, int RMASK> DI float dppf(float oldv, float v) {
    return __builtin_bit_cast(float, __builtin_amdgcn_update_dpp(__builtin_bit_cast(int, oldv), __builtin_bit_cast(int, v), CTRL, RMASK, 0xf, false));
}
#define RG_SCAN_STEP(CTRL, RMASK) do { _Pragma("unroll") for (int r = 0; r < 16; ++r) { const float am = aR[r], bm = aI[r]; \
        const float ap = dppf<CTRL, RMASK>(1.0f, am), bp = dppf<CTRL, RMASK>(0.0f, bm); aR[r] = am * ap; aI[r] = __builtin_fmaf(am, bp, bm); } } while (0)
template <int D, int MT_> DI void rg1_quarter(const float (&xc)[2][16], const bf16x8 (&xb)[4], const LAS unsigned char* gwl, const LAS float* pv,
                                              unsigned short* acum, unsigned short* bcum, float* SUMA, float* SUMB, int lane, size_t sbase) {
    const int hi = lane >> 5;
    f32x16 aR, aI;
#pragma unroll
    for (int i = 0; i < 16; ++i) { aR[i] = 0.f; aI[i] = 0.f; }
#pragma unroll
    for (int ks = 0; ks < 4; ++ks) {
        const bf16x8 wr_ = *(const LAS bf16x8*)(gwl + ((((D * 2 + 0) * 2 + MT_) * 4 + ks) * 64 + lane) * 16);
        const bf16x8 wi_ = *(const LAS bf16x8*)(gwl + ((((D * 2 + 1) * 2 + MT_) * 4 + ks) * 64 + lane) * 16);
        aR = __builtin_amdgcn_mfma_f32_32x32x16_bf16(wr_, xb[ks], aR, 0, 0, 0);
        aI = __builtin_amdgcn_mfma_f32_32x32x16_bf16(wi_, xb[ks], aI, 0, 0, 0);
    }
#pragma unroll
    for (int rq = 0; rq < 4; ++rq) {
        const int c0 = 32 * MT_ + 8 * rq + 4 * hi;
        const f32x4 rb4 = *(const LAS f32x4*)(pv + 320 + D * 64 + c0), ib4 = *(const LAS f32x4*)(pv + 448 + D * 64 + c0), lm4 = *(const LAS f32x4*)(pv + 576 + D * 64 + c0);
#pragma unroll
        for (int j = 0; j < 4; ++j) { const int r = 4 * rq + j;
            const float rr = __builtin_amdgcn_rcpf(1.0f + __builtin_amdgcn_exp2f(__builtin_fmaf(aR[r], -LOG2E, rb4[j])));
            const float ii = __builtin_amdgcn_rcpf(1.0f + __builtin_amdgcn_exp2f(__builtin_fmaf(aI[r], -LOG2E, ib4[j])));
            const float av = __builtin_amdgcn_exp2f(rr * lm4[j]);
            const float mult = __builtin_amdgcn_sqrtf(fmaxf(__builtin_fmaf(-av, av, 1.0f), 1e-12f));
            aR[r] = av; aI[r] = mult * ii * xc[MT_][r]; }
    }
    if (D == 1) {
#pragma unroll
        for (int r = 0; r < 16; ++r) { aR[r] = __shfl_xor(aR[r], 31); aI[r] = __shfl_xor(aI[r], 31); }
    }
    RG_SCAN_STEP(0x111, 0xf);
    RG_SCAN_STEP(0x112, 0xf);
    RG_SCAN_STEP(0x114, 0xf);
    RG_SCAN_STEP(0x118, 0xf);
    RG_SCAN_STEP(0x142, 0xa);
#pragma unroll
    for (int rq = 0; rq < 4; ++rq) {
        *(u32x2*)(acum + ((D * 2 + MT_) * 4 + rq) * 256 + lane * 4) = pack4h((f32x4){aR[4 * rq], aR[4 * rq + 1], aR[4 * rq + 2], aR[4 * rq + 3]});
        *(u32x2*)(bcum + ((D * 2 + MT_) * 4 + rq) * 256 + lane * 4) = pack4h((f32x4){aI[4 * rq], aI[4 * rq + 1], aI[4 * rq + 2], aI[4 * rq + 3]});
    }
    if ((lane & 31) == 31) {
#pragma unroll
        for (int rq = 0; rq < 4; ++rq) { const int c0 = 32 * MT_ + 8 * rq + 4 * hi;
            *(f32x4*)(SUMA + sbase + D * DLRU + c0) = (f32x4){aR[4 * rq], aR[4 * rq + 1], aR[4 * rq + 2], aR[4 * rq + 3]};
            *(f32x4*)(SUMB + sbase + D * DLRU + c0) = (f32x4){aI[4 * rq], aI[4 * rq + 1], aI[4 * rq + 2], aI[4 * rq + 3]}; }
    }
}
template <int QMASK> DI void rg1_unit(const Args& a, const LAS unsigned char* gwl, const LAS float* pv, int cb, int head, int lane_in) {
    unsigned char* ws = a.ws;
    const bf16* U = (const bf16*)(ws + WS_R1);
    float* SUMA = (float*)(ws + WS_SUMA); float* SUMB = (float*)(ws + WS_SUMB);
    int lane_o = lane_in; asm volatile("" : "+v"(lane_o));
    const int lane = lane_o, tok = lane & 31, hi = lane >> 5;
    const int gc = cb >> 1, b = cb & 1, unit = cb * 8 + head;
    const bool lat = gc < 256;
    const int ts0 = lat ? gc * 32 : (gc - 256) * 32, len = lat ? SEQ : CTX, rowbase = lat ? b * SEQ : ML + b * CTX;
    const int ts = ts0 + tok;
    u32x2 tap[8][4];
#pragma unroll
    for (int k = 0; k < 4; ++k) { const int tt = ts - 2 + k; const bool ok = (tt >= 0) && (tt < len); const int ttc = ok ? tt : ts;
        const bf16* up = U + (size_t)(rowbase + ttc) * RCW + head * 64 + 4 * hi;
#pragma unroll
        for (int q = 0; q < 8; ++q) { u32x2 v = *(const u32x2*)(up + 8 * q); if (!ok) { v.x = 0u; v.y = 0u; } tap[q][k] = v; } }
    float xc[2][16];
#pragma unroll
    for (int q = 0; q < 8; ++q) {
        f32x4 acc = *(const LAS f32x4*)(pv + 256 + 8 * q + 4 * hi);
#pragma unroll
        for (int k = 0; k < 4; ++k) acc += *(const LAS f32x4*)(pv + k * 64 + 8 * q + 4 * hi) * unpack4(tap[q][k]);
#pragma unroll
        for (int j = 0; j < 4; ++j) xc[q >> 2][4 * (q & 3) + j] = acc[j];
    }
    bf16x8 xb[4];
#pragma unroll
    for (int ks = 0; ks < 4; ++ks) { const int mt = ks >> 1, r0 = 8 * (ks & 1);
        u32x4 p; p.x = pk2(xc[mt][r0], xc[mt][r0 + 1]); p.y = pk2(xc[mt][r0 + 2], xc[mt][r0 + 3]); p.z = pk2(xc[mt][r0 + 4], xc[mt][r0 + 5]); p.w = pk2(xc[mt][r0 + 6], xc[mt][r0 + 7]);
        xb[ks] = __builtin_bit_cast(bf16x8, p); }
    unsigned short* acum = rg_acum_ptr(a, unit); unsigned short* bcum = rg_bcum_ptr(a, unit);
    const size_t sbase = ((size_t)(b * NCH + gc) * 2) * DLRU + head * 64;
    if (QMASK & 1) { rg1_quarter<0, 0>(xc, xb, gwl, pv, acum, bcum, SUMA, SUMB, lane, sbase); asm volatile("" ::: "memory"); }
    if (QMASK & 2) { rg1_quarter<0, 1>(xc, xb, gwl, pv, acum, bcum, SUMA, SUMB, lane, sbase); asm volatile("" ::: "memory"); }
    if (QMASK & 4) { rg1_quarter<1, 0>(xc, xb, gwl, pv, acum, bcum, SUMA, SUMB, lane, sbase); asm volatile("" ::: "memory"); }
    if (QMASK & 8) { rg1_quarter<1, 1>(xc, xb, gwl, pv, acum, bcum, SUMA, SUMB, lane, sbase); asm volatile("" ::: "memory"); }
}
DI void rg1_phase(const Args& a, LAS unsigned char* lds, int tid, int lane, int wave) {
    unsigned char* ws = a.ws;
    const int head = blockIdx.x & 7, nbh = ((int)gridDim.x - head + 7) >> 3;
    const int wslot = (blockIdx.x >> 3) * NWAVES + wave, NWS = nbh * NWAVES;
    LAS unsigned char* gwl = lds; LAS float* pv = (LAS float*)(lds + 32768);
    {
        const bf16* GW = (const bf16*)(ws + WS_GW);
#pragma unroll
        for (int i = 0; i < 4; ++i) { const int idx16 = tid + 512 * i, dg = idx16 >> 9;
            *(LAS u32x4*)(gwl + idx16 * 16) = *(const u32x4*)(GW + (size_t)(dg * 8 + head) * 4096 + (idx16 & 511) * 8); }
        for (int t = tid; t < 704; t += 512) { const int c = t & 63; float v;
            if (t < 256) v = a.in[12][(t >> 6) * DLRU + head * 64 + c];
            else if (t < 320) v = a.in[13][head * 64 + c];
            else if (t < 448) v = -LOG2E * a.in[15][((t - 320) >> 6) * DLRU + head * 64 + c];
            else if (t < 576) v = -LOG2E * a.in[17][((t - 448) >> 6) * DLRU + head * 64 + c];
            else v = LOG2E * ((const float*)(ws + WS_SP8))[((t - 576) >> 6) * DLRU + head * 64 + c];
            pv[t] = v; }
        __syncthreads();
    }
    for (int cb = wslot; cb < 512; cb += NWS) rg1_unit<15>(a, gwl, pv, cb, head, lane);
    for (int qi = wslot; qi < 64; qi += NWS) { const int cb = 512 + (qi >> 2), qq = qi & 3;
        if (qq == 0) rg1_unit<1>(a, gwl, pv, cb, head, lane); else if (qq == 1) rg1_unit<2>(a, gwl, pv, cb, head, lane);
        else if (qq == 2) rg1_unit<4>(a, gwl, pv, cb, head, lane); else rg1_unit<8>(a, gwl, pv, cb, head, lane); }
    __syncthreads();
}
DI void rg_carry_phase(const Args& a, LAS unsigned char* lds, int wave, int lane) {
    unsigned char* ws = a.ws;
    const float* SUMA = (const float*)(ws + WS_SUMA); const float* SUMB = (const float*)(ws + WS_SUMB); float* HIN = (float*)(ws + WS_HIN);
    LAS float* sh = (LAS float*)lds;
    for (int it = blockIdx.x; it < 32; it += gridDim.x) {
        const int head = it & 7, d = (it >> 3) & 1, b = it >> 4;
        const int c = lane, seg = wave; const float* sa = SUMA + c; const float* sb = SUMB + c; float* ho = HIN + c;
        float av[33], bv[33];
#pragma unroll
        for (int i = 0; i < 33; ++i) { const int st = seg * 33 + i; const int gc = d == 0 ? (st + 256) % NCH : (NCH - 1 - st);
            const unsigned idx = (unsigned)(((b * NCH + gc) * 2 + d) * DLRU + head * 64); av[i] = sa[idx]; bv[i] = sb[idx]; }
        float A = 1.f, B = 0.f;
#pragma unroll
        for (int i = 0; i < 33; ++i) { B = av[i] * B + bv[i]; A = av[i] * A; }
        __syncthreads();
        sh[(seg * 64 + c) * 2] = A; sh[(seg * 64 + c) * 2 + 1] = B;
        __syncthreads();
        float h = 0.f;
        for (int s = 0; s < seg; ++s) h = sh[(s * 64 + c) * 2] * h + sh[(s * 64 + c) * 2 + 1];
#pragma unroll
        for (int i = 0; i < 33; ++i) { const int st = seg * 33 + i; const int gc = d == 0 ? (st + 256) % NCH : (NCH - 1 - st);
            const unsigned idx = (unsigned)(((b * NCH + gc) * 2 + d) * DLRU + head * 64); ho[idx] = h; h = av[i] * h + bv[i]; }
    }
    __syncthreads();
}
DI void rg3_phase(const Args& a, int wave, int lane_in) {
    unsigned char* ws = a.ws;
    const bf16* U = (const bf16*)(ws + WS_R1);
    const float* HIN = (const float*)(ws + WS_HIN);
    bf16* Y = (bf16*)(ws + WS_HB);
    const int gw = blockIdx.x * NWAVES + wave, NGW = gridDim.x * NWAVES;
    for (int hu = gw; hu < 2 * RG_UNITS; hu += NGW) {
        int lane_o = lane_in; asm volatile("" : "+v"(lane_o));
        const int lane = lane_o, tok = lane & 31, hi = lane >> 5;
        const int mt = hu & 1, unit = hu >> 1, head = unit & 7, cb = unit >> 3, gc = cb >> 1, b = cb & 1;
        const bool lat = gc < 256;
        const int row = (lat ? b * SEQ + gc * 32 : ML + b * CTX + (gc - 256) * 32) + tok;
        const unsigned short* acum = rg_acum_ptr(a, unit) + mt * 1024 + lane * 4; const unsigned short* bcum = rg_bcum_ptr(a, unit) + mt * 1024 + lane * 4;
        const float* hin = HIN + ((size_t)(b * NCH + gc) * 2) * DLRU + head * 64 + 32 * mt + 4 * hi;
        f32x4 A4[2][4], B4[2][4], H4[2][4];
#pragma unroll
        for (int d = 0; d < 2; ++d)
#pragma unroll
            for (int rq = 0; rq < 4; ++rq) { A4[d][rq] = unpack4h(*(const u32x2*)(acum + d * 2048 + rq * 256)); B4[d][rq] = unpack4h(*(const u32x2*)(bcum + d * 2048 + rq * 256));
                H4[d][rq] = *(const f32x4*)(hin + d * DLRU + 8 * rq); }
        u32x2 gau[4];
#pragma unroll
        for (int rq = 0; rq < 4; ++rq) gau[rq] = *(const u32x2*)(U + (size_t)row * RCW + DLRU + head * 64 + 32 * mt + 8 * rq + 4 * hi);
#pragma unroll
        for (int rq = 0; rq < 4; ++rq) { const f32x4 ga = unpack4(gau[rq]); f32x4 y;
#pragma unroll
            for (int j = 0; j < 4; ++j) { const float h0 = __builtin_fmaf(A4[0][rq][j], H4[0][rq][j], B4[0][rq][j]), h1 = __builtin_fmaf(A4[1][rq][j], H4[1][rq][j], B4[1][rq][j]);
                y[j] = (h0 + __shfl_xor(h1, 31)) * gelu_tanh(ga[j]); }
            *(u32x2*)(Y + (size_t)row * DM + head * 64 + 32 * mt + 8 * rq + 4 * hi) = pack4(y); }
    }
}
DI void sc_phase(const Args& a, int wave, int lane) {
    unsigned char* ws = a.ws;
    const bf16* U = (const bf16*)(ws + WS_R1);
    bf16* Y = (bf16*)(ws + WS_HB);
    const float* convB = a.in[19];
    const int gw = blockIdx.x * NWAVES + wave, NGW = gridDim.x * NWAVES;
    f32x4 w[3][2];
#pragma unroll
    for (int k = 0; k < 3; ++k) { w[k][0] = *(const f32x4*)(convB + k * DLRU + 8 * lane); w[k][1] = *(const f32x4*)(convB + k * DLRU + 8 * lane + 4); }
    for (int tile = gw; tile < MT / 8; tile += NGW) {
        const int row0 = tile * 8;
        const int seq0 = row0 < ML ? (row0 & ~(SEQ - 1)) : ML + ((row0 - ML) & ~(CTX - 1)), seqlen = row0 < ML ? SEQ : CTX;
        const bf16* up = U + (size_t)row0 * RCW + 8 * lane;
        u32x4 cgr[10], vr[10], bgr[8];
#pragma unroll
        for (int i = 0; i < 10; ++i) { const int r = row0 - 1 + i; const bool ok = (r >= seq0) && (r < seq0 + seqlen); const bf16* q = up + (ptrdiff_t)(ok ? i - 1 : 0) * RCW;
            cgr[i] = *(const u32x4*)(q + 3 * DLRU); vr[i] = *(const u32x4*)(q + 4 * DLRU); if (!ok) { cgr[i] = (u32x4){0u, 0u, 0u, 0u}; } }
#pragma unroll
        for (int i = 0; i < 8; ++i) bgr[i] = *(const u32x4*)(up + (size_t)i * RCW + 2 * DLRU);
        f32x4 p[10][2];
#pragma unroll
        for (int i = 0; i < 10; ++i) { p[i][0] = unpack4((u32x2){cgr[i].x, cgr[i].y}) * unpack4((u32x2){vr[i].x, vr[i].y}); p[i][1] = unpack4((u32x2){cgr[i].z, cgr[i].w}) * unpack4((u32x2){vr[i].z, vr[i].w}); }
#pragma unroll
        for (int i = 0; i < 8; ++i) {
            const f32x4 o0 = unpack4((u32x2){bgr[i].x, bgr[i].y}) * (w[0][0] * p[i][0] + w[1][0] * p[i + 1][0] + w[2][0] * p[i + 2][0]);
            const f32x4 o1 = unpack4((u32x2){bgr[i].z, bgr[i].w}) * (w[0][1] * p[i][1] + w[1][1] * p[i + 1][1] + w[2][1] * p[i + 2][1]);
            const u32x2 q0 = pack4(o0), q1 = pack4(o1);
            *(u32x4*)(Y + (size_t)(row0 + i) * DM + DLRU + 8 * lane) = (u32x4){q0.x, q0.y, q1.x, q1.y}; }
    }
}

constexpr int ATT_TB = 64 * 144;
DI int att_nt(int u) { const int q64 = (u >> 2) & 127; const int lo = q64 - 2 < 0 ? 0 : q64 - 2, hi = q64 + 2 > 127 ? 127 : q64 + 2; return hi - lo + 1 + 4; }
DI void att_load(const bf16* KV, int u, int t, int srow, int sch, u32x4& kreg, u32x4& vreg) {
    const int hk = u & 3, q64 = (u >> 2) & 127, b = u >> 9;
    const int kt_lo = q64 - 2 < 0 ? 0 : q64 - 2, kt_hi = q64 + 2 > 127 ? 127 : q64 + 2, nwin = kt_hi - kt_lo + 1;
    const int rowk = (t < nwin) ? (b * SEQ + (kt_lo + t) * 64 + srow) : (ML + b * CTX + (t - nwin) * 64 + srow);
    const bf16* kp = KV + (size_t)rowk * 512 + hk * 64 + sch * 8; kreg = *(const u32x4*)kp; vreg = *(const u32x4*)(kp + 256);
}
DI void att_store(LAS unsigned char* base, int srow, int sch, const u32x4& kreg, const u32x4& vreg) {
    *(LAS u32x4*)(base + srow * 144 + sch * 16) = kreg;
    *(LAS u32x4*)(base + ATT_TB + srow * 144 + sch * 16) = vreg;
}
typedef short v4i16_t __attribute__((ext_vector_type(4)));
DI void att_tile(const LAS unsigned char* kb_, const bf16x8 (&qr)[4], float& m, float& l, f32x16 (&o)[2], const f32x16& zero16, bool edge, int kt, int qrow, int r32, int hi, int lane) {
    const LAS unsigned char* vb_ = kb_ + ATT_TB;
    f32x16 p[2];
#pragma unroll
    for (int sub = 0; sub < 2; ++sub)
#pragma unroll
        for (int d0 = 0; d0 < 4; ++d0) { const bf16x8 kf = *(const LAS bf16x8*)(kb_ + (32 * sub + r32) * 144 + (16 * d0 + 8 * hi) * 2);
            p[sub] = __builtin_amdgcn_mfma_f32_32x32x16_bf16(kf, qr[d0], d0 == 0 ? zero16 : p[sub], 0, 0, 0); }
    if (edge) {
#pragma unroll
        for (int sub = 0; sub < 2; ++sub)
#pragma unroll
            for (int r = 0; r < 16; ++r) { const int kpos = kt * 64 + 32 * sub + (r & 3) + 8 * (r >> 2) + 4 * hi; const int df = kpos - qrow;
                if (df > 128 || df < -128) p[sub][r] = -1e30f; }
    }
    float mx = p[0][0];
#pragma unroll
    for (int r = 1; r < 16; ++r) mx = fmaxf(mx, p[0][r]);
#pragma unroll
    for (int r = 0; r < 16; ++r) mx = fmaxf(mx, p[1][r]);
    mx = fmaxf(mx, __shfl_xor(mx, 32));
    const float mnew = fmaxf(m, mx), sc = __builtin_amdgcn_exp2f(m - mnew); m = mnew;
    float ls = 0.f;
#pragma unroll
    for (int sub = 0; sub < 2; ++sub)
#pragma unroll
        for (int r = 0; r < 16; ++r) { const float e = __builtin_amdgcn_exp2f(p[sub][r] - m); p[sub][r] = e; ls += e; }
    l = l * sc + ls;
#pragma unroll
    for (int i = 0; i < 16; ++i) { o[0][i] *= sc; o[1][i] *= sc; }
    bf16x8 pb[4];
#pragma unroll
    for (int ks = 0; ks < 4; ++ks) { const int sub = ks >> 1, r0 = 8 * (ks & 1);
        u32x4 w; w.x = pk2(p[sub][r0], p[sub][r0 + 1]); w.y = pk2(p[sub][r0 + 2], p[sub][r0 + 3]); w.z = pk2(p[sub][r0 + 4], p[sub][r0 + 5]); w.w = pk2(p[sub][r0 + 6], p[sub][r0 + 7]);
        pb[ks] = __builtin_bit_cast(bf16x8, w); }
    const LAS unsigned char* vtb = vb_ + (4 * hi + ((lane & 15) >> 2)) * 144 + (16 * ((lane >> 4) & 1) + 4 * (lane & 3)) * 2;
#pragma unroll
    for (int dt = 0; dt < 2; ++dt)
#pragma unroll
        for (int ks = 0; ks < 4; ++ks) { const LAS unsigned char* vp = vtb + (16 * ks) * 144 + (32 * dt) * 2;
            const v4i16_t lo = __builtin_amdgcn_ds_read_tr16_b64_v4i16((LAS v4i16_t*)vp), hi2 = __builtin_amdgcn_ds_read_tr16_b64_v4i16((LAS v4i16_t*)(vp + 8 * 144));
            const bf16x8 av = __builtin_shufflevector(lo, hi2, 0, 1, 2, 3, 4, 5, 6, 7);
            o[dt] = __builtin_amdgcn_mfma_f32_32x32x16_bf16(av, pb[ks], o[dt], 0, 0, 0); }
}
DI void attn_phase(const Args& a, LAS unsigned char* lds, int tid, int lane, int wave) {
    unsigned char* ws = a.ws;
    const bf16* Q = (const bf16*)(ws + WS_Q); const bf16* KV = (const bf16*)(ws + WS_KV);
    bf16* O = (bf16*)(ws + WS_O);
    const float* sink = a.in[22];
    const int r32 = lane & 31, hi = lane >> 5, srow = tid >> 3, sch = tid & 7;
    const int G = gridDim.x, NU = NB * 128 * 4;
    f32x16 zero16;
#pragma unroll
    for (int i = 0; i < 16; ++i) zero16[i] = 0.f;
    asm volatile("" : "+v"(zero16));
    const int u0 = blockIdx.x;
    if (u0 >= NU) return;
    for (int ubase = u0; ubase < NU; ubase += 4 * G) {
        const int c1 = att_nt(ubase);
        const int c2 = c1 + ((ubase + G < NU) ? att_nt(ubase + G) : 0);
        const int c3 = c2 + ((ubase + 2 * G < NU) ? att_nt(ubase + 2 * G) : 0);
        const int T = c3 + ((ubase + 3 * G < NU) ? att_nt(ubase + 3 * G) : 0);
#define ATT_DECODE(g, uu, tt) do { const int i_ = ((g) >= c1) + ((g) >= c2) + ((g) >= c3); uu = ubase + i_ * G; tt = (g) - (i_ == 0 ? 0 : (i_ == 1 ? c1 : (i_ == 2 ? c2 : c3))); } while (0)
        u32x4 k0, v0, k1, v1;
        { att_load(KV, ubase, 0, srow, sch, k0, v0); if (T > 1) { int uu, tt; ATT_DECODE(1, uu, tt); att_load(KV, uu, tt, srow, sch, k1, v1); } }
        int cu = ubase, ct = 0, cnt = c1;
        bf16x8 qr[4], qn[4];
        float m, l; f32x16 o[2];
#define ATT_QLOAD(dst, uu) do { const int hk_ = (uu) & 3, q64_ = ((uu) >> 2) & 127, b_ = (uu) >> 9; const int head_ = hk_ * 4 + (wave >> 1), qrow_ = q64_ * 64 + (wave & 1) * 32 + r32; \
            _Pragma("unroll") for (int d0 = 0; d0 < 4; ++d0) dst[d0] = *(const bf16x8*)(Q + (size_t)(b_ * SEQ + qrow_) * DM + head_ * 64 + 16 * d0 + 8 * hi); } while (0)
#define ATT_INIT(uu) do { const int head_ = ((uu) & 3) * 4 + (wave >> 1); m = sink[head_] * LOG2E; l = (hi == 0) ? 1.f : 0.f; \
            _Pragma("unroll") for (int i = 0; i < 16; ++i) { o[0][i] = 0.f; o[1][i] = 0.f; } } while (0)
        ATT_QLOAD(qr, cu); ATT_INIT(cu);
        att_store(lds, srow, sch, k0, v0);
        __syncthreads();
#define ATT_ITER(f, KL, VL, KS, VS, CB, SB) do { \
            if ((f) + 2 < T) { int uu_, tt_; ATT_DECODE((f) + 2, uu_, tt_); att_load(KV, uu_, tt_, srow, sch, KL, VL); } \
            const bool last_ = (ct == cnt - 1); const bool more_ = last_ && ((f) + 1 < T); \
            if (more_) ATT_QLOAD(qn, cu + G); \
            { const int q64_ = (cu >> 2) & 127; const int kt_lo_ = q64_ - 2 < 0 ? 0 : q64_ - 2; const int nwin_ = cnt - 4; const int kt_ = kt_lo_ + ct; \
              const bool edge_ = (ct < nwin_) && (kt_ == q64_ - 2 || kt_ == q64_ + 2); \
              att_tile(lds + (CB) * 2 * ATT_TB, qr, m, l, o, zero16, edge_, kt_, q64_ * 64 + (wave & 1) * 32 + r32, r32, hi, lane); } \
            if ((f) + 1 < T) att_store(lds + (SB) * 2 * ATT_TB, srow, sch, KS, VS); \
            __syncthreads(); \
            if (last_) { const int hk_ = cu & 3, q64_ = (cu >> 2) & 127, b_ = cu >> 9; const int head_ = hk_ * 4 + (wave >> 1), qrow_ = q64_ * 64 + (wave & 1) * 32 + r32; \
                const float lt_ = l + __shfl_xor(l, 32), inv_ = 1.0f / lt_; bf16* op_ = O + (size_t)(b_ * SEQ + qrow_) * DM + head_ * 64; \
                _Pragma("unroll") for (int dt = 0; dt < 2; ++dt) _Pragma("unroll") for (int rq = 0; rq < 4; ++rq) { \
                    f32x4 v_ = {o[dt][4 * rq] * inv_, o[dt][4 * rq + 1] * inv_, o[dt][4 * rq + 2] * inv_, o[dt][4 * rq + 3] * inv_}; *(u32x2*)(op_ + 32 * dt + 8 * rq + 4 * hi) = pack4(v_); } \
                if (more_) { cu += G; ct = 0; cnt = att_nt(cu); _Pragma("unroll") for (int d0 = 0; d0 < 4; ++d0) qr[d0] = qn[d0]; ATT_INIT(cu); } } \
            else { ++ct; } } while (0)
        for (int f = 0; f < T; f += 2) {
            ATT_ITER(f, k0, v0, k1, v1, 0, 1);
            if (f + 1 < T) ATT_ITER(f + 1, k1, v1, k0, v0, 1, 0);
        }
#undef ATT_ITER
#undef ATT_QLOAD
#undef ATT_INIT
#undef ATT_DECODE
    }
}

#define XB_TMO      128
#define XB_XCNT(j)  (256  + 64 * (j))
#define XB_XSUB(j)  (1280 + 64 * (j))
#define XB_XGEN(j)  (2304 + 64 * (j))
#define XB_TOP      3328
#define XB_TOPGEN   3392
#define XCD_BAR_WORDS 3456
#define XB_SPIN_CAP (1u << 18)

__device__ __forceinline__ unsigned xb_ld(unsigned* p)              { return __hip_atomic_load(p, __ATOMIC_RELAXED, __HIP_MEMORY_SCOPE_AGENT); }
__device__ __forceinline__ unsigned xb_add(unsigned* p, unsigned v) { return __hip_atomic_fetch_add(p, v, __ATOMIC_RELAXED, __HIP_MEMORY_SCOPE_AGENT); }
__device__ __forceinline__ unsigned xb_xcc_id() { return (unsigned)__builtin_amdgcn_s_getreg((3 << 11) | 20) & 0xFu; }
#define XB_SPIN(cond, bar) do { unsigned _sp = 0; while (cond) { __builtin_amdgcn_s_sleep(1); \
    if ((++_sp & 255u) == 0u) { if (xb_ld(&(bar)[XB_TMO])) break; if (_sp > XB_SPIN_CAP) { atomicAdd(&(bar)[XB_TMO], 1u); break; } } } } while (0)

struct XcdBarrier {
    unsigned* bar; unsigned x;
    volatile LAS unsigned* st;
};

__device__ __forceinline__ XcdBarrier xcd_barrier_post(unsigned* bar, volatile LAS unsigned* st) {
    XcdBarrier b; b.bar = bar; b.x = xb_xcc_id(); b.st = st;
    if (threadIdx.x == 0) (void)xb_add(&bar[XB_XCNT(b.x)], 1u);
    return b;
}
__device__ __forceinline__ void xcd_barrier_complete(unsigned* bar, unsigned x, unsigned& nloc, unsigned& nx) {
    const unsigned G = gridDim.x * gridDim.y * gridDim.z;
    unsigned sum, cnt, mine, sp = 0u;
    for (;;) {
        sum = 0u; cnt = 0u; mine = 0u;
#pragma unroll
        for (unsigned j = 0; j < 16; ++j) { const unsigned c = xb_ld(&bar[XB_XCNT(j)]); sum += c; cnt += (c > 0u) ? 1u : 0u; mine = (j == x) ? c : mine; }
        if (sum == G) break;
        __builtin_amdgcn_s_sleep(1);
        if ((++sp & 255u) == 0u) { if (xb_ld(&bar[XB_TMO])) break; if (sp > XB_SPIN_CAP) { atomicAdd(&bar[XB_TMO], 1u); break; } }
    }
    nloc = mine > 0u ? mine : 1u; nx = cnt > 0u ? cnt : 1u;
}

__device__ __forceinline__ void xcd_barrier(const XcdBarrier& b) {
    asm volatile("s_waitcnt vmcnt(0)" ::: "memory");
    __syncthreads();
    if (threadIdx.x == 0) {
        unsigned* bar = b.bar;
        __builtin_amdgcn_s_waitcnt(0);
        unsigned nloc = b.st[0], nx = b.st[1];
        if (nloc == 0u) { xcd_barrier_complete(bar, b.x, nloc, nx); b.st[0] = nloc; b.st[1] = nx; }
        const unsigned old = xb_add(&bar[XB_XSUB(b.x)], 1u);
        const unsigned gen = old / nloc;
        if (old + 1u == (gen + 1u) * nloc) {
            __builtin_amdgcn_fence(__ATOMIC_RELEASE, "agent");
            asm volatile("s_waitcnt vmcnt(0)" ::: "memory");
            const unsigned og = xb_add(&bar[XB_TOP], 1u);
            const unsigned tg = og / nx;
            if (og + 1u == (tg + 1u) * nx) xb_add(&bar[XB_TOPGEN], 1u);
            else XB_SPIN(xb_ld(&bar[XB_TOPGEN]) == tg, bar);
            __builtin_amdgcn_fence(__ATOMIC_ACQUIRE, "agent");
            xb_add(&bar[XB_XGEN(b.x)], 1u);
            asm volatile("s_waitcnt vmcnt(0)" ::: "memory");
        } else {
            XB_SPIN(xb_ld(&bar[XB_XGEN(b.x)]) == gen, bar);
            __builtin_amdgcn_fence(__ATOMIC_ACQUIRE, "agent");
            asm volatile("s_waitcnt vmcnt(0)" ::: "memory");
        }
    }
    __syncthreads();
}

DI void static_unit(int L, int nM, int nN, pg8::Unit& u) {
    const int nwg = nM * nN; int wgid = L; { const int q = nwg / pg8::NXCD, r = nwg % pg8::NXCD, xcd = wgid % pg8::NXCD, off = wgid / pg8::NXCD; wgid = (xcd < r ? xcd * (q + 1) : r * (q + 1) + (xcd - r) * q) + off; }
    const int nig = pg8::WGM * nN, gid = wgid / nig, fm = gid * pg8::WGM, gsz = (nM - fm) < pg8::WGM ? (nM - fm) : pg8::WGM;
    u.pm = fm + ((wgid % nig) % gsz); u.pn = (wgid % nig) / gsz;
}
constexpr int FIN_NN = 2 * DFF / 256, FIN_CTX_UNITS = 2 * FIN_NN, FIN_LAT_UNITS = 64 * FIN_NN;
struct CtxFirstOrder {
    int G, c, lane; unsigned* cnt;
    DI bool next(int i, pg8::Unit& u) const {
        const int L = i * G + c; if (L >= FIN_CTX_UNITS + FIN_LAT_UNITS) return false;
        if (L < FIN_CTX_UNITS) { u.pm = 64 + L / FIN_NN; u.pn = L % FIN_NN; } else static_unit(L - FIN_CTX_UNITS, 64, FIN_NN, u);
        return true;
    }
    DI void a_ready(const pg8::Unit&) const {}
    DI void done(const pg8::Unit& u) const { if (u.pm >= 64) { __threadfence(); if (lane == 0) __hip_atomic_fetch_add(cnt, 1u, __ATOMIC_RELAXED, __HIP_MEMORY_SCOPE_AGENT); } }
};
struct OneUnit {
    int pm, pn;
    DI bool next(int i, pg8::Unit& u) const { if (i) return false; u.pm = pm; u.pn = pn; return true; }
    DI void a_ready(const pg8::Unit&) const {}
    DI void done(const pg8::Unit&) const {}
};
struct EpiPartial {
    static constexpr bool PERM = false, AFTER_DRAIN = false;
    float* P;
    DI void operator()(const f32x4 (&acc)[2][2][4][2], const pg8::Unit& u, int wr, int wc, int fr, int fq) const {
        const int col0 = u.pn * 256 + wc * 32 + 4 * fq;
#pragma unroll
        for (int ai = 0; ai < 2; ++ai)
#pragma unroll
            for (int m = 0; m < 4; ++m) { float* op = P + (size_t)(u.pm * 256 + ai * 128 + wr * 64 + m * 16 + fr) * DM + col0;
#pragma unroll
                for (int bj = 0; bj < 2; ++bj)
#pragma unroll
                    for (int n = 0; n < 2; ++n) *(f32x4*)(op + bj * 128 + n * 16) = acc[ai][bj][m][n]; }
    }
};
DI void ctx_finish_row(const Args& a, int rc, int lane, const float* base, const float* gate, const float* gm, bf16* hbn) {
    unsigned char* ws = a.ws;
    const float* P = (const float*)(ws + WS_PART) + (size_t)rc * DM; float* X = (float*)(ws + WS_X) + (size_t)(ML + rc) * DM;
    const float* bp = base + (size_t)rc * DM; bf16* hb = hbn + (size_t)(ML + rc) * DM; float* ssp = (float*)(ws + WS_SSP) + (size_t)(ML + rc) * 16;
    float ss = 0.f;
#pragma unroll
    for (int j = 0; j < 4; ++j) { const int c = 4 * (lane + 64 * j);
        const f32x4 p0 = *(const f32x4*)(P + c), p1 = *(const f32x4*)(P + (size_t)MC * DM + c), p2 = *(const f32x4*)(P + (size_t)2 * MC * DM + c), p3 = *(const f32x4*)(P + (size_t)3 * MC * DM + c);
        const f32x4 xn = *(const f32x4*)(bp + c) + *(const f32x4*)(gate + c) * (((p0 + p1) + p2) + p3);
        *(f32x4*)(X + c) = xn; ss += (xn[0] * xn[0] + xn[1] * xn[1]) + (xn[2] * xn[2] + xn[3] * xn[3]);
        *(u32x2*)(hb + c) = pack4(xn * *(const f32x4*)(gm + c)); }
    ss = wave_sum(ss);
    if (lane < 16) ssp[lane] = lane == 0 ? ss : 0.f;
}
struct OneUnitCounted {
    int pm, pn, lane; unsigned* cnt;
    DI bool next(int i, pg8::Unit& u) const { if (i) return false; u.pm = pm; u.pn = pn; return true; }
    DI void a_ready(const pg8::Unit&) const {}
    DI void done(const pg8::Unit&) const { __threadfence(); if (lane == 0) __hip_atomic_fetch_add(cnt, 1u, __ATOMIC_RELAXED, __HIP_MEMORY_SCOPE_AGENT); }
};
DI void wait_count(unsigned* cnt, unsigned want, int tid) {
    if (tid == 0) { unsigned sp = 0;
        while (__hip_atomic_load(cnt, __ATOMIC_RELAXED, __HIP_MEMORY_SCOPE_AGENT) < want) { __builtin_amdgcn_s_sleep(2); if (++sp > (1u << 22)) break; }
        __builtin_amdgcn_fence(__ATOMIC_ACQUIRE, "agent"); asm volatile("s_waitcnt vmcnt(0)" ::: "memory"); }
    __syncthreads();
}

constexpr int N_PHASES = 18;
__global__ void __launch_bounds__(NWAVES * 64, 2) fwd_kernel(Args a) {
    extern __shared__ __attribute__((aligned(16))) unsigned char lds_raw[];
    LAS unsigned char* lds = (LAS unsigned char*)lds_raw;
    cg::grid_group grid = cg::this_grid();
    const int tid = threadIdx.x, lane = tid & 63, wave = __builtin_amdgcn_readfirstlane(tid >> 6);
    unsigned char* ws = a.ws;
    const int lo = a.ph_lo, hi = a.ph_hi, G = gridDim.x, bx = blockIdx.x;
#ifndef PHASE_MASK
#define PHASE_MASK 0x3ffff
#endif
#define IN(k) (((PHASE_MASK >> (k)) & 1) && lo <= (k) && (k) < hi)
    {
        if (tid < 64) ((LAS unsigned*)(lds + 131072))[tid] = 0u;
        __syncthreads();
    }
    XcdBarrier bar = xcd_barrier_post((unsigned*)(ws + WS_CTL), (volatile LAS unsigned*)(lds + 131072 + 64));
    if (a.ph_lo < 0) grid.sync();
#define GSYNC() xcd_barrier(bar)
#define SEAM(k) do { if (IN(k) && (k) + 1 < hi) GSYNC(); } while (0)
#ifndef RPT_MASK
#define RPT_MASK 0
#endif
#ifndef RPT_N
#define RPT_N 1
#endif
#ifndef EXTRA_SYNCS
#define EXTRA_SYNCS 0
#endif
#define PHASE(k, ...) do { if (IN(k)) { _Pragma("nounroll") for (int rp_ = 0; rp_ <= ((((RPT_MASK) >> (k)) & 1) ? (RPT_N) : 0); ++rp_) { if (rp_) GSYNC(); __VA_ARGS__; } } SEAM(k); } while (0)
    bf16* HB = (bf16*)(ws + WS_HB); float* X = (float*)(ws + WS_X);
    bf16* U = (bf16*)(ws + WS_R1); bf16* FH = (bf16*)(ws + WS_R1);
    const float* MOD = (const float*)(ws + WS_MOD); const float* GM = (const float*)(ws + WS_GM); const float* BV = (const float*)(ws + WS_BV); float* SSP = (float*)(ws + WS_SSP);
    const float* xin = a.in[0]; const float* ctxin = a.in[2];

    PHASE(0, prologue(a, lds, tid, lane, wave););
    PHASE(1, norm_mod_phase(xin, ctxin, MT, a.in[6], MOD, 0, 1, HB, wave, lane););
    PHASE(2, pg8::Gemm g{HB, (const bf16*)(ws + WS_WRCIN), MT, RCW, DM, 0}; pg8::StaticOrder S; S.init(MT, RCW, G, bx);
        EpiStore E{U, RCW}; pg8::gemm_phase<EpiStore, pg8::StaticOrder, true, true>(lds, g, S, E);
        {
            const int nfull2 = ((MT / 256) * (RCW / 256)) % G;
            if (nfull2 == 0 || G - nfull2 < 16) aux_phase(a, tid, wave, lane, bx, G); else if (bx >= nfull2) aux_phase(a, tid, wave, lane, bx - nfull2, G - nfull2);
        });
    PHASE(3, rg1_phase(a, lds, tid, lane, wave););
    PHASE(4, rg_carry_phase(a, lds, wave, lane); sc_phase(a, wave, lane););
    PHASE(5, rg3_phase(a, wave, lane););
    PHASE(6, const bool split6 = (G == 256);
        if (split6) {
            { pg8::Gemm g{HB, (const bf16*)(ws + WS_WRCOUT), ML, DM, DM, 0}; pg8::StaticOrder S; S.init(ML, DM, G, bx);
              EpiResid E{xin, ctxin, X, MOD + 2 * 1024, (bf16*)a.out, GM, SSP}; pg8::gemm_phase<EpiResid, pg8::StaticOrder, true, true>(lds, g, S, E); }
            unsigned* cnt6 = (unsigned*)(ws + WS_CTL) + CTL_CTXCNT + 64;
            if (bx < 32) { const int sl = bx & 3, cu_ = bx >> 2;
                pg8::Gemm g2{HB + (size_t)ML * DM + sl * 256, (const bf16*)(ws + WS_WRCOUT) + sl * 256, MC, DM, 256, DM}; OneUnitCounted S2{cu_ >> 2, cu_ & 3, lane, cnt6};
                EpiPartial E2{(float*)(ws + WS_PART) + (size_t)sl * MC * DM}; pg8::gemm_phase<EpiPartial, OneUnitCounted, true, true>(lds, g2, S2, E2); }
            else if (bx < 96) { wait_count(cnt6, 8u * 32u, tid);
                ctx_finish_row(a, (bx - 32) * NWAVES + wave, lane, ctxin, MOD + (size_t)2 * 6144 + 2 * 1024, GM + 2 * 1024, (bf16*)a.out); }
        } else { pg8::Gemm g{HB, (const bf16*)(ws + WS_WRCOUT), MT, DM, DM, 0}; pg8::StaticOrder S; S.init(MT, DM, G, bx);
            EpiResid E{xin, ctxin, X, MOD + 2 * 1024, (bf16*)a.out, GM, SSP}; pg8::gemm_phase<EpiResid, pg8::StaticOrder, true, true>(lds, g, S, E); });
    PHASE(8, pg8::Gemm g{(const bf16*)a.out, (const bf16*)(ws + WS_WFIN0), MT, 2 * DFF, DM, 0}; CtxFirstOrder S{G, bx, lane, (unsigned*)(ws + WS_CTL) + CTL_CTXCNT};
        rstd_table(lds, SSP, S, tid); EpiSwiGLU E{FH, DFF, lds, BV}; pg8::gemm_phase<EpiSwiGLU, CtxFirstOrder, true, true>(lds, g, S, E);
        {
            const int nfull = (FIN_CTX_UNITS + FIN_LAT_UNITS) % G, su = bx - nfull;
            if (nfull != 0 && G - nfull >= 32 && su >= 0 && su < 32) {
                wait_count((unsigned*)(ws + WS_CTL) + CTL_CTXCNT, 8u * FIN_CTX_UNITS, tid);
                const int sl = su & 3, cu_ = su >> 2, k0 = sl < 2 ? sl * 768 : 1536 + (sl - 2) * 640, klen = sl < 2 ? 768 : 640;
                pg8::Gemm g2{FH + (size_t)ML * DFF + k0, (const bf16*)(ws + WS_WFOUT0) + k0, MC, DM, klen, DFF}; OneUnit S2{cu_ >> 2, cu_ & 3};
                EpiPartial E2{(float*)(ws + WS_PART) + (size_t)sl * MC * DM}; pg8::gemm_phase<EpiPartial, OneUnit, true, true>(lds, g2, S2, E2);
            }
        });
    PHASE(9, const int nfull9 = (FIN_CTX_UNITS + FIN_LAT_UNITS) % G; const bool split9 = nfull9 != 0 && G - nfull9 >= 32;
        if (split9) { { const int rc = bx * NWAVES + wave; if (rc < MC) ctx_finish_row(a, rc, lane, X + (size_t)ML * DM, MOD + (size_t)2 * 6144 + 5 * 1024, GM + 3072 + 2 * 1024, HB); }
            pg8::Gemm g{FH, (const bf16*)(ws + WS_WFOUT0), ML, DM, DFF, 0}; pg8::StaticOrder S; S.init(ML, DM, G, bx);
            EpiResid E{X, X + (size_t)ML * DM, X, MOD + 5 * 1024, HB, GM + 3072, SSP}; pg8::gemm_phase<EpiResid, pg8::StaticOrder, true, true>(lds, g, S, E); }
        else { pg8::Gemm g{FH, (const bf16*)(ws + WS_WFOUT0), MT, DM, DFF, 0}; pg8::StaticOrder S; S.init(MT, DM, G, bx);
            EpiResid E{X, X + (size_t)ML * DM, X, MOD + 5 * 1024, HB, GM + 3072, SSP}; pg8::gemm_phase<EpiResid, pg8::StaticOrder, true, true>(lds, g, S, E); });
    const float* MOD1 = MOD + 3 * 6144;
    PHASE(11, pg8::Gemm g{HB, (const bf16*)(ws + WS_WQKV), MT, NQKV, DM}; pg8::StaticOrder S; S.init(MT, NQKV, G, bx);
        EpiQKV E{(bf16*)(ws + WS_Q), (bf16*)(ws + WS_KV), (const float*)(ws + WS_ROPEC), (const float*)(ws + WS_ROPES), lds, BV + 3 * 2 * DFF}; rstd_table(lds, SSP, S, tid);
        pg8::gemm_phase<EpiQKV, pg8::StaticOrder, true, true>(lds, g, S, E););
    PHASE(12, attn_phase(a, lds, tid, lane, wave););
    PHASE(13, pg8::Gemm g{(const bf16*)(ws + WS_O), (const bf16*)(ws + WS_WAOUT), ML, DM, DM}; pg8::StaticOrder S; S.init(ML, DM, G, bx);
        EpiResid E{X, X + (size_t)ML * DM, X, MOD1 + 2 * 1024, HB, GM + 2 * 3072, SSP}; pg8::gemm_phase<EpiResid, pg8::StaticOrder, true, true>(lds, g, S, E););
    PHASE(15, pg8::Gemm g{HB, (const bf16*)(ws + WS_WFIN1), ML, 2 * DFF, DM}; pg8::StaticOrder S; S.init(ML, 2 * DFF, G, bx);
        rstd_table(lds, SSP, S, tid); EpiSwiGLU E{FH, DFF, lds, BV + 2 * 3 * 2 * DFF}; pg8::gemm_phase<EpiSwiGLU, pg8::StaticOrder, true, true>(lds, g, S, E););
    PHASE(16, pg8::Gemm g{FH, (const bf16*)(ws + WS_WFOUT1), ML, DM, DFF}; pg8::StaticOrder S; S.init(ML, DM, G, bx);
        EpiResid E{X, X + (size_t)ML * DM, X, MOD1 + 5 * 1024, nullptr, nullptr, nullptr}; pg8::gemm_phase<EpiResid, pg8::StaticOrder, true, true>(lds, g, S, E););
    PHASE(17, final_norm_phase(X, a.in[8], a.out, wave, lane););
    for (int es_ = 0; es_ < EXTRA_SYNCS; ++es_) GSYNC();
#undef IN
#undef SEAM
}

#ifndef MK_MULTI
#define MK_MULTI 0
#endif
extern "C" void kernel_launch(void* const* d_in, const int* in_sizes, int n_in, void* d_out, int out_size, void* d_ws, size_t ws_size, hipStream_t stream) {
    static int grid = 0;
    if (grid == 0) {
        if (n_in != 24 || out_size != ML * DM || ws_size < WS_END) { fprintf(stderr, "kernel_launch: unexpected shapes n_in %d out %d ws %zu\n", n_in, out_size, ws_size); grid = -1; return; }
        int dev = 0, cus = 0, per_cu = 0;
        hipGetDevice(&dev); hipDeviceGetAttribute(&cus, hipDeviceAttributeMultiprocessorCount, dev);
        if (hipFuncSetAttribute((const void*)fwd_kernel, hipFuncAttributeMaxDynamicSharedMemorySize, LDS_BYTES) != hipSuccess) { fprintf(stderr, "kernel_launch: hipFuncSetAttribute failed\n"); grid = -1; return; }
        if (hipOccupancyMaxActiveBlocksPerMultiprocessor(&per_cu, (const void*)fwd_kernel, NWAVES * 64, LDS_BYTES) != hipSuccess || per_cu < 1) { fprintf(stderr, "kernel_launch: occupancy query says %d\n", per_cu); per_cu = 1; }
        (void)hipGetLastError();
        grid = cus * 1;
    }
    if (grid < 0) return;
    Args a{};
    for (int i = 0; i < 24; ++i) a.in[i] = (const float*)d_in[i];
    a.out = (float*)d_out; a.ws = (unsigned char*)d_ws;
#if MK_MULTI
    for (int p = 0; p < N_PHASES; ++p) { a.ph_lo = p; a.ph_hi = p + 1; hipLaunchKernelGGL(fwd_kernel, dim3(grid), dim3(NWAVES * 64), LDS_BYTES, stream, a); }
#else
    a.ph_lo = 0; a.ph_hi = N_PHASES;
    if (hipMemsetAsync((char*)d_ws + WS_CTL, 0, CTL_BYTES, stream) != hipSuccess) { fprintf(stderr, "kernel_launch: memset failed\n"); return; }
    void* args[] = {&a};
    hipError_t e = hipLaunchCooperativeKernel((const void*)fwd_kernel, dim3(grid), dim3(NWAVES * 64), args, LDS_BYTES, stream);
    if (e != hipSuccess) fprintf(stderr, "kernel_launch: cooperative launch failed: %s (grid %d)\n", hipGetErrorString(e), grid);
#endif
}
```

```cpp
#include <hip/hip_runtime.h>
#include <hip/hip_cooperative_groups.h>
#include <cstdio>
#include <cstdint>
namespace cg = cooperative_groups;
namespace pg8 {
#define PG8_LAS __attribute__((address_space(3)))
typedef unsigned short bf16_t;
typedef short bf16x8 __attribute__((ext_vector_type(8)));
typedef float f32x4 __attribute__((ext_vector_type(4)));
typedef unsigned u32x4 __attribute__((ext_vector_type(4)));
constexpr int BM = 256, BK = 64, HALF = 128, HTB = HALF * BK * 2  , STAGE_BYTES = 8 * HTB, NXCD = 8, WGM = 8;

__host__ __device__ __forceinline__ int lds_byte(int r, int c) { const int st = (r >> 4) * 2 + (c >> 5), rr = r & 15, cc = c & 31, ob = rr * 64 + cc * 2; return st * 1024 + (ob ^ (((ob >> 9) & 1) << 5)); }
__host__ __device__ __forceinline__ void stage_rc(int b, int& R, int& C) { const int st = b / 1024, sb = b % 1024, swz = sb ^ (((sb >> 9) & 1) << 5); R = (st >> 1) * 16 + swz / 64; C = (st & 1) * 32 + (swz % 64) / 2; }
__host__ __device__ __forceinline__ int perm32(int rho) { const int n = rho >> 4, i = rho & 15; return 8 * (i >> 2) + 4 * n + (i & 3); }

struct Unit { int pm, pn, ord; };
struct Gemm { const bf16_t* A; const bf16_t* Bt; int M, N, K, ld; };

struct StaticOrder {
    int nM, nN, nwg, G, c;
    __host__ __device__ void init(int M, int N, int G_, int c_) { nM = M / BM; nN = N / BM; nwg = nM * nN; G = G_; c = c_; }
    __host__ __device__ bool next(int i, Unit& u) const {
        const long L = (long)i * G + c; if (L >= nwg) return false;
        int wgid = (int)L; { const int q = nwg / NXCD, r = nwg % NXCD, xcd = wgid % NXCD, off = wgid / NXCD; wgid = (xcd < r ? xcd * (q + 1) : r * (q + 1) + (xcd - r) * q) + off; }
        const int nig = WGM * nN, gid = wgid / nig, fm = gid * WGM, gsz = (nM - fm) < WGM ? (nM - fm) : WGM;
        u.pm = fm + ((wgid % nig) % gsz); u.pn = (wgid % nig) / gsz; return true;
    }
    __device__ __forceinline__ void a_ready(const Unit&) const {}
    __device__ __forceinline__ void done(const Unit&) const {}
};
template <class Epi, class Sched, bool ALIGN_EPI = false, bool SP2 = false>
__device__ __forceinline__ void gemm_phase(PG8_LAS unsigned char* lds, const Gemm g, const Sched& S, const Epi& E) {
    const int tid = threadIdx.x, wid = __builtin_amdgcn_readfirstlane(tid >> 6), lane = tid & 63, wr = wid >> 2, wc = wid & 3, fr = lane & 15, fq = lane >> 4;
    const int nt = g.K / BK, K = g.ld ? g.ld : g.K;
    unsigned voffA[2], voffB[2];
#pragma unroll
    for (int i = 0; i < 2; ++i) { int R, C; stage_rc(tid * 16 + i * 8192, R, C); const int Rb = Epi::PERM ? ((R & ~31) + perm32(R & 31)) : R;
        voffA[i] = (unsigned)(R * K + C) * 2u; voffB[i] = (unsigned)(Rb * K + C) * 2u; }
    const size_t kstep = (size_t)(BK * 2);
    const size_t hstep = (size_t)HALF * K * 2;
    const size_t tstep = 2 * hstep;
    const unsigned ldsw = (unsigned)wid * 1024u;
    const int aoff = lds_byte(wr * 64 + fr, fq * 8), boff = lds_byte(wc * 32 + fr, fq * 8);
#define PG8_SA(b, h) (((b) * 2 + (h)) * HTB)
#define PG8_SB(b, h) ((4 + (b) * 2 + (h)) * HTB)
#define PG8_STAGE(bufoff, gbase, voff) do { _Pragma("unroll") for (int _i = 0; _i < 2; ++_i) \
        __builtin_amdgcn_global_load_lds((const unsigned*)((const char*)(gbase) + (voff)[_i]), (PG8_LAS unsigned*)(lds + (bufoff) + ldsw + _i * 8192), 16, 0, 0); } while (0)
#define PG8_LDA(dst, b, h) do { _Pragma("unroll") for (int m = 0; m < 4; ++m) _Pragma("unroll") for (int k = 0; k < 2; ++k) dst[m][k] = *(const PG8_LAS bf16x8*)(lds + PG8_SA(b, h) + aoff + m * 2048 + k * 1024); } while (0)
#define PG8_LDB(dst, b, h) do { _Pragma("unroll") for (int n = 0; n < 2; ++n) _Pragma("unroll") for (int k = 0; k < 2; ++k) dst[n][k] = *(const PG8_LAS bf16x8*)(lds + PG8_SB(b, h) + boff + n * 2048 + k * 1024); } while (0)
#define PG8_MMA(ai, bj, At, Bt) do { __builtin_amdgcn_s_setprio(1); _Pragma("unroll") for (int m = 0; m < 4; ++m) _Pragma("unroll") for (int n = 0; n < 2; ++n) _Pragma("unroll") for (int k = 0; k < 2; ++k) \
        acc[ai][bj][m][n] = __builtin_amdgcn_mfma_f32_16x16x32_bf16(Bt[n][k], At[m][k], acc[ai][bj][m][n], 0, 0, 0); __builtin_amdgcn_s_setprio(0); } while (0)
#define PG8_WAIT_V(n) asm volatile("s_waitcnt vmcnt(" #n ")" ::: "memory")
#define PG8_WAIT_L(n) asm volatile("s_waitcnt lgkmcnt(" #n ")" ::: "memory")
#define PG8_BAR __builtin_amdgcn_s_barrier()
#define PG8_SCHED __builtin_amdgcn_sched_barrier(0)
    Unit cur, nxt; int ui = 0;
    if (!S.next(0, cur)) return; cur.ord = 0;
    f32x4 acc[2][2][4][2];
#pragma unroll
    for (int a = 0; a < 2; ++a)
#pragma unroll
        for (int b = 0; b < 2; ++b)
#pragma unroll
            for (int m = 0; m < 4; ++m)
#pragma unroll
                for (int n = 0; n < 2; ++n) acc[a][b][m][n] = (f32x4){0.f, 0.f, 0.f, 0.f};
    bf16x8 At[4][2], B0[2][2], B1[2][2];
    const char* cA = (const char*)g.A + (size_t)cur.pm * tstep; const char* cB = (const char*)g.Bt + (size_t)cur.pn * tstep;
    S.a_ready(cur);
    if constexpr (SP2) {
        PG8_STAGE(PG8_SB(0, 0), cB, voffB); PG8_STAGE(PG8_SB(0, 1), cB + hstep, voffB); PG8_STAGE(PG8_SA(0, 0), cA, voffA); PG8_STAGE(PG8_SA(0, 1), cA + hstep, voffA);
        if (wr == 1) PG8_BAR;
        PG8_WAIT_V(2); PG8_BAR;
        PG8_STAGE(PG8_SB(1, 0), cB + kstep, voffB); PG8_STAGE(PG8_SA(1, 0), cA + kstep, voffA); PG8_STAGE(PG8_SB(1, 1), cB + hstep + kstep, voffB);
        PG8_WAIT_V(6); PG8_BAR;
    } else {
        PG8_STAGE(PG8_SB(0, 0), cB, voffB); PG8_STAGE(PG8_SA(0, 0), cA, voffA); PG8_STAGE(PG8_SB(0, 1), cB + hstep, voffB); PG8_STAGE(PG8_SA(0, 1), cA + hstep, voffA);
        if (wr == 1) PG8_BAR;
        PG8_WAIT_V(4); PG8_BAR;
        PG8_STAGE(PG8_SB(1, 0), cB + kstep, voffB); PG8_STAGE(PG8_SA(1, 0), cA + kstep, voffA); PG8_STAGE(PG8_SB(1, 1), cB + hstep + kstep, voffB);
        PG8_WAIT_V(6); PG8_BAR;
    }
    for (;;) {
        const bool has_next = S.next(ui + 1, nxt); nxt.ord = ui + 1;
        const char* nA = has_next ? (const char*)g.A + (size_t)nxt.pm * tstep : cA; const char* nB = has_next ? (const char*)g.Bt + (size_t)nxt.pn * tstep : cB;
        for (int t = 0; t < nt; t += 2) {
            const bool last = (t == nt - 2);
            const char* a1 = cA + (size_t)(t + 1) * kstep;
            const char* a2 = last ? nA : cA + (size_t)(t + 2) * kstep; const char* b2 = last ? nB : cB + (size_t)(t + 2) * kstep;
            const char* a3 = a2 + kstep; const char* b3 = b2 + kstep;
            if (last && has_next) S.a_ready(nxt);
            if constexpr (SP2) {
            PG8_LDB(B0, 0, 0); PG8_LDB(B1, 0, 1); PG8_SCHED; PG8_LDA(At, 0, 0); PG8_STAGE(PG8_SA(1, 1), a1 + hstep, voffA);
            PG8_WAIT_V(8); PG8_WAIT_L(0); PG8_BAR; PG8_MMA(0, 0, At, B0); PG8_MMA(0, 1, At, B1); PG8_BAR; PG8_SCHED;
            PG8_LDA(At, 0, 1); PG8_STAGE(PG8_SB(0, 0), b2, voffB); PG8_STAGE(PG8_SB(0, 1), b2 + hstep, voffB); PG8_STAGE(PG8_SA(0, 0), a2, voffA);
            PG8_WAIT_V(8); PG8_WAIT_L(0); PG8_BAR; PG8_MMA(1, 0, At, B0); PG8_MMA(1, 1, At, B1); PG8_BAR; PG8_SCHED;
            PG8_LDB(B0, 1, 0); PG8_LDB(B1, 1, 1); PG8_SCHED; PG8_LDA(At, 1, 0); PG8_STAGE(PG8_SA(0, 1), a2 + hstep, voffA);
            PG8_WAIT_V(8); PG8_WAIT_L(0); PG8_BAR; PG8_MMA(0, 0, At, B0); PG8_MMA(0, 1, At, B1); PG8_BAR; PG8_SCHED;
            PG8_LDA(At, 1, 1); PG8_STAGE(PG8_SB(1, 0), b3, voffB); PG8_STAGE(PG8_SB(1, 1), b3 + hstep, voffB); PG8_STAGE(PG8_SA(1, 0), a3, voffA);
            PG8_WAIT_V(8); PG8_WAIT_L(0); PG8_BAR; PG8_MMA(1, 0, At, B0); PG8_MMA(1, 1, At, B1); PG8_BAR; PG8_SCHED;
            } else {
            PG8_LDB(B0, 0, 0); PG8_SCHED; PG8_LDA(At, 0, 0); PG8_STAGE(PG8_SA(1, 1), a1 + hstep, voffA);
            PG8_WAIT_L(8); PG8_BAR; PG8_WAIT_L(0); PG8_MMA(0, 0, At, B0); PG8_BAR; PG8_SCHED;
            PG8_LDB(B1, 0, 1); PG8_STAGE(PG8_SB(0, 0), b2, voffB);
            PG8_BAR; PG8_WAIT_L(0); PG8_MMA(0, 1, At, B1); PG8_BAR;
            PG8_LDA(At, 0, 1); PG8_STAGE(PG8_SA(0, 0), a2, voffA);
            PG8_BAR; PG8_WAIT_L(0); PG8_MMA(1, 0, At, B0); PG8_BAR; PG8_SCHED;
            PG8_STAGE(PG8_SB(0, 1), b2 + hstep, voffB);
            PG8_WAIT_V(6); PG8_BAR; PG8_MMA(1, 1, At, B1); PG8_BAR;
            PG8_LDB(B0, 1, 0); PG8_SCHED; PG8_LDA(At, 1, 0); PG8_STAGE(PG8_SA(0, 1), a2 + hstep, voffA);
            PG8_WAIT_L(8); PG8_BAR; PG8_WAIT_L(0); PG8_MMA(0, 0, At, B0); PG8_BAR; PG8_SCHED;
            PG8_LDB(B1, 1, 1); PG8_STAGE(PG8_SB(1, 0), b3, voffB);
            PG8_BAR; PG8_WAIT_L(0); PG8_MMA(0, 1, At, B1); PG8_BAR;
            PG8_LDA(At, 1, 1); PG8_STAGE(PG8_SA(1, 0), a3, voffA);
            PG8_BAR; PG8_WAIT_L(0); PG8_MMA(1, 0, At, B0); PG8_BAR; PG8_SCHED;
            PG8_STAGE(PG8_SB(1, 1), b3 + hstep, voffB);
            PG8_WAIT_V(6); PG8_BAR; PG8_MMA(1, 1, At, B1); PG8_BAR;
            }
        }
        if constexpr (ALIGN_EPI) { if (wr == 0) PG8_BAR; }
        if constexpr (!Epi::AFTER_DRAIN) { E(acc, cur, wr, wc, fr, fq); S.done(cur); }
        if (!has_next) break;
#pragma unroll
        for (int a = 0; a < 2; ++a)
#pragma unroll
            for (int b = 0; b < 2; ++b)
#pragma unroll
                for (int m = 0; m < 4; ++m)
#pragma unroll
                    for (int n = 0; n < 2; ++n) acc[a][b][m][n] = (f32x4){0.f, 0.f, 0.f, 0.f};
        cur = nxt; cA = nA; cB = nB; ++ui;
        if constexpr (ALIGN_EPI) { if (wr == 1) PG8_BAR; }
    }
    PG8_WAIT_V(0);
    if constexpr (!ALIGN_EPI) { if (wr == 0) PG8_BAR; }
    PG8_BAR;
    if constexpr (Epi::AFTER_DRAIN) { E.fused(acc, cur, wr, wc, fr, fq, lds, wid, lane); S.done(cur); }
#undef PG8_SA
#undef PG8_SB
#undef PG8_STAGE
#undef PG8_LDA
#undef PG8_LDB
#undef PG8_MMA
#undef PG8_WAIT_V
#undef PG8_WAIT_L
#undef PG8_BAR
#undef PG8_SCHED
}
}

#ifndef WT_ALL
#define WT_ALL 0
#endif
#define DI __device__ __forceinline__
#define LAS __attribute__((address_space(3)))
typedef unsigned short bf16;
typedef pg8::f32x4 f32x4;
typedef pg8::bf16x8 bf16x8;
typedef pg8::u32x4 u32x4;
typedef unsigned u32x2 __attribute__((ext_vector_type(2)));
typedef float f32x16 __attribute__((ext_vector_type(16)));
typedef float f32x2_t __attribute__((ext_vector_type(2)));
typedef __bf16 bf16x2_t __attribute__((ext_vector_type(2)));

constexpr int DM = 1024, NB = 2, SEQ = 8192, CTX = 256;
constexpr int ML = NB * SEQ, MC = NB * CTX, MT = ML + MC;
constexpr int DFF = 2816, RCW = 2560, NQKV = 1536, DLRU = 512;
constexpr int NCH = 264;
constexpr int NWAVES = 8;
constexpr float LOG2E = 1.4426950408889634f;
constexpr float QSCALE = 0.125f * LOG2E;

constexpr size_t MiB = 1u << 20;
constexpr size_t WS_WRCIN = 0, WS_WRCOUT = 5 * MiB, WS_WFIN0 = 7 * MiB, WS_WFIN1 = 18 * MiB, WS_WFOUT0 = 29 * MiB, WS_WFOUT1 = 29 * MiB + 5632 * 1024,
                 WS_WQKV = 40 * MiB, WS_WAOUT = 43 * MiB;
constexpr size_t WS_SMALL = 45 * MiB;
constexpr size_t WS_GW = WS_SMALL, WS_MOD = WS_SMALL + 256 * 1024, WS_ROPEC = WS_SMALL + 512 * 1024, WS_ROPES = WS_ROPEC + 8192, WS_SP8 = WS_ROPES + 8192,
                 WS_SUMA = WS_SMALL + 1 * MiB, WS_SUMB = WS_SMALL + 3 * MiB + 256 * 1024, WS_HIN = WS_SMALL + 5 * MiB + 512 * 1024;
constexpr size_t WS_HB = 53 * MiB;
constexpr size_t WS_X = 86 * MiB;
constexpr size_t WS_R1 = 152 * MiB;
constexpr size_t WS_Q = WS_R1, WS_KV = WS_R1 + 33 * MiB, WS_O = WS_KV + 17 * MiB;
constexpr size_t WS_SSP = 244 * MiB;
constexpr size_t WS_BV = 246 * MiB, WS_GM = 247 * MiB;
constexpr size_t WS_BTAIL = 235 * MiB;
constexpr size_t WS_CTL = 243 * MiB, CTL_BYTES = 65536;
constexpr size_t WS_PART = 248 * MiB;
constexpr size_t WS_END = 256 * MiB;
constexpr int CTL_CTXCNT = 4096;
static_assert(WS_O + (size_t)ML * DM * 2 <= WS_CTL && WS_R1 + (size_t)MT * DFF * 2 <= WS_CTL, "ws map");
static_assert(WS_SUMB - WS_SUMA >= (size_t)NB * NCH * 2 * DLRU * 4 && WS_HIN + (size_t)NB * NCH * 2 * DLRU * 4 <= WS_HB, "ws small map");

constexpr int LDS_BYTES = 147456;

struct Args { const float* in[24]; float* out; unsigned char* ws; int ph_lo, ph_hi; };

DI unsigned pk2(float lo, float hi) { f32x2_t v = {lo, hi}; bf16x2_t b = __builtin_convertvector(v, bf16x2_t); return __builtin_bit_cast(unsigned, b); }
DI float bflo(unsigned u) { return __uint_as_float(u << 16); }
DI float bfhi(unsigned u) { return __uint_as_float(u & 0xffff0000u); }
DI f32x4 unpack4(u32x2 u) { return (f32x4){bflo(u.x), bfhi(u.x), bflo(u.y), bfhi(u.y)}; }
DI u32x2 pack4(f32x4 v) { u32x2 r; r.x = pk2(v[0], v[1]); r.y = pk2(v[2], v[3]); return r; }
DI float wave_sum(float v) {
#pragma unroll
    for (int o = 1; o < 64; o <<= 1) v += __shfl_xor(v, o);
    return v;
}
DI float fast_exp(float x) { return __builtin_amdgcn_exp2f(x * LOG2E); }
DI float sigmoidf_(float x) { return __builtin_amdgcn_rcpf(1.f + fast_exp(-x)); }
DI float siluf_(float x) { return x * sigmoidf_(x); }
DI float gelu_tanh(float x) { const float u = 0.7978845608028654f * (x + 0.044715f * x * x * x); return x * __builtin_amdgcn_rcpf(1.f + fast_exp(-2.f * u)); }
DI int bsel(int row) { return row < SEQ ? 0 : (row < ML ? 1 : 2); }
DI void wait_count(unsigned* cnt, unsigned want, int tid) {
    if (tid == 0) { unsigned sp = 0;
        while (__hip_atomic_load(cnt, __ATOMIC_RELAXED, __HIP_MEMORY_SCOPE_AGENT) < want) { __builtin_amdgcn_s_sleep(2); if (++sp > (1u << 22)) break; }
        __builtin_amdgcn_fence(__ATOMIC_ACQUIRE, "agent"); asm volatile("s_waitcnt vmcnt(0)" ::: "memory"); }
    __syncthreads();
}

struct EpiStore {
    static constexpr bool PERM = true, AFTER_DRAIN = false;
    bf16* O; int ldc;
    DI void operator()(const f32x4 (&acc)[2][2][4][2], const pg8::Unit& u, int wr, int wc, int fr, int fq) const {
        const int row0 = u.pm * 256 + wr * 64 + fr, col0 = u.pn * 256 + wc * 32 + 8 * fq;
#pragma unroll
        for (int ai = 0; ai < 2; ++ai)
#pragma unroll
            for (int m = 0; m < 4; ++m) { bf16* rowp = O + (size_t)(row0 + ai * 128 + m * 16) * ldc + col0;
#pragma unroll
                for (int bj = 0; bj < 2; ++bj) { const f32x4 v0 = acc[ai][bj][m][0], v1 = acc[ai][bj][m][1];
                    u32x4 w; w.x = pk2(v0[0], v0[1]); w.y = pk2(v0[2], v0[3]); w.z = pk2(v1[0], v1[1]); w.w = pk2(v1[2], v1[3]);
                    *(u32x4*)(rowp + bj * 128) = w; } }
    }
};
constexpr int RS_TAB_OFF = 132096, RS_TAB_UNITS = 12;
template <class Sched> DI void rstd_table(LAS unsigned char* lds, const float* ssp, const Sched& S, int tid) {
    LAS float* tab = (LAS float*)(lds + RS_TAB_OFF);
    pg8::Unit u;
    for (int i = 0; i < RS_TAB_UNITS && S.next(i, u); ++i) {
        const int rr = tid >> 1, hf = tid & 1; const f32x4* q = (const f32x4*)(ssp + (size_t)(u.pm * 256 + rr) * 16 + hf * 8); const f32x4 a = q[0], b = q[1];
        float s = ((a[0] + a[1]) + (a[2] + a[3])) + ((b[0] + b[1]) + (b[2] + b[3]));
        s += __shfl_xor(s, 1);
        if (hf == 0) tab[i * 256 + rr] = 1.0f / sqrtf(s * (1.f / DM) + 1e-6f);
    }
    __syncthreads();
}
DI float row_rstd(LAS unsigned char* lds, int ord, int rin) { return ((const LAS float*)(lds + RS_TAB_OFF))[ord * 256 + rin]; }
struct EpiSwiGLU {
    static constexpr bool PERM = true, AFTER_DRAIN = false;
    bf16* O; int ldc; LAS unsigned char* lds; const float* bias; bool wt;
    DI void operator()(const f32x4 (&acc)[2][2][4][2], const pg8::Unit& u, int wr, int wc, int fr, int fq) const {
        const int row0 = u.pm * 256 + wr * 64 + fr, col0 = u.pn * 128 + wc * 32 + 8 * fq;
        const int bs = u.pm < 32 ? 0 : (u.pm < 64 ? 1 : 2);
        const float* bp = bias + bs * (2 * DFF) + u.pn * 256 + wc * 32 + 8 * fq;
        f32x4 bv[2][2];
#pragma unroll
        for (int bj = 0; bj < 2; ++bj)
#pragma unroll
            for (int n = 0; n < 2; ++n) bv[bj][n] = *(const f32x4*)(bp + bj * 128 + 4 * n);
#pragma unroll
        for (int ai = 0; ai < 2; ++ai)
#pragma unroll
            for (int m = 0; m < 4; ++m) { const int r = row0 + ai * 128 + m * 16; bf16* rowp = O + (size_t)r * ldc + col0;
                const float rs = row_rstd(lds, u.ord, wr * 64 + fr + ai * 128 + m * 16);
                float v[8];
#pragma unroll
                for (int n = 0; n < 2; ++n)
#pragma unroll
                    for (int j = 0; j < 4; ++j) v[n * 4 + j] = siluf_(__builtin_fmaf(acc[ai][0][m][n][j], rs, bv[0][n][j])) * __builtin_fmaf(acc[ai][1][m][n][j], rs, bv[1][n][j]);
                u32x4 w; w.x = pk2(v[0], v[1]); w.y = pk2(v[2], v[3]); w.z = pk2(v[4], v[5]); w.w = pk2(v[6], v[7]);
                if (wt && (WT_ALL || u.pm >= 64)) { const __amdgpu_buffer_rsrc_t rsr = __builtin_amdgcn_make_buffer_rsrc(O, 0, MT * DFF * 2, 0x00020000);
                    __builtin_amdgcn_raw_buffer_store_b128(w, rsr, (unsigned)(((size_t)r * ldc + col0) * 2), 0, 16); }
                else *(u32x4*)rowp = w; }
    }
};
template <bool BASEBF> struct EpiResid {
    static constexpr bool PERM = true, AFTER_DRAIN = false;
    const void* baseL; const void* baseC;
    bf16* X; const float* gate;
    bf16* HBn; const float* gm; float* ssp;
    DI void operator()(const f32x4 (&acc)[2][2][4][2], const pg8::Unit& u, int wr, int wc, int fr, int fq) const {
        const int bs = u.pm < 32 ? 0 : (u.pm < 64 ? 1 : 2);
        const int col0 = u.pn * 256 + wc * 32 + 8 * fq;
        const float* gp = gate + bs * 6144 + col0;
        f32x4 gv[2][2], gmv[2][2];
#pragma unroll
        for (int bj = 0; bj < 2; ++bj)
#pragma unroll
            for (int n = 0; n < 2; ++n) { gv[bj][n] = *(const f32x4*)(gp + bj * 128 + 4 * n); if (HBn) gmv[bj][n] = *(const f32x4*)(gm + bs * 1024 + col0 + bj * 128 + 4 * n); }
        if constexpr (BASEBF) {
#pragma unroll
            for (int ai = 0; ai < 2; ++ai) {
                u32x4 praw[4][2];
#pragma unroll
                for (int m = 0; m < 4; ++m) { const int r = u.pm * 256 + ai * 128 + wr * 64 + m * 16 + fr;
                    const bf16* bp = (const bf16*)(r < ML ? baseL : baseC) + (r < ML ? (size_t)r * DM : (size_t)(r - ML) * DM) + col0;
#pragma unroll
                    for (int bj = 0; bj < 2; ++bj) praw[m][bj] = *(const u32x4*)(bp + bj * 128); }
#pragma unroll
                for (int m = 0; m < 4; ++m) { const int r = u.pm * 256 + ai * 128 + wr * 64 + m * 16 + fr;
                    float ss = 0.f;
#pragma unroll
                    for (int bj = 0; bj < 2; ++bj) {
                        const f32x4 x0 = unpack4((u32x2){praw[m][bj].x, praw[m][bj].y}) + gv[bj][0] * acc[ai][bj][m][0], x1 = unpack4((u32x2){praw[m][bj].z, praw[m][bj].w}) + gv[bj][1] * acc[ai][bj][m][1];
                        const u32x2 a_ = pack4(x0), b_ = pack4(x1);
                        *(u32x4*)(X + (size_t)r * DM + col0 + bj * 128) = (u32x4){a_.x, a_.y, b_.x, b_.y};
                        if (HBn) { ss += ((x0[0] * x0[0] + x0[1] * x0[1]) + (x0[2] * x0[2] + x0[3] * x0[3])) + ((x1[0] * x1[0] + x1[1] * x1[1]) + (x1[2] * x1[2] + x1[3] * x1[3]));
                            const u32x2 c_ = pack4(x0 * gmv[bj][0]), d_ = pack4(x1 * gmv[bj][1]);
                            *(u32x4*)(HBn + (size_t)r * DM + col0 + bj * 128) = (u32x4){c_.x, c_.y, d_.x, d_.y}; } }
                    if (HBn) { ss += __shfl_xor(ss, 16); ss += __shfl_xor(ss, 32); if (fq == 0) ssp[(size_t)r * 16 + u.pn * 4 + wc] = ss; } }
                asm volatile("" ::: "memory");
            }
        } else {
#pragma unroll
            for (int h2 = 0; h2 < 4; ++h2) { const int ai = h2 >> 1, m0 = (h2 & 1) * 2;
                f32x4 pre[2][2][2];
#pragma unroll
                for (int mm = 0; mm < 2; ++mm) { const int r = u.pm * 256 + ai * 128 + wr * 64 + (m0 + mm) * 16 + fr;
                    const float* bp = (const float*)(r < ML ? baseL : baseC) + (r < ML ? (size_t)r * DM : (size_t)(r - ML) * DM) + col0;
#pragma unroll
                    for (int bj = 0; bj < 2; ++bj)
#pragma unroll
                        for (int n = 0; n < 2; ++n) pre[mm][bj][n] = *(const f32x4*)(bp + bj * 128 + 4 * n); }
#pragma unroll
                for (int mm = 0; mm < 2; ++mm) { const int m = m0 + mm; const int r = u.pm * 256 + ai * 128 + wr * 64 + m * 16 + fr;
                    float ss = 0.f;
#pragma unroll
                    for (int bj = 0; bj < 2; ++bj) {
                        const f32x4 x0 = pre[mm][bj][0] + gv[bj][0] * acc[ai][bj][m][0], x1 = pre[mm][bj][1] + gv[bj][1] * acc[ai][bj][m][1];
                        const u32x2 a_ = pack4(x0), b_ = pack4(x1);
                        *(u32x4*)(X + (size_t)r * DM + col0 + bj * 128) = (u32x4){a_.x, a_.y, b_.x, b_.y};
                        if (HBn) { ss += ((x0[0] * x0[0] + x0[1] * x0[1]) + (x0[2] * x0[2] + x0[3] * x0[3])) + ((x1[0] * x1[0] + x1[1] * x1[1]) + (x1[2] * x1[2] + x1[3] * x1[3]));
                            const u32x2 c_ = pack4(x0 * gmv[bj][0]), d_ = pack4(x1 * gmv[bj][1]);
                            *(u32x4*)(HBn + (size_t)r * DM + col0 + bj * 128) = (u32x4){c_.x, c_.y, d_.x, d_.y}; } }
                    if (HBn) { ss += __shfl_xor(ss, 16); ss += __shfl_xor(ss, 32); if (fq == 0) ssp[(size_t)r * 16 + u.pn * 4 + wc] = ss; } }
                asm volatile("" ::: "memory");
            }
        }
    }
};
struct EpiQKV {
    static constexpr bool PERM = false, AFTER_DRAIN = false;
    bf16 *Q, *KV; const float *ropec, *ropes; LAS unsigned char* lds; const float* bias;
    DI void operator()(const f32x4 (&acc)[2][2][4][2], const pg8::Unit& u, int wr, int wc, int fr, int fq) const {
        const bool rope_on = (u.pm < 64) && (u.pn < 5);
        const float scale = u.pn < 4 ? QSCALE : 1.0f;
        bf16* dst = u.pn < 4 ? Q + u.pn * 256 : KV + (u.pn - 4) * 256; const int ld = u.pn < 4 ? DM : 512;
        const int ax = wc & 1, cc = wc * 32 + 4 * fq;
        const int bs = u.pm < 32 ? 0 : (u.pm < 64 ? 1 : 2);
        const float* bp = bias + bs * NQKV + u.pn * 256 + cc;
        f32x4 bv[2][2];
#pragma unroll
        for (int bj = 0; bj < 2; ++bj)
#pragma unroll
            for (int n = 0; n < 2; ++n) bv[bj][n] = *(const f32x4*)(bp + bj * 128 + n * 16);
#pragma unroll
        for (int ai = 0; ai < 2; ++ai)
#pragma unroll
            for (int m = 0; m < 4; ++m) { const int r = u.pm * 256 + ai * 128 + wr * 64 + m * 16 + fr;
                const float rs = row_rstd(lds, u.ord, ai * 128 + wr * 64 + m * 16 + fr);
                const int s = r & (SEQ - 1); const int pos = ax ? (s & 63) : (s >> 6);
                f32x4 c4 = (f32x4){1.f, 1.f, 1.f, 1.f}, s4 = (f32x4){0.f, 0.f, 0.f, 0.f};
                if (rope_on) { c4 = *(const f32x4*)(ropec + pos * 16 + 4 * fq); s4 = *(const f32x4*)(ropes + pos * 16 + 4 * fq); }
                bf16* p = dst + (size_t)r * ld + cc;
#pragma unroll
                for (int bj = 0; bj < 2; ++bj) { const f32x4 x1 = acc[ai][bj][m][0] * rs + bv[bj][0], x2 = acc[ai][bj][m][1] * rs + bv[bj][1];
                    const f32x4 o1 = (x1 * c4 - x2 * s4) * scale, o2 = (x2 * c4 + x1 * s4) * scale;
                    *(u32x2*)(p + bj * 128) = pack4(o1); *(u32x2*)(p + bj * 128 + 16) = pack4(o2); } }
    }
};

DI void item_desc(const Args& a, int it, const float*& src, int& ldN, bf16*& dst, int& K) {
    unsigned char* ws = a.ws;
    constexpr int I0 = 16 * 80, I1 = 16 * 32, I2 = 16 * 176, I4 = 44 * 32, I6 = 16 * 48;
    const float* W; bf16* WT; int N; bool remap = false; int r = it;
    if (r < I0) { W = a.in[11]; K = 1024; N = RCW; WT = (bf16*)(ws + WS_WRCIN); }
    else if ((r -= I0) < I2) { W = a.in[9]; K = 1024; N = 2 * DFF; WT = (bf16*)(ws + WS_WFIN0); remap = true; }
    else if ((r -= I2) < I6) { W = a.in[21]; K = 1024; N = NQKV; WT = (bf16*)(ws + WS_WQKV); }
    else if ((r -= I6) < I1) { W = a.in[20]; K = 1024; N = 1024; WT = (bf16*)(ws + WS_WRCOUT); }
    else if ((r -= I1) < I4) { W = a.in[10]; K = DFF; N = 1024; WT = (bf16*)(ws + WS_WFOUT0); }
    else if ((r -= I4) < I2) { W = a.in[9] + (size_t)1024 * 2 * DFF; K = 1024; N = 2 * DFF; WT = (bf16*)(ws + WS_WFIN1); remap = true; }
    else if ((r -= I2) < I1) { W = a.in[23]; K = 1024; N = 1024; WT = (bf16*)(ws + WS_WAOUT); }
    else { r -= I1; W = a.in[10] + (size_t)DFF * 1024; K = DFF; N = 1024; WT = (bf16*)(ws + WS_WFOUT1); }
    const int nblk = N / 32, kb = r / nblk, nb = r % nblk; const int dst_n0 = 32 * nb; int src_n0 = dst_n0;
    if (remap) { const int pn = dst_n0 >> 8, w = dst_n0 & 255; src_n0 = (w < 128) ? 128 * pn + w : DFF + 128 * pn + (w - 128); }
    ldN = N; src = W + (size_t)(64 * kb) * N + src_n0; dst = WT + (size_t)dst_n0 * K + 64 * kb;
}
constexpr int COPY_NITEMS = 16 * 80 + 16 * 32 + 2 * 16 * 176 + 2 * 44 * 32 + 16 * 48 + 16 * 32;
constexpr int COPY_GA = 16 * 80 + 16 * 176 + 16 * 48;
constexpr int COPY_G1 = 16 * 80 + 16 * 32 + 16 * 176 + 16 * 48, COPY_G2 = COPY_G1 + 44 * 32, COPY_G3 = COPY_G2 + 16 * 176 + 16 * 32;
static_assert(COPY_G3 + 44 * 32 == COPY_NITEMS, "copy groups");
DI void copy_items(const Args& a, LAS unsigned char* lds, int wave, int lane, int first, int second, int stride, int end) {
    LAS float* scr = (LAS float*)(lds + wave * 16384);
    int it = first; bool fst = true;
    float tv[32], tn[32];
    const float* src; int ldN; bf16* dst; int K;
    if (it < end) { item_desc(a, it, src, ldN, dst, K);
#pragma unroll
        for (int i = 0; i < 32; ++i) tv[i] = src[(size_t)(2 * i + (lane >> 5)) * ldN + (lane & 31)]; }
    while (it < end) {
        bf16* dcur = dst; const int Kcur = K;
        const int nx = fst ? second : it + stride; fst = false;
        const bool more = nx < end;
        if (more) { item_desc(a, nx, src, ldN, dst, K);
#pragma unroll
            for (int i = 0; i < 32; ++i) tn[i] = src[(size_t)(2 * i + (lane >> 5)) * ldN + (lane & 31)]; }
#pragma unroll
        for (int i = 0; i < 32; ++i) scr[(2 * i + (lane >> 5)) * 33 + (lane & 31)] = tv[i];
        asm volatile("s_waitcnt lgkmcnt(0)" ::: "memory");
        const int c = lane & 7;
#pragma unroll
        for (int j = 0; j < 4; ++j) { const int n = (lane >> 3) + 8 * j; const LAS float* s_ = scr + (8 * c) * 33 + n;
            u32x4 o; o.x = pk2(s_[0 * 33], s_[1 * 33]); o.y = pk2(s_[2 * 33], s_[3 * 33]); o.z = pk2(s_[4 * 33], s_[5 * 33]); o.w = pk2(s_[6 * 33], s_[7 * 33]);
            *(u32x4*)(dcur + (size_t)n * Kcur + 8 * c) = o; }
        asm volatile("s_waitcnt lgkmcnt(0)" ::: "memory");
        if (more) {
#pragma unroll
            for (int i = 0; i < 32; ++i) tv[i] = tn[i]; }
        it = nx;
    }
}
DI void ada_items(const Args& a, LAS unsigned char* lds, int tid, int wave, int lane, int first, int last, int brank, int nblk, unsigned* cnt) {
    LAS float* red = (LAS float*)lds;
    float* MOD = (float*)(a.ws + WS_MOD);
    for (int it = first + brank; it < last; it += nblk) {
        __syncthreads();
        const int l = it / 96, n0 = (it % 96) * 64, cl = lane & 15, ksub = lane >> 4;
        f32x4 a0 = {0.f, 0.f, 0.f, 0.f}, a1 = a0, a2 = a0;
        const float* wbase = a.in[4] + (size_t)l * 1024 * 6144 + n0 + 4 * cl;
#pragma unroll 16
        for (int i = 0; i < 32; ++i) { const int k = 128 * wave + 4 * i + ksub;
            const f32x4 w = *(const f32x4*)(wbase + (size_t)k * 6144);
            const float s0 = siluf_(a.in[1][k]), s1 = siluf_(a.in[1][1024 + k]), s2 = siluf_(a.in[3][k]);
            a0 += w * s0; a1 += w * s1; a2 += w * s2; }
#pragma unroll
        for (int j = 0; j < 4; ++j) { a0[j] += __shfl_xor(a0[j], 16); a0[j] += __shfl_xor(a0[j], 32); a1[j] += __shfl_xor(a1[j], 16); a1[j] += __shfl_xor(a1[j], 32); a2[j] += __shfl_xor(a2[j], 16); a2[j] += __shfl_xor(a2[j], 32); }
        if (ksub == 0) {
#pragma unroll
            for (int j = 0; j < 4; ++j) { red[(wave * 3 + 0) * 64 + 4 * cl + j] = a0[j]; red[(wave * 3 + 1) * 64 + 4 * cl + j] = a1[j]; red[(wave * 3 + 2) * 64 + 4 * cl + j] = a2[j]; } }
        __syncthreads();
        if (tid < 192) { const int bs = tid >> 6, col = tid & 63; float s_ = a.in[5][l * 6144 + n0 + col];
#pragma unroll
            for (int w = 0; w < 8; ++w) s_ += red[(w * 3 + bs) * 64 + col];
            __hip_atomic_store(MOD + (size_t)(l * 3 + bs) * 6144 + n0 + col, s_, __ATOMIC_RELAXED, __HIP_MEMORY_SCOPE_AGENT); }
        if (cnt) { asm volatile("s_waitcnt vmcnt(0)" ::: "memory"); __syncthreads(); if (tid == 0) __hip_atomic_fetch_add(cnt, 1u, __ATOMIC_RELAXED, __HIP_MEMORY_SCOPE_AGENT); }
    }
    __syncthreads();
}
constexpr int CTL_ADA = 12288;
DI void prologue(const Args& a, LAS unsigned char* lds, int tid, int lane, int wave) {
    unsigned char* ws = a.ws;
    unsigned* adacnt = (unsigned*)(ws + WS_CTL) + CTL_ADA;
    const bool deal = (gridDim.x == 256);
    const int n_ada = deal ? 96 : 192;
    ada_items(a, lds, tid, wave, lane, 0, n_ada, blockIdx.x, gridDim.x, adacnt);
    {
        const int gw = blockIdx.x * NWAVES + wave, NGW = gridDim.x * NWAVES;
        const int base = deal ? 1280 : 0; const bool ex = deal && blockIdx.x >= 96;
        copy_items(a, lds, wave, lane, ex ? (blockIdx.x - 96) * NWAVES + wave : base + gw, ex ? base + gw : base + gw + NGW, NGW, deal ? COPY_GA : COPY_NITEMS);
    }
    {
        const int gt = blockIdx.x * 512 + tid, NT = gridDim.x * 512;
        bf16* GW = (bf16*)(ws + WS_GW);
        for (int idx = gt; idx < 131072; idx += NT) {
            const int j = idx & 7, ln = (idx >> 3) & 63, ks = (idx >> 9) & 3, mt = (idx >> 11) & 1, head = (idx >> 12) & 7, dg = idx >> 15;
            const int hi = ln >> 5, m = ln & 31;
            const int cin = 32 * (ks >> 1) + 16 * (ks & 1) + 8 * (j >> 2) + 4 * hi + (j & 3), cout = 32 * mt + m;
            const int d = dg >> 1; const float* src = (dg & 1) ? a.in[16] : a.in[14];
            const float v = src[((size_t)(d * 8 + head) * 64 + cin) * 64 + cout];
            GW[idx] = (bf16)(pk2(v, 0.f) & 0xffffu);
        }
        float* sp8 = (float*)(ws + WS_SP8);
        for (int idx = gt; idx < 2 * DLRU; idx += NT) sp8[idx] = -8.0f * log1pf(expf(-a.in[18][idx]));
        float* rc = (float*)(ws + WS_ROPEC); float* rs = (float*)(ws + WS_ROPES);
        for (int idx = blockIdx.x * 8 + tid; tid < 8 && idx < 2048; idx += gridDim.x * 8) {
            const int pos = idx >> 4, f = idx & 15;
            const float inv = exp2f((float)f * -0.83048202372184058696f);
            const float ang = (float)pos * inv;
            double x = (double)ang; const double n = rint(x * 0.15915494309189535); x -= n * 6.283185307179586476925;
            const double x2 = x * x; double cs = 1.0, sn = 1.0;
            { double t = 1.0, s_ = 1.0;
#pragma unroll
              for (int i = 1; i <= 14; ++i) { t *= -x2 * (1.0 / (double)((2 * i - 1) * (2 * i))); s_ += t; } cs = s_; }
            { double t = 1.0, s_ = 1.0;
#pragma unroll
              for (int i = 1; i <= 14; ++i) { t *= -x2 * (1.0 / (double)((2 * i) * (2 * i + 1))); s_ += t; } sn = s_ * x; }
            rc[idx] = (float)cs; rs[idx] = (float)sn;
        }
    }
    wait_count(adacnt, (unsigned)n_ada, tid);

}

DI void norm_mod_phase(const float* srcL, const float* srcC, int nrows, const float* g, const float* mod, int shk, int sck, bf16* dst, int wave, int lane) {
    const int gw = blockIdx.x * NWAVES + wave, NGW = gridDim.x * NWAVES;
    f32x4 v[3][4], vn[3][4];
#pragma unroll
    for (int q = 0; q < 3; ++q) { const int row = gw + q * NGW;
        if (row < nrows) { const f32x4* x4 = (const f32x4*)(row < ML ? srcL + (size_t)row * DM : srcC + (size_t)(row - ML) * DM) + lane;
#pragma unroll
            for (int j = 0; j < 4; ++j) v[q][j] = x4[64 * j]; } }
    for (int base = gw; base < nrows; base += 3 * NGW) {
#pragma unroll
        for (int q = 0; q < 3; ++q) { const int row = base + (3 + q) * NGW;
            if (row < nrows) { const f32x4* x4 = (const f32x4*)(row < ML ? srcL + (size_t)row * DM : srcC + (size_t)(row - ML) * DM) + lane;
#pragma unroll
                for (int j = 0; j < 4; ++j) vn[q][j] = x4[64 * j]; } }
#pragma unroll
        for (int q = 0; q < 3; ++q) { const int row = base + q * NGW;
            if (row < nrows) {
                const float* mb = mod + bsel(row) * 6144;
                float ss = 0.f;
#pragma unroll
                for (int j = 0; j < 4; ++j) ss += (v[q][j][0] * v[q][j][0] + v[q][j][1] * v[q][j][1]) + (v[q][j][2] * v[q][j][2] + v[q][j][3] * v[q][j][3]);
                const float rstd = 1.0f / sqrtf(wave_sum(ss) * (1.f / DM) + 1e-6f);
                u32x2* o = (u32x2*)(dst + (size_t)row * DM) + lane;
#pragma unroll
                for (int j = 0; j < 4; ++j) { const f32x4 gg = ((const f32x4*)g)[lane + 64 * j], sc = ((const f32x4*)(mb + sck * 1024))[lane + 64 * j], sh = ((const f32x4*)(mb + shk * 1024))[lane + 64 * j];
                    const f32x4 y = (v[q][j] * rstd * gg) * (sc + 1.0f) + sh; o[64 * j] = pack4(y); } } }
#pragma unroll
        for (int q = 0; q < 3; ++q)
#pragma unroll
            for (int j = 0; j < 4; ++j) v[q][j] = vn[q][j];
    }
}
DI void final_norm_phase(const bf16* X, const float* g, float* out, int wave, int lane) {
    const int gw = blockIdx.x * NWAVES + wave, NGW = gridDim.x * NWAVES;
    for (int row = gw; row < ML; row += NGW) {
        const u32x2* x2 = (const u32x2*)(X + (size_t)row * DM) + lane;
        f32x4 v[4]; float ss = 0.f;
#pragma unroll
        for (int j = 0; j < 4; ++j) { v[j] = unpack4(x2[64 * j]); ss += (v[j][0] * v[j][0] + v[j][1] * v[j][1]) + (v[j][2] * v[j][2] + v[j][3] * v[j][3]); }
        const float rstd = 1.0f / sqrtf(wave_sum(ss) * (1.f / DM) + 1e-6f);
        f32x4* o = (f32x4*)(out + (size_t)row * DM) + lane;
#pragma unroll
        for (int j = 0; j < 4; ++j) o[64 * j] = v[j] * rstd * ((const f32x4*)g)[lane + 64 * j];
    }
}

DI void aux_bias_f32(const Args& a, LAS unsigned char* lds, int tid, int wave, int lane, int brank, int nblk) {
    unsigned char* ws = a.ws;
    const float* sh = (const float*)(ws + WS_MOD) + (size_t)3 * 6144 + 3 * 1024;
    const float* W = a.in[9] + (size_t)1024 * 2 * DFF;
    float* BV2 = (float*)(ws + WS_BV) + (size_t)2 * 3 * (2 * DFF);
    LAS float* red = (LAS float*)lds;
    for (int it = brank; it < 2 * DFF / 64; it += nblk) {
        __syncthreads();
        const int c0 = 64 * it, cl = lane & 15, ksub = lane >> 4;
        f32x4 a0 = {0.f, 0.f, 0.f, 0.f}, a1 = a0;
#pragma unroll 16
        for (int i = 0; i < 32; ++i) { const int k = 128 * wave + 4 * i + ksub;
            const f32x4 w = *(const f32x4*)(W + (size_t)k * (2 * DFF) + c0 + 4 * cl);
            a0 += w * sh[k]; a1 += w * sh[6144 + k]; }
#pragma unroll
        for (int j = 0; j < 4; ++j) { a0[j] += __shfl_xor(a0[j], 16); a0[j] += __shfl_xor(a0[j], 32); a1[j] += __shfl_xor(a1[j], 16); a1[j] += __shfl_xor(a1[j], 32); }
        if (ksub == 0) {
#pragma unroll
            for (int j = 0; j < 4; ++j) { red[(wave * 2 + 0) * 64 + 4 * cl + j] = a0[j]; red[(wave * 2 + 1) * 64 + 4 * cl + j] = a1[j]; } }
        __syncthreads();
        if (tid < 128) { const int bs = tid >> 6, col = tid & 63; float s_ = 0.f;
#pragma unroll
            for (int w = 0; w < 8; ++w) s_ += red[(w * 2 + bs) * 64 + col];
            const int c = c0 + col, half = c >= DFF ? 1 : 0, cc = c - half * DFF, np = 256 * (cc >> 7) + 128 * half + (cc & 127);
            BV2[(size_t)bs * (2 * DFF) + np] = s_; }
    }
    __syncthreads();
}
DI void aux_phase(const Args& a, int tid, int wave, int lane, int brank, int nblk, int lmask) {
    unsigned char* ws = a.ws;
    const float* MOD = (const float*)(ws + WS_MOD);
    float* GM = (float*)(ws + WS_GM); float* BV = (float*)(ws + WS_BV);
    const int gt = brank * 512 + tid, NT = nblk * 512;
    for (int idx = gt; idx < 9 * 1024; idx += NT) { const int c = idx & 1023, bs = (idx >> 10) % 3, which = idx / 3072;
        if (!((lmask >> (which == 0 ? 0 : 1)) & 1)) continue;
        const float g = which == 0 ? a.in[7][c] : (which == 1 ? a.in[6][DM + c] : a.in[7][DM + c]);
        const float sc = MOD[(size_t)((which == 0 ? 0 : 1) * 3 + bs) * 6144 + (which == 1 ? 1 : 4) * 1024 + c];
        GM[idx] = g * (1.0f + sc); }
    const int gw = brank * NWAVES + wave, NGW = nblk * NWAVES;
    for (int it = gw; it < 2 * DFF + NQKV; it += NGW) {
        int which, n; if (it < 2 * DFF) { which = 0; n = it; } else { which = 1; n = it - 2 * DFF; }
        if (!((lmask >> which) & 1)) continue;
        const bf16* Bt = (const bf16*)(ws + (which == 0 ? WS_WFIN0 : (which == 1 ? WS_WQKV : WS_WFIN1))) + (size_t)n * DM + 16 * lane;
        const int N = which == 1 ? NQKV : 2 * DFF;
        const float* shb = MOD + (size_t)((which == 0 ? 0 : 1) * 3) * 6144 + (which == 1 ? 0 : 3) * 1024 + 16 * lane;
        const u32x4 w0 = *(const u32x4*)Bt, w1 = *(const u32x4*)(Bt + 8);
        const f32x4 wv[4] = {unpack4((u32x2){w0.x, w0.y}), unpack4((u32x2){w0.z, w0.w}), unpack4((u32x2){w1.x, w1.y}), unpack4((u32x2){w1.z, w1.w})};
        float acc[3];
#pragma unroll
        for (int bs = 0; bs < 3; ++bs) { float s_ = 0.f;
#pragma unroll
            for (int q = 0; q < 4; ++q) { const f32x4 sh = *(const f32x4*)(shb + bs * 6144 + 4 * q); s_ += (wv[q][0] * sh[0] + wv[q][1] * sh[1]) + (wv[q][2] * sh[2] + wv[q][3] * sh[3]); }
            acc[bs] = wave_sum(s_); }
        if (lane == 0) { float* o = BV + (size_t)which * 3 * (2 * DFF) + n; o[0] = acc[0]; o[N] = acc[1]; o[2 * N] = acc[2]; }
    }
}

constexpr int RG_UNITS = NB * NCH * 8;
typedef _Float16 f16x4_t __attribute__((ext_vector_type(4)));
DI u32x2 pack4h(f32x4 v) { f16x4_t h = __builtin_convertvector(v, f16x4_t); return __builtin_bit_cast(u32x2, h); }
DI f32x4 unpack4h(u32x2 u) { return __builtin_convertvector(__builtin_bit_cast(f16x4_t, u), f32x4); }
DI unsigned short* rg_acum_ptr(const Args& a, int unit) { return (unsigned short*)(a.ws + WS_X) + (size_t)unit * 4096; }
DI unsigned short* rg_bcum_ptr(const Args& a, int unit) { return (unsigned short*)a.out + (size_t)unit * 4096; }
template <int CTRL, int RMASK> DI float dppf(float oldv, float v) {
    return __builtin_bit_cast(float, __builtin_amdgcn_update_dpp(__builtin_bit_cast(int, oldv), __builtin_bit_cast(int, v), CTRL, RMASK, 0xf, false));
}
#define RG_SCAN_STEP(CTRL, RMASK) do { _Pragma("unroll") for (int r = 0; r < 16; ++r) { const float am = aR[r], bm = aI[r]; \
        const float ap = dppf<CTRL, RMASK>(1.0f, am), bp = dppf<CTRL, RMASK>(0.0f, bm); aR[r] = am * ap; aI[r] = __builtin_fmaf(am, bp, bm); } } while (0)
template <int D, int MT_> DI void rg1_quarter(const float (&xc)[2][16], const bf16x8 (&xb)[4], const LAS unsigned char* gwl, const LAS float* pv,
                                              unsigned short* acum, unsigned short* bcum, float* SUMA, float* SUMB, int lane, size_t sbase) {
    const int hi = lane >> 5;
    f32x16 aR, aI;
#pragma unroll
    for (int i = 0; i < 16; ++i) { aR[i] = 0.f; aI[i] = 0.f; }
#pragma unroll
    for (int ks = 0; ks < 4; ++ks) {
        const bf16x8 wr_ = *(const LAS bf16x8*)(gwl + ((((D * 2 + 0) * 2 + MT_) * 4 + ks) * 64 + lane) * 16);
        const bf16x8 wi_ = *(const LAS bf16x8*)(gwl + ((((D * 2 + 1) * 2 + MT_) * 4 + ks) * 64 + lane) * 16);
        aR = __builtin_amdgcn_mfma_f32_32x32x16_bf16(wr_, xb[ks], aR, 0, 0, 0);
        aI = __builtin_amdgcn_mfma_f32_32x32x16_bf16(wi_, xb[ks], aI, 0, 0, 0);
    }
#pragma unroll
    for (int rq = 0; rq < 4; ++rq) {
        const int c0 = 32 * MT_ + 8 * rq + 4 * hi;
        const f32x4 rb4 = *(const LAS f32x4*)(pv + 320 + D * 64 + c0), ib4 = *(const LAS f32x4*)(pv + 448 + D * 64 + c0), lm4 = *(const LAS f32x4*)(pv + 576 + D * 64 + c0);
#pragma unroll
        for (int j = 0; j < 4; ++j) { const int r = 4 * rq + j;
            const float rr = __builtin_amdgcn_rcpf(1.0f + __builtin_amdgcn_exp2f(__builtin_fmaf(aR[r], -LOG2E, rb4[j])));
            const float ii = __builtin_amdgcn_rcpf(1.0f + __builtin_amdgcn_exp2f(__builtin_fmaf(aI[r], -LOG2E, ib4[j])));
            const float av = __builtin_amdgcn_exp2f(rr * lm4[j]);
            const float mult = __builtin_amdgcn_sqrtf(fmaxf(__builtin_fmaf(-av, av, 1.0f), 1e-12f));
            aR[r] = av; aI[r] = mult * ii * xc[MT_][r]; }
    }
    if (D == 1) {
#pragma unroll
        for (int r = 0; r < 16; ++r) { aR[r] = __shfl_xor(aR[r], 31); aI[r] = __shfl_xor(aI[r], 31); }
    }
    RG_SCAN_STEP(0x111, 0xf);
    RG_SCAN_STEP(0x112, 0xf);
    RG_SCAN_STEP(0x114, 0xf);
    RG_SCAN_STEP(0x118, 0xf);
    RG_SCAN_STEP(0x142, 0xa);
#pragma unroll
    for (int rq = 0; rq < 4; ++rq) {
        *(u32x2*)(acum + ((D * 2 + MT_) * 4 + rq) * 256 + lane * 4) = pack4h((f32x4){aR[4 * rq], aR[4 * rq + 1], aR[4 * rq + 2], aR[4 * rq + 3]});
        *(u32x2*)(bcum + ((D * 2 + MT_) * 4 + rq) * 256 + lane * 4) = pack4h((f32x4){aI[4 * rq], aI[4 * rq + 1], aI[4 * rq + 2], aI[4 * rq + 3]});
    }
    if ((lane & 31) == 31) {
#pragma unroll
        for (int rq = 0; rq < 4; ++rq) { const int c0 = 32 * MT_ + 8 * rq + 4 * hi;
            *(f32x4*)(SUMA + sbase + D * DLRU + c0) = (f32x4){aR[4 * rq], aR[4 * rq + 1], aR[4 * rq + 2], aR[4 * rq + 3]};
            *(f32x4*)(SUMB + sbase + D * DLRU + c0) = (f32x4){aI[4 * rq], aI[4 * rq + 1], aI[4 * rq + 2], aI[4 * rq + 3]}; }
    }
}
template <int QMASK> DI void rg1_unit(const Args& a, const LAS unsigned char* gwl, const LAS float* pv, int cb, int head, int lane_in) {
    unsigned char* ws = a.ws;
    const bf16* U = (const bf16*)(ws + WS_R1);
    float* SUMA = (float*)(ws + WS_SUMA); float* SUMB = (float*)(ws + WS_SUMB);
    int lane_o = lane_in; asm volatile("" : "+v"(lane_o));
    const int lane = lane_o, tok = lane & 31, hi = lane >> 5;
    const int gc = cb >> 1, b = cb & 1, unit = cb * 8 + head;
    const bool lat = gc < 256;
    const int ts0 = lat ? gc * 32 : (gc - 256) * 32, len = lat ? SEQ : CTX, rowbase = lat ? b * SEQ : ML + b * CTX;
    const int ts = ts0 + tok;
    u32x2 tap[8][4];
#pragma unroll
    for (int k = 0; k < 4; ++k) { const int tt = ts - 2 + k; const bool ok = (tt >= 0) && (tt < len); const int ttc = ok ? tt : ts;
        const bf16* up = U + (size_t)(rowbase + ttc) * RCW + head * 64 + 4 * hi;
#pragma unroll
        for (int q = 0; q < 8; ++q) { u32x2 v = *(const u32x2*)(up + 8 * q); if (!ok) { v.x = 0u; v.y = 0u; } tap[q][k] = v; } }
    float xc[2][16];
#pragma unroll
    for (int q = 0; q < 8; ++q) {
        f32x4 acc = *(const LAS f32x4*)(pv + 256 + 8 * q + 4 * hi);
#pragma unroll
        for (int k = 0; k < 4; ++k) acc += *(const LAS f32x4*)(pv + k * 64 + 8 * q + 4 * hi) * unpack4(tap[q][k]);
#pragma unroll
        for (int j = 0; j < 4; ++j) xc[q >> 2][4 * (q & 3) + j] = acc[j];
    }
    bf16x8 xb[4];
#pragma unroll
    for (int ks = 0; ks < 4; ++ks) { const int mt = ks >> 1, r0 = 8 * (ks & 1);
        u32x4 p; p.x = pk2(xc[mt][r0], xc[mt][r0 + 1]); p.y = pk2(xc[mt][r0 + 2], xc[mt][r0 + 3]); p.z = pk2(xc[mt][r0 + 4], xc[mt][r0 + 5]); p.w = pk2(xc[mt][r0 + 6], xc[mt][r0 + 7]);
        xb[ks] = __builtin_bit_cast(bf16x8, p); }
    unsigned short* acum = rg_acum_ptr(a, unit); unsigned short* bcum = rg_bcum_ptr(a, unit);
    const size_t sbase = ((size_t)(b * NCH + gc) * 2) * DLRU + head * 64;
    if (QMASK & 1) { rg1_quarter<0, 0>(xc, xb, gwl, pv, acum, bcum, SUMA, SUMB, lane, sbase); asm volatile("" ::: "memory"); }
    if (QMASK & 2) { rg1_quarter<0, 1>(xc, xb, gwl, pv, acum, bcum, SUMA, SUMB, lane, sbase); asm volatile("" ::: "memory"); }
    if (QMASK & 4) { rg1_quarter<1, 0>(xc, xb, gwl, pv, acum, bcum, SUMA, SUMB, lane, sbase); asm volatile("" ::: "memory"); }
    if (QMASK & 8) { rg1_quarter<1, 1>(xc, xb, gwl, pv, acum, bcum, SUMA, SUMB, lane, sbase); asm volatile("" ::: "memory"); }
}
DI void rg1_phase(const Args& a, LAS unsigned char* lds, int tid, int lane, int wave) {
    unsigned char* ws = a.ws;
    const int head = blockIdx.x & 7, nbh = ((int)gridDim.x - head + 7) >> 3;
    const int wslot = (blockIdx.x >> 3) * NWAVES + wave, NWS = nbh * NWAVES;
    LAS unsigned char* gwl = lds; LAS float* pv = (LAS float*)(lds + 32768);
    {
        const bf16* GW = (const bf16*)(ws + WS_GW);
#pragma unroll
        for (int i = 0; i < 4; ++i) { const int idx16 = tid + 512 * i, dg = idx16 >> 9;
            *(LAS u32x4*)(gwl + idx16 * 16) = *(const u32x4*)(GW + (size_t)(dg * 8 + head) * 4096 + (idx16 & 511) * 8); }
        for (int t = tid; t < 704; t += 512) { const int c = t & 63; float v;
            if (t < 256) v = a.in[12][(t >> 6) * DLRU + head * 64 + c];
            else if (t < 320) v = a.in[13][head * 64 + c];
            else if (t < 448) v = -LOG2E * a.in[15][((t - 320) >> 6) * DLRU + head * 64 + c];
            else if (t < 576) v = -LOG2E * a.in[17][((t - 448) >> 6) * DLRU + head * 64 + c];
            else v = LOG2E * ((const float*)(ws + WS_SP8))[((t - 576) >> 6) * DLRU + head * 64 + c];
            pv[t] = v; }
        __syncthreads();
    }
    for (int cb = wslot; cb < 512; cb += NWS) rg1_unit<15>(a, gwl, pv, cb, head, lane);
    for (int qi = wslot; qi < 64; qi += NWS) { const int cb = 512 + (qi >> 2), qq = qi & 3;
        if (qq == 0) rg1_unit<1>(a, gwl, pv, cb, head, lane); else if (qq == 1) rg1_unit<2>(a, gwl, pv, cb, head, lane);
        else if (qq == 2) rg1_unit<4>(a, gwl, pv, cb, head, lane); else rg1_unit<8>(a, gwl, pv, cb, head, lane); }
    __syncthreads();
}
DI void rg_carry_phase(const Args& a, LAS unsigned char* lds, int wave, int lane) {
    unsigned char* ws = a.ws;
    const float* SUMA = (const float*)(ws + WS_SUMA); const float* SUMB = (const float*)(ws + WS_SUMB); float* HIN = (float*)(ws + WS_HIN);
    LAS float* sh = (LAS float*)lds;
    for (int it = blockIdx.x; it < 32; it += gridDim.x) {
        const int head = it & 7, d = (it >> 3) & 1, b = it >> 4;
        const int c = lane, seg = wave; const float* sa = SUMA + c; const float* sb = SUMB + c; float* ho = HIN + c;
        float av[33], bv[33];
#pragma unroll
        for (int i = 0; i < 33; ++i) { const int st = seg * 33 + i; const int gc = d == 0 ? (st + 256) % NCH : (NCH - 1 - st);
            const unsigned idx = (unsigned)(((b * NCH + gc) * 2 + d) * DLRU + head * 64); av[i] = sa[idx]; bv[i] = sb[idx]; }
        float A = 1.f, B = 0.f;
#pragma unroll
        for (int i = 0; i < 33; ++i) { B = av[i] * B + bv[i]; A = av[i] * A; }
        __syncthreads();
        sh[(seg * 64 + c) * 2] = A; sh[(seg * 64 + c) * 2 + 1] = B;
        __syncthreads();
        float h = 0.f;
        for (int s = 0; s < seg; ++s) h = sh[(s * 64 + c) * 2] * h + sh[(s * 64 + c) * 2 + 1];
#pragma unroll
        for (int i = 0; i < 33; ++i) { const int st = seg * 33 + i; const int gc = d == 0 ? (st + 256) % NCH : (NCH - 1 - st);
            const unsigned idx = (unsigned)(((b * NCH + gc) * 2 + d) * DLRU + head * 64); ho[idx] = h; h = av[i] * h + bv[i]; }
    }
    __syncthreads();
}
struct Rg3In { u32x2 A[2][4], B[2][4], ga[4]; f32x4 H[2][4]; };
DI void rg3_load(const Args& a, int hu, int lane, Rg3In& r, int& row, int& ycol) {
    unsigned char* ws = a.ws;
    const bf16* U = (const bf16*)(ws + WS_R1); const float* HIN = (const float*)(ws + WS_HIN);
    const int tok = lane & 31, hi = lane >> 5;
    const int mt = hu & 1, unit = hu >> 1, head = unit & 7, cb = unit >> 3, gc = cb >> 1, b = cb & 1;
    row = (gc < 256 ? b * SEQ + gc * 32 : ML + b * CTX + (gc - 256) * 32) + tok; ycol = head * 64 + 32 * mt + 4 * hi;
    const unsigned short* acum = rg_acum_ptr(a, unit) + mt * 1024 + lane * 4; const unsigned short* bcum = rg_bcum_ptr(a, unit) + mt * 1024 + lane * 4;
    const float* hin = HIN + ((size_t)(b * NCH + gc) * 2) * DLRU + head * 64 + 32 * mt + 4 * hi;
#pragma unroll
    for (int d = 0; d < 2; ++d)
#pragma unroll
        for (int rq = 0; rq < 4; ++rq) { r.A[d][rq] = *(const u32x2*)(acum + d * 2048 + rq * 256); r.B[d][rq] = *(const u32x2*)(bcum + d * 2048 + rq * 256); r.H[d][rq] = *(const f32x4*)(hin + d * DLRU + 8 * rq); }
#pragma unroll
    for (int rq = 0; rq < 4; ++rq) r.ga[rq] = *(const u32x2*)(U + (size_t)row * RCW + DLRU + ycol + 8 * rq);
}
DI void rg3_phase(const Args& a, int wave, int lane_in) {
    bf16* Y = (bf16*)(a.ws + WS_HB);
    const int gw = blockIdx.x * NWAVES + wave, NGW = gridDim.x * NWAVES;
    int lane_o = lane_in; asm volatile("" : "+v"(lane_o));
    const int lane = lane_o;
    Rg3In cur, nxt; int row = 0, ycol = 0, nrow = 0, nycol = 0;
    if (gw < 2 * RG_UNITS) rg3_load(a, gw, lane, cur, row, ycol);
    for (int hu = gw; hu < 2 * RG_UNITS; hu += NGW) {
        const bool more = hu + NGW < 2 * RG_UNITS;
        if (more) rg3_load(a, hu + NGW, lane, nxt, nrow, nycol);
#pragma unroll
        for (int rq = 0; rq < 4; ++rq) { const f32x4 ga = unpack4(cur.ga[rq]), A0 = unpack4h(cur.A[0][rq]), A1 = unpack4h(cur.A[1][rq]), B0 = unpack4h(cur.B[0][rq]), B1 = unpack4h(cur.B[1][rq]); f32x4 y;
#pragma unroll
            for (int j = 0; j < 4; ++j) { const float h0 = __builtin_fmaf(A0[j], cur.H[0][rq][j], B0[j]), h1 = __builtin_fmaf(A1[j], cur.H[1][rq][j], B1[j]);
                y[j] = (h0 + __shfl_xor(h1, 31)) * gelu_tanh(ga[j]); }
            *(u32x2*)(Y + (size_t)row * DM + ycol + 8 * rq) = pack4(y); }
        if (more) { cur = nxt; row = nrow; ycol = nycol; }
    }
}
DI void sc_phase(const Args& a, int wave, int lane) {
    unsigned char* ws = a.ws;
    const bf16* U = (const bf16*)(ws + WS_R1);
    bf16* Y = (bf16*)(ws + WS_HB);
    const float* convB = a.in[19];
    const int gw = blockIdx.x * NWAVES + wave, NGW = gridDim.x * NWAVES;
    f32x4 w[3][2];
#pragma unroll
    for (int k = 0; k < 3; ++k) { w[k][0] = *(const f32x4*)(convB + k * DLRU + 8 * lane); w[k][1] = *(const f32x4*)(convB + k * DLRU + 8 * lane + 4); }
    for (int tile = gw; tile < MT / 8; tile += NGW) {
        const int row0 = tile * 8;
        const int seq0 = row0 < ML ? (row0 & ~(SEQ - 1)) : ML + ((row0 - ML) & ~(CTX - 1)), seqlen = row0 < ML ? SEQ : CTX;
        const bf16* up = U + (size_t)row0 * RCW + 8 * lane;
        u32x4 cgr[10], vr[10], bgr[8];
#pragma unroll
        for (int i = 0; i < 10; ++i) { const int r = row0 - 1 + i; const bool ok = (r >= seq0) && (r < seq0 + seqlen); const bf16* q = up + (ptrdiff_t)(ok ? i - 1 : 0) * RCW;
            cgr[i] = *(const u32x4*)(q + 3 * DLRU); vr[i] = *(const u32x4*)(q + 4 * DLRU); if (!ok) { cgr[i] = (u32x4){0u, 0u, 0u, 0u}; } }
#pragma unroll
        for (int i = 0; i < 8; ++i) bgr[i] = *(const u32x4*)(up + (size_t)i * RCW + 2 * DLRU);
        f32x4 p[10][2];
#pragma unroll
        for (int i = 0; i < 10; ++i) { p[i][0] = unpack4((u32x2){cgr[i].x, cgr[i].y}) * unpack4((u32x2){vr[i].x, vr[i].y}); p[i][1] = unpack4((u32x2){cgr[i].z, cgr[i].w}) * unpack4((u32x2){vr[i].z, vr[i].w}); }
#pragma unroll
        for (int i = 0; i < 8; ++i) {
            const f32x4 o0 = unpack4((u32x2){bgr[i].x, bgr[i].y}) * (w[0][0] * p[i][0] + w[1][0] * p[i + 1][0] + w[2][0] * p[i + 2][0]);
            const f32x4 o1 = unpack4((u32x2){bgr[i].z, bgr[i].w}) * (w[0][1] * p[i][1] + w[1][1] * p[i + 1][1] + w[2][1] * p[i + 2][1]);
            const u32x2 q0 = pack4(o0), q1 = pack4(o1);
            *(u32x4*)(Y + (size_t)(row0 + i) * DM + DLRU + 8 * lane) = (u32x4){q0.x, q0.y, q1.x, q1.y}; }
    }
}

constexpr int ATT_TB = 64 * 144;
DI int att_nt(int u) { const int q64 = (u >> 2) & 127; const int lo = q64 - 2 < 0 ? 0 : q64 - 2, hi = q64 + 2 > 127 ? 127 : q64 + 2; return hi - lo + 1 + 4; }
DI void att_load(const bf16* KV, int u, int t, int srow, int sch, u32x4& kreg, u32x4& vreg) {
    const int hk = u & 3, q64 = (u >> 2) & 127, b = u >> 9;
    const int kt_lo = q64 - 2 < 0 ? 0 : q64 - 2, kt_hi = q64 + 2 > 127 ? 127 : q64 + 2, nwin = kt_hi - kt_lo + 1;
    const int rowk = (t < nwin) ? (b * SEQ + (kt_lo + t) * 64 + srow) : (ML + b * CTX + (t - nwin) * 64 + srow);
    const bf16* kp = KV + (size_t)rowk * 512 + hk * 64 + sch * 8; kreg = *(const u32x4*)kp; vreg = *(const u32x4*)(kp + 256);
}
DI void att_store(LAS unsigned char* base, int srow, int sch, const u32x4& kreg, const u32x4& vreg) {
    *(LAS u32x4*)(base + srow * 144 + sch * 16) = kreg;
    *(LAS u32x4*)(base + ATT_TB + srow * 144 + sch * 16) = vreg;
}
typedef short v4i16_t __attribute__((ext_vector_type(4)));
DI void att_tile(const LAS unsigned char* kb_, const bf16x8 (&qr)[4], float& m, float& l, f32x16 (&o)[2], f32x16& negm, bool edge, int kt, int qrow, int r32, int hi, int lane) {
    const LAS unsigned char* vb_ = kb_ + ATT_TB;
    f32x16 p[2];
#pragma unroll
    for (int sub = 0; sub < 2; ++sub)
#pragma unroll
        for (int d0 = 0; d0 < 4; ++d0) { const bf16x8 kf = *(const LAS bf16x8*)(kb_ + (32 * sub + r32) * 144 + (16 * d0 + 8 * hi) * 2);
            p[sub] = __builtin_amdgcn_mfma_f32_32x32x16_bf16(kf, qr[d0], d0 == 0 ? negm : p[sub], 0, 0, 0); }
    if (edge) {
#pragma unroll
        for (int sub = 0; sub < 2; ++sub)
#pragma unroll
            for (int r = 0; r < 16; ++r) { const int kpos = kt * 64 + 32 * sub + (r & 3) + 8 * (r >> 2) + 4 * hi; const int df = kpos - qrow;
                if (df > 128 || df < -128) p[sub][r] = -1e30f; }
    }
    float mx = p[0][0];
#pragma unroll
    for (int r = 1; r < 16; ++r) mx = fmaxf(mx, p[0][r]);
#pragma unroll
    for (int r = 0; r < 16; ++r) mx = fmaxf(mx, p[1][r]);
    mx = fmaxf(mx, __shfl_xor(mx, 32));
    if (__any(mx > 8.0f)) {
        const float dl = fmaxf(mx, 0.f), f = __builtin_amdgcn_exp2f(-dl); m += dl; l *= f;
#pragma unroll
        for (int i = 0; i < 16; ++i) { p[0][i] -= dl; p[1][i] -= dl; o[0][i] *= f; o[1][i] *= f; negm[i] = -m; }
    }
    float ls = 0.f;
#pragma unroll
    for (int sub = 0; sub < 2; ++sub)
#pragma unroll
        for (int r = 0; r < 16; ++r) { const float e = __builtin_amdgcn_exp2f(p[sub][r]); p[sub][r] = e; ls += e; }
    l += ls;
    bf16x8 pb[4];
#pragma unroll
    for (int ks = 0; ks < 4; ++ks) { const int sub = ks >> 1, r0 = 8 * (ks & 1);
        u32x4 w; w.x = pk2(p[sub][r0], p[sub][r0 + 1]); w.y = pk2(p[sub][r0 + 2], p[sub][r0 + 3]); w.z = pk2(p[sub][r0 + 4], p[sub][r0 + 5]); w.w = pk2(p[sub][r0 + 6], p[sub][r0 + 7]);
        pb[ks] = __builtin_bit_cast(bf16x8, w); }
    const LAS unsigned char* vtb = vb_ + (4 * hi + ((lane & 15) >> 2)) * 144 + (16 * ((lane >> 4) & 1) + 4 * (lane & 3)) * 2;
#pragma unroll
    for (int dt = 0; dt < 2; ++dt)
#pragma unroll
        for (int ks = 0; ks < 4; ++ks) { const LAS unsigned char* vp = vtb + (16 * ks) * 144 + (32 * dt) * 2;
            const v4i16_t lo = __builtin_amdgcn_ds_read_tr16_b64_v4i16((LAS v4i16_t*)vp), hi2 = __builtin_amdgcn_ds_read_tr16_b64_v4i16((LAS v4i16_t*)(vp + 8 * 144));
            const bf16x8 av = __builtin_shufflevector(lo, hi2, 0, 1, 2, 3, 4, 5, 6, 7);
            o[dt] = __builtin_amdgcn_mfma_f32_32x32x16_bf16(av, pb[ks], o[dt], 0, 0, 0); }
}
DI void attn_phase(const Args& a, LAS unsigned char* lds, int tid, int lane, int wave) {
    unsigned char* ws = a.ws;
    const bf16* Q = (const bf16*)(ws + WS_Q); const bf16* KV = (const bf16*)(ws + WS_KV);
    bf16* O = (bf16*)(ws + WS_O);
    const float* sink = a.in[22];
    const int r32 = lane & 31, hi = lane >> 5, srow = tid >> 3, sch = tid & 7;
    const int G = gridDim.x, NU = NB * 128 * 4;
    f32x16 zero16;
#pragma unroll
    for (int i = 0; i < 16; ++i) zero16[i] = 0.f;
    asm volatile("" : "+v"(zero16));
    const int u0 = blockIdx.x;
    if (u0 >= NU) return;
    for (int ubase = u0; ubase < NU; ubase += 4 * G) {
        const int c1 = att_nt(ubase);
        const int c2 = c1 + ((ubase + G < NU) ? att_nt(ubase + G) : 0);
        const int c3 = c2 + ((ubase + 2 * G < NU) ? att_nt(ubase + 2 * G) : 0);
        const int T = c3 + ((ubase + 3 * G < NU) ? att_nt(ubase + 3 * G) : 0);
#define ATT_DECODE(g, uu, tt) do { const int i_ = ((g) >= c1) + ((g) >= c2) + ((g) >= c3); uu = ubase + i_ * G; tt = (g) - (i_ == 0 ? 0 : (i_ == 1 ? c1 : (i_ == 2 ? c2 : c3))); } while (0)
        u32x4 k0, v0, k1, v1;
        { att_load(KV, ubase, 0, srow, sch, k0, v0); if (T > 1) { int uu, tt; ATT_DECODE(1, uu, tt); att_load(KV, uu, tt, srow, sch, k1, v1); } }
        int cu = ubase, ct = 0, cnt = c1;
        bf16x8 qr[4], qn[4];
        float m, l; f32x16 o[2], negm;
#define ATT_QLOAD(dst, uu) do { const int hk_ = (uu) & 3, q64_ = ((uu) >> 2) & 127, b_ = (uu) >> 9; const int head_ = hk_ * 4 + (wave >> 1), qrow_ = q64_ * 64 + (wave & 1) * 32 + r32; \
            _Pragma("unroll") for (int d0 = 0; d0 < 4; ++d0) dst[d0] = *(const bf16x8*)(Q + (size_t)(b_ * SEQ + qrow_) * DM + head_ * 64 + 16 * d0 + 8 * hi); } while (0)
#define ATT_INIT(uu) do { const int head_ = ((uu) & 3) * 4 + (wave >> 1); m = sink[head_] * LOG2E; l = (hi == 0) ? 1.f : 0.f; \
            _Pragma("unroll") for (int i = 0; i < 16; ++i) { o[0][i] = 0.f; o[1][i] = 0.f; negm[i] = -m; } } while (0)
        ATT_QLOAD(qr, cu); ATT_INIT(cu);
        att_store(lds, srow, sch, k0, v0);
        __syncthreads();
#define ATT_ITER(f, KL, VL, KS, VS, CB, SB) do { \
            if ((f) + 2 < T) { int uu_, tt_; ATT_DECODE((f) + 2, uu_, tt_); att_load(KV, uu_, tt_, srow, sch, KL, VL); } \
            const bool last_ = (ct == cnt - 1); const bool more_ = last_ && ((f) + 1 < T); \
            if (more_) ATT_QLOAD(qn, cu + G); \
            { const int q64_ = (cu >> 2) & 127; const int kt_lo_ = q64_ - 2 < 0 ? 0 : q64_ - 2; const int nwin_ = cnt - 4; const int kt_ = kt_lo_ + ct; \
              const bool edge_ = (ct < nwin_) && (kt_ == q64_ - 2 || kt_ == q64_ + 2); \
              att_tile(lds + (CB) * 2 * ATT_TB, qr, m, l, o, negm, edge_, kt_, q64_ * 64 + (wave & 1) * 32 + r32, r32, hi, lane); } \
            if ((f) + 1 < T) att_store(lds + (SB) * 2 * ATT_TB, srow, sch, KS, VS); \
            __syncthreads(); \
            if (last_) { const int hk_ = cu & 3, q64_ = (cu >> 2) & 127, b_ = cu >> 9; const int head_ = hk_ * 4 + (wave >> 1), qrow_ = q64_ * 64 + (wave & 1) * 32 + r32; \
                const float lt_ = l + __shfl_xor(l, 32), inv_ = 1.0f / lt_; bf16* op_ = O + (size_t)(b_ * SEQ + qrow_) * DM + head_ * 64; \
                _Pragma("unroll") for (int dt = 0; dt < 2; ++dt) _Pragma("unroll") for (int rp = 0; rp < 2; ++rp) {   \
                    const f32x4 va_ = {o[dt][8 * rp] * inv_, o[dt][8 * rp + 1] * inv_, o[dt][8 * rp + 2] * inv_, o[dt][8 * rp + 3] * inv_}, vb_ = {o[dt][8 * rp + 4] * inv_, o[dt][8 * rp + 5] * inv_, o[dt][8 * rp + 6] * inv_, o[dt][8 * rp + 7] * inv_}; \
                    const u32x2 p0_ = pack4(va_), p1_ = pack4(vb_); const u32x2 sd_ = hi ? p0_ : p1_; u32x2 rc_; rc_.x = (unsigned)__shfl_xor((int)sd_.x, 32); rc_.y = (unsigned)__shfl_xor((int)sd_.y, 32); \
                    const u32x4 w_ = hi ? (u32x4){rc_.x, rc_.y, p1_.x, p1_.y} : (u32x4){p0_.x, p0_.y, rc_.x, rc_.y}; *(u32x4*)(op_ + 32 * dt + 8 * (2 * rp + hi)) = w_; } \
                if (more_) { cu += G; ct = 0; cnt = att_nt(cu); _Pragma("unroll") for (int d0 = 0; d0 < 4; ++d0) qr[d0] = qn[d0]; ATT_INIT(cu); } } \
            else { ++ct; } } while (0)
        for (int f = 0; f < T; f += 2) {
            ATT_ITER(f, k0, v0, k1, v1, 0, 1);
            if (f + 1 < T) ATT_ITER(f + 1, k1, v1, k0, v0, 1, 0);
        }
#undef ATT_ITER
#undef ATT_QLOAD
#undef ATT_INIT
#undef ATT_DECODE
    }
}

#define XB_TMO      128
#define XB_XCNT(j)  (256  + 64 * (j))
#define XB_XSUB(j)  (1280 + 64 * (j))
#define XB_XGEN(j)  (2304 + 64 * (j))
#define XB_TOP      3328
#define XB_TOPGEN   3392
#define XCD_BAR_WORDS 3456
#define XB_SPIN_CAP (1u << 18)

__device__ __forceinline__ unsigned xb_ld(unsigned* p)              { return __hip_atomic_load(p, __ATOMIC_RELAXED, __HIP_MEMORY_SCOPE_AGENT); }
__device__ __forceinline__ unsigned xb_add(unsigned* p, unsigned v) { return __hip_atomic_fetch_add(p, v, __ATOMIC_RELAXED, __HIP_MEMORY_SCOPE_AGENT); }
__device__ __forceinline__ unsigned xb_xcc_id() { return (unsigned)__builtin_amdgcn_s_getreg((3 << 11) | 20) & 0xFu; }
#define XB_SPIN(cond, bar) do { unsigned _sp = 0; while (cond) { __builtin_amdgcn_s_sleep(1); \
    if ((++_sp & 255u) == 0u) { if (xb_ld(&(bar)[XB_TMO])) break; if (_sp > XB_SPIN_CAP) { atomicAdd(&(bar)[XB_TMO], 1u); break; } } } } while (0)

struct XcdBarrier {
    unsigned* bar; unsigned x;
    volatile LAS unsigned* st;
};

__device__ __forceinline__ XcdBarrier xcd_barrier_post(unsigned* bar, volatile LAS unsigned* st) {
    XcdBarrier b; b.bar = bar; b.x = xb_xcc_id(); b.st = st;
    if (threadIdx.x == 0) (void)xb_add(&bar[XB_XCNT(b.x)], 1u);
    return b;
}
__device__ __forceinline__ void xcd_barrier_complete(unsigned* bar, unsigned x, unsigned& nloc, unsigned& nx) {
    const unsigned G = gridDim.x * gridDim.y * gridDim.z;
    unsigned sum, cnt, mine, sp = 0u;
    for (;;) {
        sum = 0u; cnt = 0u; mine = 0u;
#pragma unroll
        for (unsigned j = 0; j < 16; ++j) { const unsigned c = xb_ld(&bar[XB_XCNT(j)]); sum += c; cnt += (c > 0u) ? 1u : 0u; mine = (j == x) ? c : mine; }
        if (sum == G) break;
        __builtin_amdgcn_s_sleep(1);
        if ((++sp & 255u) == 0u) { if (xb_ld(&bar[XB_TMO])) break; if (sp > XB_SPIN_CAP) { atomicAdd(&bar[XB_TMO], 1u); break; } }
    }
    nloc = mine > 0u ? mine : 1u; nx = cnt > 0u ? cnt : 1u;
}

__device__ __forceinline__ void xcd_barrier(const XcdBarrier& b) {
    asm volatile("s_waitcnt vmcnt(0)" ::: "memory");
    __syncthreads();
    if (threadIdx.x == 0) {
        unsigned* bar = b.bar;
        __builtin_amdgcn_s_waitcnt(0);
        unsigned nloc = b.st[0], nx = b.st[1];
        if (nloc == 0u) { xcd_barrier_complete(bar, b.x, nloc, nx); b.st[0] = nloc; b.st[1] = nx; }
        const unsigned old = xb_add(&bar[XB_XSUB(b.x)], 1u);
        const unsigned gen = old / nloc;
        if (old + 1u == (gen + 1u) * nloc) {
            __builtin_amdgcn_fence(__ATOMIC_RELEASE, "agent");
            asm volatile("s_waitcnt vmcnt(0)" ::: "memory");
            const unsigned og = xb_add(&bar[XB_TOP], 1u);
            const unsigned tg = og / nx;
            if (og + 1u == (tg + 1u) * nx) xb_add(&bar[XB_TOPGEN], 1u);
            else XB_SPIN(xb_ld(&bar[XB_TOPGEN]) == tg, bar);
            __builtin_amdgcn_fence(__ATOMIC_ACQUIRE, "agent");
            xb_add(&bar[XB_XGEN(b.x)], 1u);
            asm volatile("s_waitcnt vmcnt(0)" ::: "memory");
        } else {
            XB_SPIN(xb_ld(&bar[XB_XGEN(b.x)]) == gen, bar);
            __builtin_amdgcn_fence(__ATOMIC_ACQUIRE, "agent");
            asm volatile("s_waitcnt vmcnt(0)" ::: "memory");
        }
    }
    __syncthreads();
}

DI void static_unit(int L, int nM, int nN, pg8::Unit& u) {
    const int nwg = nM * nN; int wgid = L; { const int q = nwg / pg8::NXCD, r = nwg % pg8::NXCD, xcd = wgid % pg8::NXCD, off = wgid / pg8::NXCD; wgid = (xcd < r ? xcd * (q + 1) : r * (q + 1) + (xcd - r) * q) + off; }
    const int nig = pg8::WGM * nN, gid = wgid / nig, fm = gid * pg8::WGM, gsz = (nM - fm) < pg8::WGM ? (nM - fm) : pg8::WGM;
    u.pm = fm + ((wgid % nig) % gsz); u.pn = (wgid % nig) / gsz;
}
constexpr int FIN_NN = 2 * DFF / 256, FIN_CTX_UNITS = 2 * FIN_NN, FIN_LAT_UNITS = 64 * FIN_NN;
struct CtxFirstOrder {
    int G, c, lane; unsigned* cnt;
    DI bool next(int i, pg8::Unit& u) const {
        const int L = i * G + c; if (L >= FIN_CTX_UNITS + FIN_LAT_UNITS) return false;
        if (L < FIN_CTX_UNITS) { u.pm = 64 + L / FIN_NN; u.pn = L % FIN_NN; } else static_unit(L - FIN_CTX_UNITS, 64, FIN_NN, u);
        return true;
    }
    DI void a_ready(const pg8::Unit&) const {}
    DI void done(const pg8::Unit& u) const { if (u.pm >= 64) { asm volatile("s_waitcnt vmcnt(0)" ::: "memory"); if (lane == 0) __hip_atomic_fetch_add(cnt, 1u, __ATOMIC_RELAXED, __HIP_MEMORY_SCOPE_AGENT); } }
};
struct OneUnit {
    int pm, pn;
    DI bool next(int i, pg8::Unit& u) const { if (i) return false; u.pm = pm; u.pn = pn; return true; }
    DI void a_ready(const pg8::Unit&) const {}
    DI void done(const pg8::Unit&) const {}
};
struct EpiPartial {
    static constexpr bool PERM = false, AFTER_DRAIN = false;
    float* P;
    DI void operator()(const f32x4 (&acc)[2][2][4][2], const pg8::Unit& u, int wr, int wc, int fr, int fq) const {
        const __amdgpu_buffer_rsrc_t rs = __builtin_amdgcn_make_buffer_rsrc(P, 0, MC * DM * 4, 0x00020000);
        const int col0 = u.pn * 256 + wc * 32 + 4 * fq;
#pragma unroll
        for (int ai = 0; ai < 2; ++ai)
#pragma unroll
            for (int m = 0; m < 4; ++m) { const unsigned ob = (unsigned)(((u.pm * 256 + ai * 128 + wr * 64 + m * 16 + fr) * DM + col0) * 4);
#pragma unroll
                for (int bj = 0; bj < 2; ++bj)
#pragma unroll
                    for (int n = 0; n < 2; ++n) __builtin_amdgcn_raw_buffer_store_b128(__builtin_bit_cast(u32x4, acc[ai][bj][m][n]), rs, ob + (bj * 128 + n * 16) * 4, 0, 16); }
    }
};
template <bool BASEBF> DI void ctx_finish_row(const Args& a, int rc, int lane, const void* base, const float* gate, const float* gm, bf16* hbn) {
    unsigned char* ws = a.ws;
    const float* P = (const float*)(ws + WS_PART) + (size_t)rc * DM; bf16* X = (bf16*)(ws + WS_X) + (size_t)(ML + rc) * DM;
    bf16* hb = hbn + (size_t)(ML + rc) * DM; float* ssp = (float*)(ws + WS_SSP) + (size_t)(ML + rc) * 16;
    float ss = 0.f;
#pragma unroll
    for (int j = 0; j < 4; ++j) { const int c = 4 * (lane + 64 * j);
        const f32x4 p0 = *(const f32x4*)(P + c), p1 = *(const f32x4*)(P + (size_t)MC * DM + c), p2 = *(const f32x4*)(P + (size_t)2 * MC * DM + c), p3 = *(const f32x4*)(P + (size_t)3 * MC * DM + c);
        const f32x4 b4 = BASEBF ? unpack4(*(const u32x2*)((const bf16*)base + (size_t)rc * DM + c)) : *(const f32x4*)((const float*)base + (size_t)rc * DM + c);
        const f32x4 xn = b4 + *(const f32x4*)(gate + c) * (((p0 + p1) + p2) + p3);
        *(u32x2*)(X + c) = pack4(xn); ss += (xn[0] * xn[0] + xn[1] * xn[1]) + (xn[2] * xn[2] + xn[3] * xn[3]);
        *(u32x2*)(hb + c) = pack4(xn * *(const f32x4*)(gm + c)); }
    ss = wave_sum(ss);
    if (lane < 16) ssp[lane] = lane == 0 ? ss : 0.f;
}
struct OneUnitCounted {
    int pm, pn, lane; unsigned* cnt;
    DI bool next(int i, pg8::Unit& u) const { if (i) return false; u.pm = pm; u.pn = pn; return true; }
    DI void a_ready(const pg8::Unit&) const {}
    DI void done(const pg8::Unit&) const { asm volatile("s_waitcnt vmcnt(0)" ::: "memory"); if (lane == 0) __hip_atomic_fetch_add(cnt, 1u, __ATOMIC_RELAXED, __HIP_MEMORY_SCOPE_AGENT); }
};

struct EpiFinal {
    static constexpr bool PERM = false, AFTER_DRAIN = true;
    const bf16* X; const float* gate; const float* gfin; float* out; float* ssp; unsigned* cnt;
    DI void fused(f32x4 (&acc)[2][2][4][2], const pg8::Unit& u, int wr, int wc, int fr, int fq, LAS unsigned char* lds, int wid, int lane) const {
        const int bs = u.pm < 32 ? 0 : 1;
        const int col0 = u.pn * 256 + wc * 32 + 4 * fq;
        f32x4 gv[2][2];
#pragma unroll
        for (int bj = 0; bj < 2; ++bj)
#pragma unroll
            for (int n = 0; n < 2; ++n) gv[bj][n] = *(const f32x4*)(gate + bs * 6144 + col0 + bj * 128 + n * 16);
#pragma unroll
        for (int ai = 0; ai < 2; ++ai) {
            u32x2 praw[4][2][2];
#pragma unroll
            for (int m = 0; m < 4; ++m) { const int r = u.pm * 256 + ai * 128 + wr * 64 + m * 16 + fr; const bf16* bp = X + (size_t)r * DM + col0;
#pragma unroll
                for (int bj = 0; bj < 2; ++bj)
#pragma unroll
                    for (int n = 0; n < 2; ++n) praw[m][bj][n] = *(const u32x2*)(bp + bj * 128 + n * 16); }
#pragma unroll
            for (int m = 0; m < 4; ++m) { const int r = u.pm * 256 + ai * 128 + wr * 64 + m * 16 + fr;
                float ss = 0.f;
#pragma unroll
                for (int bj = 0; bj < 2; ++bj)
#pragma unroll
                    for (int n = 0; n < 2; ++n) { const f32x4 xn = unpack4(praw[m][bj][n]) + gv[bj][n] * acc[ai][bj][m][n]; acc[ai][bj][m][n] = xn;
                        ss += (xn[0] * xn[0] + xn[1] * xn[1]) + (xn[2] * xn[2] + xn[3] * xn[3]); }
                ss += __shfl_xor(ss, 16); ss += __shfl_xor(ss, 32); if (fq == 0) __hip_atomic_store(ssp + (size_t)r * 16 + u.pn * 4 + wc, ss, __ATOMIC_RELAXED, __HIP_MEMORY_SCOPE_AGENT); }
        }
        asm volatile("s_waitcnt vmcnt(0)" ::: "memory");
        if (lane == 0) __hip_atomic_fetch_add(cnt + 64 * u.pm, 1u, __ATOMIC_RELAXED, __HIP_MEMORY_SCOPE_AGENT);
        const int tid = wid * 64 + lane;
        if (tid == 0) { unsigned sp = 0; while (__hip_atomic_load(cnt + 64 * u.pm, __ATOMIC_RELAXED, __HIP_MEMORY_SCOPE_AGENT) < 32u) { __builtin_amdgcn_s_sleep(1); if (++sp > (1u << 22)) break; } }
        __syncthreads();
        LAS float* tab = (LAS float*)(lds + RS_TAB_OFF);
        { const int rr = tid >> 1, hf = tid & 1; const float* q = ssp + (size_t)(u.pm * 256 + rr) * 16 + hf * 8; float v_[8];
#pragma unroll
          for (int i = 0; i < 8; ++i) v_[i] = __hip_atomic_load(q + i, __ATOMIC_RELAXED, __HIP_MEMORY_SCOPE_AGENT);
          float s_ = ((v_[0] + v_[1]) + (v_[2] + v_[3])) + ((v_[4] + v_[5]) + (v_[6] + v_[7])); s_ += __shfl_xor(s_, 1);
          if (hf == 0) tab[rr] = 1.0f / sqrtf(s_ * (1.f / DM) + 1e-6f); }
        __syncthreads();
        f32x4 gf[2][2];
#pragma unroll
        for (int bj = 0; bj < 2; ++bj)
#pragma unroll
            for (int n = 0; n < 2; ++n) gf[bj][n] = *(const f32x4*)(gfin + col0 + bj * 128 + n * 16);
#pragma unroll
        for (int ai = 0; ai < 2; ++ai)
#pragma unroll
            for (int m = 0; m < 4; ++m) { const int rin = ai * 128 + wr * 64 + m * 16 + fr; const float rs = tab[rin]; float* op = out + (size_t)(u.pm * 256 + rin) * DM + col0;
#pragma unroll
                for (int bj = 0; bj < 2; ++bj)
#pragma unroll
                    for (int n = 0; n < 2; ++n) *(f32x4*)(op + bj * 128 + n * 16) = acc[ai][bj][m][n] * rs * gf[bj][n]; }
    }
};

constexpr int N_PHASES = 18;
__global__ void __launch_bounds__(NWAVES * 64, 2) fwd_kernel(Args a) {
    extern __shared__ __attribute__((aligned(16))) unsigned char lds_raw[];
    LAS unsigned char* lds = (LAS unsigned char*)lds_raw;
    cg::grid_group grid = cg::this_grid();
    const int tid = threadIdx.x, lane = tid & 63, wave = __builtin_amdgcn_readfirstlane(tid >> 6);
    unsigned char* ws = a.ws;
    const int lo = a.ph_lo, hi = a.ph_hi, G = gridDim.x, bx = blockIdx.x;
#ifndef PHASE_MASK
#define PHASE_MASK 0x3ffff
#endif
#define IN(k) (((PHASE_MASK >> (k)) & 1) && lo <= (k) && (k) < hi)
    {
        if (tid < 256) ((LAS unsigned*)(lds + 131072))[tid] = 0u;
        __syncthreads();
    }
    XcdBarrier bar = xcd_barrier_post((unsigned*)(ws + WS_CTL), (volatile LAS unsigned*)(lds + 131072 + 64));
    if (a.ph_lo < 0) grid.sync();
#define GSYNC() xcd_barrier(bar)
#ifndef TPROBE_MASK
#define TPROBE_MASK 0
#endif
#define TSTAMP(k) do { if (TPROBE_MASK != 0 && bx == 0 && tid == 0) ((LAS unsigned long long*)(lds + 131072 + 512))[(k)] = __builtin_amdgcn_s_memrealtime(); } while (0)
#define SEAM(k) do { if (IN(k) && (k) + 1 < hi) GSYNC(); TSTAMP((k) + 1); } while (0)
#ifndef RPT_MASK
#define RPT_MASK 0
#endif
#ifndef RPT_N
#define RPT_N 1
#endif
#ifndef EXTRA_SYNCS
#define EXTRA_SYNCS 0
#endif
#define PHASE(k, ...) do { if (IN(k)) { _Pragma("nounroll") for (int rp_ = 0; rp_ <= ((((RPT_MASK) >> (k)) & 1) ? (RPT_N) : 0); ++rp_) { if (rp_) GSYNC(); __VA_ARGS__; } } SEAM(k); } while (0)
    bf16* HB = (bf16*)(ws + WS_HB); bf16* X = (bf16*)(ws + WS_X);
    bf16* U = (bf16*)(ws + WS_R1); bf16* FH = (bf16*)(ws + WS_R1);
    const float* MOD = (const float*)(ws + WS_MOD); const float* GM = (const float*)(ws + WS_GM); const float* BV = (const float*)(ws + WS_BV); float* SSP = (float*)(ws + WS_SSP);
    const float* xin = a.in[0]; const float* ctxin = a.in[2];

    TSTAMP(0);
    PHASE(0, prologue(a, lds, tid, lane, wave); norm_mod_phase(xin, ctxin, MT, a.in[6], MOD, 0, 1, HB, wave, lane););
    PHASE(2, pg8::Gemm g{HB, (const bf16*)(ws + WS_WRCIN), MT, RCW, DM, 0}; pg8::StaticOrder S; S.init(MT, RCW, G, bx);
        EpiStore E{U, RCW}; pg8::gemm_phase<EpiStore, pg8::StaticOrder, true, true>(lds, g, S, E);
        {
            const int nfull2 = ((MT / 256) * (RCW / 256)) % G;
            const bool sub2 = !(nfull2 == 0 || G - nfull2 < 16); const int br2 = sub2 ? bx - nfull2 : bx, nb2 = sub2 ? G - nfull2 : G;
            if (br2 >= 0) {
                if (G == 256) { ada_items(a, lds, tid, wave, lane, 96, 192, br2, nb2, nullptr); aux_phase(a, tid, wave, lane, br2, nb2, 1);
                    copy_items(a, lds, wave, lane, COPY_GA + br2 * NWAVES + wave, COPY_GA + (br2 + nb2) * NWAVES + wave, nb2 * NWAVES, COPY_G1); }
                else { aux_phase(a, tid, wave, lane, br2, nb2, 3); aux_bias_f32(a, lds, tid, wave, lane, br2, nb2); }
            }
        });
    PHASE(3, rg1_phase(a, lds, tid, lane, wave););
    PHASE(4, rg_carry_phase(a, lds, wave, lane); sc_phase(a, wave, lane););
    PHASE(5, rg3_phase(a, wave, lane););
    PHASE(6, const bool split6 = (G == 256);
        if (split6) {
            { pg8::Gemm g{HB, (const bf16*)(ws + WS_WRCOUT), ML, DM, DM, 0}; pg8::StaticOrder S; S.init(ML, DM, G, bx);
              EpiResid<false> E{xin, ctxin, X, MOD + 2 * 1024, (bf16*)a.out, GM, SSP}; pg8::gemm_phase<EpiResid<false>, pg8::StaticOrder, true, true>(lds, g, S, E); }
            unsigned* cnt6 = (unsigned*)(ws + WS_CTL) + CTL_CTXCNT + 64;
            if (bx < 32) { const int sl = bx & 3, cu_ = bx >> 2;
                pg8::Gemm g2{HB + (size_t)ML * DM + sl * 256, (const bf16*)(ws + WS_WRCOUT) + sl * 256, MC, DM, 256, DM}; OneUnitCounted S2{cu_ >> 2, cu_ & 3, lane, cnt6};
                EpiPartial E2{(float*)(ws + WS_PART) + (size_t)sl * MC * DM}; pg8::gemm_phase<EpiPartial, OneUnitCounted, true, true>(lds, g2, S2, E2); }
            else if (bx < 96) { wait_count(cnt6, 8u * 32u, tid);
                ctx_finish_row<false>(a, (bx - 32) * NWAVES + wave, lane, ctxin, MOD + (size_t)2 * 6144 + 2 * 1024, GM + 2 * 1024, (bf16*)a.out); }
            else { const int w0 = (bx - 96) * NWAVES + wave, nw = (G - 96) * NWAVES; copy_items(a, lds, wave, lane, COPY_G1 + w0, COPY_G1 + w0 + nw, nw, COPY_G2); }
        } else { pg8::Gemm g{HB, (const bf16*)(ws + WS_WRCOUT), MT, DM, DM, 0}; pg8::StaticOrder S; S.init(MT, DM, G, bx);
            EpiResid<false> E{xin, ctxin, X, MOD + 2 * 1024, (bf16*)a.out, GM, SSP}; pg8::gemm_phase<EpiResid<false>, pg8::StaticOrder, true, true>(lds, g, S, E); });
    PHASE(8, pg8::Gemm g{(const bf16*)a.out, (const bf16*)(ws + WS_WFIN0), MT, 2 * DFF, DM, 0}; CtxFirstOrder S{G, bx, lane, (unsigned*)(ws + WS_CTL) + CTL_CTXCNT};
        rstd_table(lds, SSP, S, tid); EpiSwiGLU E{FH, DFF, lds, BV, true}; pg8::gemm_phase<EpiSwiGLU, CtxFirstOrder, true, true>(lds, g, S, E);
        {
            const int nfull = (FIN_CTX_UNITS + FIN_LAT_UNITS) % G, su = bx - nfull;
            if (nfull != 0 && G - nfull >= 32 && su >= 0 && su < 32) {
                wait_count((unsigned*)(ws + WS_CTL) + CTL_CTXCNT, 8u * FIN_CTX_UNITS, tid);
                const int sl = su & 3, cu_ = su >> 2, k0 = sl < 2 ? sl * 768 : 1536 + (sl - 2) * 640, klen = sl < 2 ? 768 : 640;
                pg8::Gemm g2{FH + (size_t)ML * DFF + k0, (const bf16*)(ws + WS_WFOUT0) + k0, MC, DM, klen, DFF}; OneUnit S2{cu_ >> 2, cu_ & 3};
                EpiPartial E2{(float*)(ws + WS_PART) + (size_t)sl * MC * DM}; pg8::gemm_phase<EpiPartial, OneUnit, true, true>(lds, g2, S2, E2);
            }
            else if (G == 256 && su >= 32) { aux_phase(a, tid, wave, lane, su - 32, G - nfull - 32, 2); aux_bias_f32(a, lds, tid, wave, lane, su - 32, G - nfull - 32); }
        });
    PHASE(9, const int nfull9 = (FIN_CTX_UNITS + FIN_LAT_UNITS) % G; const bool split9 = nfull9 != 0 && G - nfull9 >= 32;
        if (split9) { { const int rpb = (MC + G - 1) / G <= NWAVES ? (MC + G - 1) / G : NWAVES;
              const int rc = rpb * ((MC + G - 1) / G <= NWAVES ? bx : 0) + wave + ((MC + G - 1) / G <= NWAVES ? 0 : bx * NWAVES); if (wave < rpb && rc < MC) ctx_finish_row<true>(a, rc, lane, X + (size_t)ML * DM, MOD + (size_t)2 * 6144 + 5 * 1024, GM + 3072 + 2 * 1024, HB); }
            pg8::Gemm g{FH, (const bf16*)(ws + WS_WFOUT0), ML, DM, DFF, 0}; pg8::StaticOrder S; S.init(ML, DM, G, bx);
            EpiResid<true> E{X, X + (size_t)ML * DM, X, MOD + 5 * 1024, HB, GM + 3072, SSP}; pg8::gemm_phase<EpiResid<true>, pg8::StaticOrder, true, true>(lds, g, S, E); }
        else { pg8::Gemm g{FH, (const bf16*)(ws + WS_WFOUT0), MT, DM, DFF, 0}; pg8::StaticOrder S; S.init(MT, DM, G, bx);
            EpiResid<true> E{X, X + (size_t)ML * DM, X, MOD + 5 * 1024, HB, GM + 3072, SSP}; pg8::gemm_phase<EpiResid<true>, pg8::StaticOrder, true, true>(lds, g, S, E); });
    const float* MOD1 = MOD + 3 * 6144;
    PHASE(11, pg8::Gemm g{HB, (const bf16*)(ws + WS_WQKV), MT, NQKV, DM}; pg8::StaticOrder S; S.init(MT, NQKV, G, bx);
        EpiQKV E{(bf16*)(ws + WS_Q), (bf16*)(ws + WS_KV), (const float*)(ws + WS_ROPEC), (const float*)(ws + WS_ROPES), lds, BV + 3 * 2 * DFF}; rstd_table(lds, SSP, S, tid);
        pg8::gemm_phase<EpiQKV, pg8::StaticOrder, true, true>(lds, g, S, E);
        if (G == 256) {
            const int nfull11 = ((MT / 256) * (NQKV / 256)) % G, nidle = G - nfull11;
            if (bx >= nfull11) { const int w0 = (bx - nfull11) * NWAVES + wave; copy_items(a, lds, wave, lane, COPY_G2 + w0, COPY_G2 + w0 + nidle * NWAVES, nidle * NWAVES, COPY_G3); }
        });
    PHASE(12, attn_phase(a, lds, tid, lane, wave););
    PHASE(13, pg8::Gemm g{(const bf16*)(ws + WS_O), (const bf16*)(ws + WS_WAOUT), ML, DM, DM}; pg8::StaticOrder S; S.init(ML, DM, G, bx);
        EpiResid<true> E{X, X + (size_t)ML * DM, X, MOD1 + 2 * 1024, HB, GM + 2 * 3072, SSP}; pg8::gemm_phase<EpiResid<true>, pg8::StaticOrder, true, true>(lds, g, S, E););
    PHASE(15, pg8::Gemm g{HB, (const bf16*)(ws + WS_WFIN1), ML, 2 * DFF, DM}; pg8::StaticOrder S; S.init(ML, 2 * DFF, G, bx);
        rstd_table(lds, SSP, S, tid); EpiSwiGLU E{FH, DFF, lds, BV + 2 * 3 * 2 * DFF, WT_ALL != 0}; pg8::gemm_phase<EpiSwiGLU, pg8::StaticOrder, true, true>(lds, g, S, E);
        if (G == 256) { const int nfull15 = ((ML / 256) * (2 * DFF / 256)) % G, nidle = G - nfull15;
            if (bx >= nfull15) { const int w0 = (bx - nfull15) * NWAVES + wave; copy_items(a, lds, wave, lane, COPY_G3 + w0, COPY_G3 + w0 + nidle * NWAVES, nidle * NWAVES, COPY_NITEMS); } });
    const bool fuse16 = (G == 256);
    if (IN(16)) {
        if (fuse16) { pg8::Gemm g{FH, (const bf16*)(ws + WS_WFOUT1), ML, DM, DFF, 0}; pg8::StaticOrder S; S.init(ML, DM, G, bx);
            EpiFinal E{X, MOD1 + 5 * 1024, a.in[8], a.out, SSP, (unsigned*)(ws + WS_CTL) + CTL_CTXCNT + 128}; pg8::gemm_phase<EpiFinal, pg8::StaticOrder, false, true>(lds, g, S, E); }
        else { pg8::Gemm g{FH, (const bf16*)(ws + WS_WFOUT1), ML, DM, DFF, 0}; pg8::StaticOrder S; S.init(ML, DM, G, bx);
            EpiResid<true> E{X, X + (size_t)ML * DM, X, MOD1 + 5 * 1024, nullptr, nullptr, nullptr}; pg8::gemm_phase<EpiResid<true>, pg8::StaticOrder, true, true>(lds, g, S, E);
            GSYNC(); }
    }
    TSTAMP(17);
    if (IN(17) && !fuse16) { final_norm_phase(X, a.in[8], a.out, wave, lane); }
    TSTAMP(18);
    for (int es_ = 0; es_ < EXTRA_SYNCS; ++es_) GSYNC();
    if (TPROBE_MASK != 0 && bx == 0 && tid == 0) {
        const LAS unsigned long long* ts = (const LAS unsigned long long*)(lds + 131072 + 512); unsigned long long sum = 0;
        unsigned long long last = ts[0];
        for (int k = 0; k < N_PHASES; ++k) { const unsigned long long t = ts[k + 1]; if (t != 0ull) { if ((TPROBE_MASK >> k) & 1) sum += t - last; last = t; } }
        const unsigned long long t0 = __builtin_amdgcn_s_memrealtime();
        while (__builtin_amdgcn_s_memrealtime() - t0 < 7ull * sum) __builtin_amdgcn_s_sleep(8);
    }
#undef IN
#undef SEAM
}

#ifndef MK_MULTI
#define MK_MULTI 0
#endif
extern "C" void kernel_launch(void* const* d_in, const int* in_sizes, int n_in, void* d_out, int out_size, void* d_ws, size_t ws_size, hipStream_t stream) {
    static int grid = 0;
    if (grid == 0) {
        if (n_in != 24 || out_size != ML * DM || ws_size < WS_END) { fprintf(stderr, "kernel_launch: unexpected shapes n_in %d out %d ws %zu\n", n_in, out_size, ws_size); grid = -1; return; }
        int dev = 0, cus = 0, per_cu = 0;
        hipGetDevice(&dev); hipDeviceGetAttribute(&cus, hipDeviceAttributeMultiprocessorCount, dev);
        if (hipFuncSetAttribute((const void*)fwd_kernel, hipFuncAttributeMaxDynamicSharedMemorySize, LDS_BYTES) != hipSuccess) { fprintf(stderr, "kernel_launch: hipFuncSetAttribute failed\n"); grid = -1; return; }
        if (hipOccupancyMaxActiveBlocksPerMultiprocessor(&per_cu, (const void*)fwd_kernel, NWAVES * 64, LDS_BYTES) != hipSuccess || per_cu < 1) { fprintf(stderr, "kernel_launch: occupancy query says %d\n", per_cu); per_cu = 1; }
        (void)hipGetLastError();
        grid = cus * 1;
    }
    if (grid < 0) return;
    Args a{};
    for (int i = 0; i < 24; ++i) a.in[i] = (const float*)d_in[i];
    a.out = (float*)d_out; a.ws = (unsigned char*)d_ws;
#if MK_MULTI
    for (int p = 0; p < N_PHASES; ++p) { a.ph_lo = p; a.ph_hi = p + 1; hipLaunchKernelGGL(fwd_kernel, dim3(grid), dim3(NWAVES * 64), LDS_BYTES, stream, a); }
#else
    a.ph_lo = 0; a.ph_hi = N_PHASES;
    if (hipMemsetAsync((char*)d_ws + WS_CTL, 0, CTL_BYTES, stream) != hipSuccess) { fprintf(stderr, "kernel_launch: memset failed\n"); return; }
    void* args[] = {&a};
    hipError_t e = hipLaunchCooperativeKernel((const void*)fwd_kernel, dim3(grid), dim3(NWAVES * 64), args, LDS_BYTES, stream);
    if (e != hipSuccess) fprintf(stderr, "kernel_launch: cooperative launch failed: %s (grid %d)\n", hipGetErrorString(e), grid);
#endif
}
```

```cpp
#include <hip/hip_runtime.h>
#include <hip/hip_cooperative_groups.h>
#include <cstdio>
#include <cstdint>
namespace cg = cooperative_groups;
namespace pg8 {
#define PG8_LAS __attribute__((address_space(3)))
typedef unsigned short bf16_t;
typedef short bf16x8 __attribute__((ext_vector_type(8)));
typedef float f32x4 __attribute__((ext_vector_type(4)));
typedef unsigned u32x4 __attribute__((ext_vector_type(4)));
constexpr int BM = 256, BK = 64, HALF = 128, HTB = HALF * BK * 2  , STAGE_BYTES = 8 * HTB, NXCD = 8, WGM = 8;

__host__ __device__ __forceinline__ int lds_byte(int r, int c) { const int st = (r >> 4) * 2 + (c >> 5), rr = r & 15, cc = c & 31, ob = rr * 64 + cc * 2; return st * 1024 + (ob ^ (((ob >> 9) & 1) << 5)); }
__host__ __device__ __forceinline__ void stage_rc(int b, int& R, int& C) { const int st = b / 1024, sb = b % 1024, swz = sb ^ (((sb >> 9) & 1) << 5); R = (st >> 1) * 16 + swz / 64; C = (st & 1) * 32 + (swz % 64) / 2; }
__host__ __device__ __forceinline__ int perm32(int rho) { const int n = rho >> 4, i = rho & 15; return 8 * (i >> 2) + 4 * n + (i & 3); }

struct Unit { int pm, pn, ord; };
struct Gemm { const bf16_t* A; const bf16_t* Bt; int M, N, K, ld; };

struct StaticOrder {
    int nM, nN, nwg, G, c;
    __host__ __device__ void init(int M, int N, int G_, int c_) { nM = M / BM; nN = N / BM; nwg = nM * nN; G = G_; c = c_; }
    __host__ __device__ bool next(int i, Unit& u) const {
        const long L = (long)i * G + c; if (L >= nwg) return false;
        int wgid = (int)L; { const int q = nwg / NXCD, r = nwg % NXCD, xcd = wgid % NXCD, off = wgid / NXCD; wgid = (xcd < r ? xcd * (q + 1) : r * (q + 1) + (xcd - r) * q) + off; }
        const int nig = WGM * nN, gid = wgid / nig, fm = gid * WGM, gsz = (nM - fm) < WGM ? (nM - fm) : WGM;
        u.pm = fm + ((wgid % nig) % gsz); u.pn = (wgid % nig) / gsz; return true;
    }
    __device__ __forceinline__ void a_ready(const Unit&) const {}
    __device__ __forceinline__ void done(const Unit&) const {}
};
template <class Epi, class Sched, bool ALIGN_EPI = false, bool SP2 = false>
__device__ __forceinline__ void gemm_phase(PG8_LAS unsigned char* lds, const Gemm g, const Sched& S, const Epi& E) {
    const int tid = threadIdx.x, wid = __builtin_amdgcn_readfirstlane(tid >> 6), lane = tid & 63, wr = wid >> 2, wc = wid & 3, fr = lane & 15, fq = lane >> 4;
    const int nt = g.K / BK, K = g.ld ? g.ld : g.K;
    unsigned voffA[2], voffB[2];
#pragma unroll
    for (int i = 0; i < 2; ++i) { int R, C; stage_rc(tid * 16 + i * 8192, R, C); const int Rb = Epi::PERM ? ((R & ~31) + perm32(R & 31)) : R;
        voffA[i] = (unsigned)(R * K + C) * 2u; voffB[i] = (unsigned)(Rb * K + C) * 2u; }
    const size_t kstep = (size_t)(BK * 2);
    const size_t hstep = (size_t)HALF * K * 2;
    const size_t tstep = 2 * hstep;
    const unsigned ldsw = (unsigned)wid * 1024u;
    const int aoff = lds_byte(wr * 64 + fr, fq * 8), boff = lds_byte(wc * 32 + fr, fq * 8);
#define PG8_SA(b, h) (((b) * 2 + (h)) * HTB)
#define PG8_SB(b, h) ((4 + (b) * 2 + (h)) * HTB)
#define PG8_STAGE(bufoff, gbase, voff) do { _Pragma("unroll") for (int _i = 0; _i < 2; ++_i) \
        __builtin_amdgcn_global_load_lds((const unsigned*)((const char*)(gbase) + (voff)[_i]), (PG8_LAS unsigned*)(lds + (bufoff) + ldsw + _i * 8192), 16, 0, 0); } while (0)
#define PG8_LDA(dst, b, h) do { _Pragma("unroll") for (int m = 0; m < 4; ++m) _Pragma("unroll") for (int k = 0; k < 2; ++k) dst[m][k] = *(const PG8_LAS bf16x8*)(lds + PG8_SA(b, h) + aoff + m * 2048 + k * 1024); } while (0)
#define PG8_LDB(dst, b, h) do { _Pragma("unroll") for (int n = 0; n < 2; ++n) _Pragma("unroll") for (int k = 0; k < 2; ++k) dst[n][k] = *(const PG8_LAS bf16x8*)(lds + PG8_SB(b, h) + boff + n * 2048 + k * 1024); } while (0)
#define PG8_MMA(ai, bj, At, Bt) do { __builtin_amdgcn_s_setprio(1); _Pragma("unroll") for (int m = 0; m < 4; ++m) _Pragma("unroll") for (int n = 0; n < 2; ++n) _Pragma("unroll") for (int k = 0; k < 2; ++k) \
        acc[ai][bj][m][n] = __builtin_amdgcn_mfma_f32_16x16x32_bf16(Bt[n][k], At[m][k], acc[ai][bj][m][n], 0, 0, 0); __builtin_amdgcn_s_setprio(0); } while (0)
#define PG8_WAIT_V(n) asm volatile("s_waitcnt vmcnt(" #n ")" ::: "memory")
#define PG8_WAIT_L(n) asm volatile("s_waitcnt lgkmcnt(" #n ")" ::: "memory")
#define PG8_BAR __builtin_amdgcn_s_barrier()
#define PG8_SCHED __builtin_amdgcn_sched_barrier(0)
    Unit cur, nxt; int ui = 0;
    if (!S.next(0, cur)) return; cur.ord = 0;
    f32x4 acc[2][2][4][2];
#pragma unroll
    for (int a = 0; a < 2; ++a)
#pragma unroll
        for (int b = 0; b < 2; ++b)
#pragma unroll
            for (int m = 0; m < 4; ++m)
#pragma unroll
                for (int n = 0; n < 2; ++n) acc[a][b][m][n] = (f32x4){0.f, 0.f, 0.f, 0.f};
    bf16x8 At[4][2], B0[2][2], B1[2][2];
    const char* cA = (const char*)g.A + (size_t)cur.pm * tstep; const char* cB = (const char*)g.Bt + (size_t)cur.pn * tstep;
    S.a_ready(cur);
    if constexpr (SP2) {
        PG8_STAGE(PG8_SB(0, 0), cB, voffB); PG8_STAGE(PG8_SB(0, 1), cB + hstep, voffB); PG8_STAGE(PG8_SA(0, 0), cA, voffA); PG8_STAGE(PG8_SA(0, 1), cA + hstep, voffA);
        if (wr == 1) PG8_BAR;
        PG8_WAIT_V(2); PG8_BAR;
        PG8_STAGE(PG8_SB(1, 0), cB + kstep, voffB); PG8_STAGE(PG8_SA(1, 0), cA + kstep, voffA); PG8_STAGE(PG8_SB(1, 1), cB + hstep + kstep, voffB);
        PG8_WAIT_V(6); PG8_BAR;
    } else {
        PG8_STAGE(PG8_SB(0, 0), cB, voffB); PG8_STAGE(PG8_SA(0, 0), cA, voffA); PG8_STAGE(PG8_SB(0, 1), cB + hstep, voffB); PG8_STAGE(PG8_SA(0, 1), cA + hstep, voffA);
        if (wr == 1) PG8_BAR;
        PG8_WAIT_V(4); PG8_BAR;
        PG8_STAGE(PG8_SB(1, 0), cB + kstep, voffB); PG8_STAGE(PG8_SA(1, 0), cA + kstep, voffA); PG8_STAGE(PG8_SB(1, 1), cB + hstep + kstep, voffB);
        PG8_WAIT_V(6); PG8_BAR;
    }
    for (;;) {
        const bool has_next = S.next(ui + 1, nxt); nxt.ord = ui + 1;
        const char* nA = has_next ? (const char*)g.A + (size_t)nxt.pm * tstep : cA; const char* nB = has_next ? (const char*)g.Bt + (size_t)nxt.pn * tstep : cB;
        for (int t = 0; t < nt; t += 2) {
            const bool last = (t == nt - 2);
            const char* a1 = cA + (size_t)(t + 1) * kstep;
            const char* a2 = last ? nA : cA + (size_t)(t + 2) * kstep; const char* b2 = last ? nB : cB + (size_t)(t + 2) * kstep;
            const char* a3 = a2 + kstep; const char* b3 = b2 + kstep;
            if (last && has_next) S.a_ready(nxt);
            if constexpr (SP2) {
            PG8_LDB(B0, 0, 0); PG8_LDB(B1, 0, 1); PG8_SCHED; PG8_LDA(At, 0, 0); PG8_STAGE(PG8_SA(1, 1), a1 + hstep, voffA);
            PG8_WAIT_V(8); PG8_WAIT_L(0); PG8_BAR; PG8_MMA(0, 0, At, B0); PG8_MMA(0, 1, At, B1); PG8_BAR; PG8_SCHED;
            PG8_LDA(At, 0, 1); PG8_STAGE(PG8_SB(0, 0), b2, voffB); PG8_STAGE(PG8_SB(0, 1), b2 + hstep, voffB); PG8_STAGE(PG8_SA(0, 0), a2, voffA);
            PG8_WAIT_V(8); PG8_WAIT_L(0); PG8_BAR; PG8_MMA(1, 0, At, B0); PG8_MMA(1, 1, At, B1); PG8_BAR; PG8_SCHED;
            PG8_LDB(B0, 1, 0); PG8_LDB(B1, 1, 1); PG8_SCHED; PG8_LDA(At, 1, 0); PG8_STAGE(PG8_SA(0, 1), a2 + hstep, voffA);
            PG8_WAIT_V(8); PG8_WAIT_L(0); PG8_BAR; PG8_MMA(0, 0, At, B0); PG8_MMA(0, 1, At, B1); PG8_BAR; PG8_SCHED;
            PG8_LDA(At, 1, 1); PG8_STAGE(PG8_SB(1, 0), b3, voffB); PG8_STAGE(PG8_SB(1, 1), b3 + hstep, voffB); PG8_STAGE(PG8_SA(1, 0), a3, voffA);
            PG8_WAIT_V(8); PG8_WAIT_L(0); PG8_BAR; PG8_MMA(1, 0, At, B0); PG8_MMA(1, 1, At, B1); PG8_BAR; PG8_SCHED;
            } else {
            PG8_LDB(B0, 0, 0); PG8_SCHED; PG8_LDA(At, 0, 0); PG8_STAGE(PG8_SA(1, 1), a1 + hstep, voffA);
            PG8_WAIT_L(8); PG8_BAR; PG8_WAIT_L(0); PG8_MMA(0, 0, At, B0); PG8_BAR; PG8_SCHED;
            PG8_LDB(B1, 0, 1); PG8_STAGE(PG8_SB(0, 0), b2, voffB);
            PG8_BAR; PG8_WAIT_L(0); PG8_MMA(0, 1, At, B1); PG8_BAR;
            PG8_LDA(At, 0, 1); PG8_STAGE(PG8_SA(0, 0), a2, voffA);
            PG8_BAR; PG8_WAIT_L(0); PG8_MMA(1, 0, At, B0); PG8_BAR; PG8_SCHED;
            PG8_STAGE(PG8_SB(0, 1), b2 + hstep, voffB);
            PG8_WAIT_V(6); PG8_BAR; PG8_MMA(1, 1, At, B1); PG8_BAR;
            PG8_LDB(B0, 1, 0); PG8_SCHED; PG8_LDA(At, 1, 0); PG8_STAGE(PG8_SA(0, 1), a2 + hstep, voffA);
            PG8_WAIT_L(8); PG8_BAR; PG8_WAIT_L(0); PG8_MMA(0, 0, At, B0); PG8_BAR; PG8_SCHED;
            PG8_LDB(B1, 1, 1); PG8_STAGE(PG8_SB(1, 0), b3, voffB);
            PG8_BAR; PG8_WAIT_L(0); PG8_MMA(0, 1, At, B1); PG8_BAR;
            PG8_LDA(At, 1, 1); PG8_STAGE(PG8_SA(1, 0), a3, voffA);
            PG8_BAR; PG8_WAIT_L(0); PG8_MMA(1, 0, At, B0); PG8_BAR; PG8_SCHED;
            PG8_STAGE(PG8_SB(1, 1), b3 + hstep, voffB);
            PG8_WAIT_V(6); PG8_BAR; PG8_MMA(1, 1, At, B1); PG8_BAR;
            }
        }
        if constexpr (ALIGN_EPI) { if (wr == 0) PG8_BAR; }
        if constexpr (!Epi::AFTER_DRAIN) { E(acc, cur, wr, wc, fr, fq); S.done(cur); }
        if (!has_next) break;
#pragma unroll
        for (int a = 0; a < 2; ++a)
#pragma unroll
            for (int b = 0; b < 2; ++b)
#pragma unroll
                for (int m = 0; m < 4; ++m)
#pragma unroll
                    for (int n = 0; n < 2; ++n) acc[a][b][m][n] = (f32x4){0.f, 0.f, 0.f, 0.f};
        cur = nxt; cA = nA; cB = nB; ++ui;
        if constexpr (ALIGN_EPI) { if (wr == 1) PG8_BAR; }
    }
    PG8_WAIT_V(0);
    if constexpr (!ALIGN_EPI) { if (wr == 0) PG8_BAR; }
    PG8_BAR;
    if constexpr (Epi::AFTER_DRAIN) { E.fused(acc, cur, wr, wc, fr, fq, lds, wid, lane); S.done(cur); }
#undef PG8_SA
#undef PG8_SB
#undef PG8_STAGE
#undef PG8_LDA
#undef PG8_LDB
#undef PG8_MMA
#undef PG8_WAIT_V
#undef PG8_WAIT_L
#undef PG8_BAR
#undef PG8_SCHED
}
}

#ifndef WT_ALL
#define WT_ALL 0
#endif
#define DI __device__ __forceinline__
#define LAS __attribute__((address_space(3)))
typedef unsigned short bf16;
typedef pg8::f32x4 f32x4;
typedef pg8::bf16x8 bf16x8;
typedef pg8::u32x4 u32x4;
typedef unsigned u32x2 __attribute__((ext_vector_type(2)));
typedef float f32x16 __attribute__((ext_vector_type(16)));
typedef float f32x2_t __attribute__((ext_vector_type(2)));
typedef __bf16 bf16x2_t __attribute__((ext_vector_type(2)));

constexpr int DM = 1024, NB = 2, SEQ = 8192, CTX = 256;
constexpr int ML = NB * SEQ, MC = NB * CTX, MT = ML + MC;
constexpr int DFF = 2816, RCW = 2560, NQKV = 1536, DLRU = 512;
constexpr int NCH = 264;
constexpr int NWAVES = 8;
constexpr float LOG2E = 1.4426950408889634f;
constexpr float QSCALE = 0.125f * LOG2E;

constexpr size_t MiB = 1u << 20;
constexpr size_t WS_WRCIN = 0, WS_WRCOUT = 5 * MiB, WS_WFIN0 = 7 * MiB, WS_WFIN1 = 18 * MiB, WS_WFOUT0 = 29 * MiB, WS_WFOUT1 = 29 * MiB + 5632 * 1024,
                 WS_WQKV = 40 * MiB, WS_WAOUT = 43 * MiB;
constexpr size_t WS_SMALL = 45 * MiB;
constexpr size_t WS_GW = WS_SMALL, WS_MOD = WS_SMALL + 256 * 1024, WS_ROPEC = WS_SMALL + 512 * 1024, WS_ROPES = WS_ROPEC + 8192, WS_SP8 = WS_ROPES + 8192,
                 WS_SUMA = WS_SMALL + 1 * MiB, WS_SUMB = WS_SMALL + 3 * MiB + 256 * 1024, WS_HIN = WS_SMALL + 5 * MiB + 512 * 1024;
constexpr size_t WS_HB = 53 * MiB;
constexpr size_t WS_X = 86 * MiB;
constexpr size_t WS_R1 = 152 * MiB;
constexpr size_t WS_Q = WS_R1, WS_KV = WS_R1 + 33 * MiB, WS_O = WS_KV + 17 * MiB;
constexpr size_t WS_SSP = 244 * MiB;
constexpr size_t WS_BV = 246 * MiB, WS_GM = 247 * MiB;
constexpr size_t WS_BTAIL = 235 * MiB;
constexpr size_t WS_CTL = 243 * MiB, CTL_BYTES = 65536;
constexpr size_t WS_PART = 248 * MiB;
constexpr size_t WS_END = 256 * MiB;
constexpr int CTL_CTXCNT = 4096;
static_assert(WS_O + (size_t)ML * DM * 2 <= WS_CTL && WS_R1 + (size_t)MT * DFF * 2 <= WS_CTL, "ws map");
static_assert(WS_SUMB - WS_SUMA >= (size_t)NB * NCH * 2 * DLRU * 4 && WS_HIN + (size_t)NB * NCH * 2 * DLRU * 4 <= WS_HB, "ws small map");

constexpr int LDS_BYTES = 147456;

struct Args { const float* in[24]; float* out; unsigned char* ws; int ph_lo, ph_hi; };

DI unsigned pk2(float lo, float hi) { f32x2_t v = {lo, hi}; bf16x2_t b = __builtin_convertvector(v, bf16x2_t); return __builtin_bit_cast(unsigned, b); }
DI float bflo(unsigned u) { return __uint_as_float(u << 16); }
DI float bfhi(unsigned u) { return __uint_as_float(u & 0xffff0000u); }
DI f32x4 unpack4(u32x2 u) { return (f32x4){bflo(u.x), bfhi(u.x), bflo(u.y), bfhi(u.y)}; }
DI u32x2 pack4(f32x4 v) { u32x2 r; r.x = pk2(v[0], v[1]); r.y = pk2(v[2], v[3]); return r; }
DI float wave_sum(float v) {
#pragma unroll
    for (int o = 1; o < 64; o <<= 1) v += __shfl_xor(v, o);
    return v;
}
DI float fast_exp(float x) { return __builtin_amdgcn_exp2f(x * LOG2E); }
DI float sigmoidf_(float x) { return __builtin_amdgcn_rcpf(1.f + fast_exp(-x)); }
DI float siluf_(float x) { return x * sigmoidf_(x); }
DI float gelu_tanh(float x) { const float u = 0.7978845608028654f * (x + 0.044715f * x * x * x); return x * __builtin_amdgcn_rcpf(1.f + fast_exp(-2.f * u)); }
DI int bsel(int row) { return row < SEQ ? 0 : (row < ML ? 1 : 2); }
DI void wait_count(unsigned* cnt, unsigned want, int tid) {
    if (tid == 0) { unsigned sp = 0;
        while (__hip_atomic_load(cnt, __ATOMIC_RELAXED, __HIP_MEMORY_SCOPE_AGENT) < want) { __builtin_amdgcn_s_sleep(2); if (++sp > (1u << 22)) break; }
        __builtin_amdgcn_fence(__ATOMIC_ACQUIRE, "agent"); asm volatile("s_waitcnt vmcnt(0)" ::: "memory"); }
    __syncthreads();
}

struct EpiStore {
    static constexpr bool PERM = true, AFTER_DRAIN = false;
    bf16* O; int ldc;
    DI void operator()(const f32x4 (&acc)[2][2][4][2], const pg8::Unit& u, int wr, int wc, int fr, int fq) const {
        const int row0 = u.pm * 256 + wr * 64 + fr, col0 = u.pn * 256 + wc * 32 + 8 * fq;
#pragma unroll
        for (int ai = 0; ai < 2; ++ai)
#pragma unroll
            for (int m = 0; m < 4; ++m) { bf16* rowp = O + (size_t)(row0 + ai * 128 + m * 16) * ldc + col0;
#pragma unroll
                for (int bj = 0; bj < 2; ++bj) { const f32x4 v0 = acc[ai][bj][m][0], v1 = acc[ai][bj][m][1];
                    u32x4 w; w.x = pk2(v0[0], v0[1]); w.y = pk2(v0[2], v0[3]); w.z = pk2(v1[0], v1[1]); w.w = pk2(v1[2], v1[3]);
                    *(u32x4*)(rowp + bj * 128) = w; } }
    }
};
constexpr int RS_TAB_OFF = 132096, RS_TAB_UNITS = 12;
template <class Sched> DI void rstd_table(LAS unsigned char* lds, const float* ssp, const Sched& S, int tid) {
    LAS float* tab = (LAS float*)(lds + RS_TAB_OFF);
    pg8::Unit u;
    for (int i = 0; i < RS_TAB_UNITS && S.next(i, u); ++i) {
        const int rr = tid >> 1, hf = tid & 1; const f32x4* q = (const f32x4*)(ssp + (size_t)(u.pm * 256 + rr) * 16 + hf * 8); const f32x4 a = q[0], b = q[1];
        float s = ((a[0] + a[1]) + (a[2] + a[3])) + ((b[0] + b[1]) + (b[2] + b[3]));
        s += __shfl_xor(s, 1);
        if (hf == 0) tab[i * 256 + rr] = 1.0f / sqrtf(s * (1.f / DM) + 1e-6f);
    }
    __syncthreads();
}
DI float row_rstd(LAS unsigned char* lds, int ord, int rin) { return ((const LAS float*)(lds + RS_TAB_OFF))[ord * 256 + rin]; }
struct EpiSwiGLU {
    static constexpr bool PERM = true, AFTER_DRAIN = false;
    bf16* O; int ldc; LAS unsigned char* lds; const float* bias; bool wt;
    DI void operator()(const f32x4 (&acc)[2][2][4][2], const pg8::Unit& u, int wr, int wc, int fr, int fq) const {
        const int row0 = u.pm * 256 + wr * 64 + fr, col0 = u.pn * 128 + wc * 32 + 8 * fq;
        const int bs = u.pm < 32 ? 0 : (u.pm < 64 ? 1 : 2);
        const float* bp = bias + bs * (2 * DFF) + u.pn * 256 + wc * 32 + 8 * fq;
        f32x4 bv[2][2];
#pragma unroll
        for (int bj = 0; bj < 2; ++bj)
#pragma unroll
            for (int n = 0; n < 2; ++n) bv[bj][n] = *(const f32x4*)(bp + bj * 128 + 4 * n);
#pragma unroll
        for (int ai = 0; ai < 2; ++ai)
#pragma unroll
            for (int m = 0; m < 4; ++m) { const int r = row0 + ai * 128 + m * 16; bf16* rowp = O + (size_t)r * ldc + col0;
                const float rs = row_rstd(lds, u.ord, wr * 64 + fr + ai * 128 + m * 16);
                float v[8];
#pragma unroll
                for (int n = 0; n < 2; ++n)
#pragma unroll
                    for (int j = 0; j < 4; ++j) v[n * 4 + j] = siluf_(__builtin_fmaf(acc[ai][0][m][n][j], rs, bv[0][n][j])) * __builtin_fmaf(acc[ai][1][m][n][j], rs, bv[1][n][j]);
                u32x4 w; w.x = pk2(v[0], v[1]); w.y = pk2(v[2], v[3]); w.z = pk2(v[4], v[5]); w.w = pk2(v[6], v[7]);
                if (wt && (WT_ALL || u.pm >= 64)) { const __amdgpu_buffer_rsrc_t rsr = __builtin_amdgcn_make_buffer_rsrc(O, 0, MT * DFF * 2, 0x00020000);
                    __builtin_amdgcn_raw_buffer_store_b128(w, rsr, (unsigned)(((size_t)r * ldc + col0) * 2), 0, 16); }
                else *(u32x4*)rowp = w; }
    }
};
template <bool BASEBF> struct EpiResid {
    static constexpr bool PERM = true, AFTER_DRAIN = false;
    const void* baseL; const void* baseC;
    bf16* X; const float* gate;
    bf16* HBn; const float* gm; float* ssp;
    DI void operator()(const f32x4 (&acc)[2][2][4][2], const pg8::Unit& u, int wr, int wc, int fr, int fq) const {
        const int bs = u.pm < 32 ? 0 : (u.pm < 64 ? 1 : 2);
        const int col0 = u.pn * 256 + wc * 32 + 8 * fq;
        const float* gp = gate + bs * 6144 + col0;
        f32x4 gv[2][2], gmv[2][2];
#pragma unroll
        for (int bj = 0; bj < 2; ++bj)
#pragma unroll
            for (int n = 0; n < 2; ++n) { gv[bj][n] = *(const f32x4*)(gp + bj * 128 + 4 * n); if (HBn) gmv[bj][n] = *(const f32x4*)(gm + bs * 1024 + col0 + bj * 128 + 4 * n); }
        if constexpr (BASEBF) {
#pragma unroll
            for (int ai = 0; ai < 2; ++ai) {
                u32x4 praw[4][2];
#pragma unroll
                for (int m = 0; m < 4; ++m) { const int r = u.pm * 256 + ai * 128 + wr * 64 + m * 16 + fr;
                    const bf16* bp = (const bf16*)(r < ML ? baseL : baseC) + (r < ML ? (size_t)r * DM : (size_t)(r - ML) * DM) + col0;
#pragma unroll
                    for (int bj = 0; bj < 2; ++bj) praw[m][bj] = *(const u32x4*)(bp + bj * 128); }
#pragma unroll
                for (int m = 0; m < 4; ++m) { const int r = u.pm * 256 + ai * 128 + wr * 64 + m * 16 + fr;
                    float ss = 0.f;
#pragma unroll
                    for (int bj = 0; bj < 2; ++bj) {
                        const f32x4 x0 = unpack4((u32x2){praw[m][bj].x, praw[m][bj].y}) + gv[bj][0] * acc[ai][bj][m][0], x1 = unpack4((u32x2){praw[m][bj].z, praw[m][bj].w}) + gv[bj][1] * acc[ai][bj][m][1];
                        const u32x2 a_ = pack4(x0), b_ = pack4(x1);
                        *(u32x4*)(X + (size_t)r * DM + col0 + bj * 128) = (u32x4){a_.x, a_.y, b_.x, b_.y};
                        if (HBn) { ss += ((x0[0] * x0[0] + x0[1] * x0[1]) + (x0[2] * x0[2] + x0[3] * x0[3])) + ((x1[0] * x1[0] + x1[1] * x1[1]) + (x1[2] * x1[2] + x1[3] * x1[3]));
                            const u32x2 c_ = pack4(x0 * gmv[bj][0]), d_ = pack4(x1 * gmv[bj][1]);
                            *(u32x4*)(HBn + (size_t)r * DM + col0 + bj * 128) = (u32x4){c_.x, c_.y, d_.x, d_.y}; } }
                    if (HBn) { ss += __shfl_xor(ss, 16); ss += __shfl_xor(ss, 32); if (fq == 0) ssp[(size_t)r * 16 + u.pn * 4 + wc] = ss; } }
                asm volatile("" ::: "memory");
            }
        } else {
#pragma unroll
            for (int h2 = 0; h2 < 4; ++h2) { const int ai = h2 >> 1, m0 = (h2 & 1) * 2;
                f32x4 pre[2][2][2];
#pragma unroll
                for (int mm = 0; mm < 2; ++mm) { const int r = u.pm * 256 + ai * 128 + wr * 64 + (m0 + mm) * 16 + fr;
                    const float* bp = (const float*)(r < ML ? baseL : baseC) + (r < ML ? (size_t)r * DM : (size_t)(r - ML) * DM) + col0;
#pragma unroll
                    for (int bj = 0; bj < 2; ++bj)
#pragma unroll
                        for (int n = 0; n < 2; ++n) pre[mm][bj][n] = *(const f32x4*)(bp + bj * 128 + 4 * n); }
#pragma unroll
                for (int mm = 0; mm < 2; ++mm) { const int m = m0 + mm; const int r = u.pm * 256 + ai * 128 + wr * 64 + m * 16 + fr;
                    float ss = 0.f;
#pragma unroll
                    for (int bj = 0; bj < 2; ++bj) {
                        const f32x4 x0 = pre[mm][bj][0] + gv[bj][0] * acc[ai][bj][m][0], x1 = pre[mm][bj][1] + gv[bj][1] * acc[ai][bj][m][1];
                        const u32x2 a_ = pack4(x0), b_ = pack4(x1);
                        *(u32x4*)(X + (size_t)r * DM + col0 + bj * 128) = (u32x4){a_.x, a_.y, b_.x, b_.y};
                        if (HBn) { ss += ((x0[0] * x0[0] + x0[1] * x0[1]) + (x0[2] * x0[2] + x0[3] * x0[3])) + ((x1[0] * x1[0] + x1[1] * x1[1]) + (x1[2] * x1[2] + x1[3] * x1[3]));
                            const u32x2 c_ = pack4(x0 * gmv[bj][0]), d_ = pack4(x1 * gmv[bj][1]);
                            *(u32x4*)(HBn + (size_t)r * DM + col0 + bj * 128) = (u32x4){c_.x, c_.y, d_.x, d_.y}; } }
                    if (HBn) { ss += __shfl_xor(ss, 16); ss += __shfl_xor(ss, 32); if (fq == 0) ssp[(size_t)r * 16 + u.pn * 4 + wc] = ss; } }
                asm volatile("" ::: "memory");
            }
        }
    }
};
struct EpiQKV {
    static constexpr bool PERM = false, AFTER_DRAIN = false;
    bf16 *Q, *KV; const float *ropec, *ropes; LAS unsigned char* lds; const float* bias;
    DI void operator()(const f32x4 (&acc)[2][2][4][2], const pg8::Unit& u, int wr, int wc, int fr, int fq) const {
        const bool rope_on = (u.pm < 64) && (u.pn < 5);
        const float scale = u.pn < 4 ? QSCALE : 1.0f;
        bf16* dst = u.pn < 4 ? Q + u.pn * 256 : KV + (u.pn - 4) * 256; const int ld = u.pn < 4 ? DM : 512;
        const int ax = wc & 1, cc = wc * 32 + 4 * fq;
        const int bs = u.pm < 32 ? 0 : (u.pm < 64 ? 1 : 2);
        const float* bp = bias + bs * NQKV + u.pn * 256 + cc;
        f32x4 bv[2][2];
#pragma unroll
        for (int bj = 0; bj < 2; ++bj)
#pragma unroll
            for (int n = 0; n < 2; ++n) bv[bj][n] = *(const f32x4*)(bp + bj * 128 + n * 16);
#pragma unroll
        for (int ai = 0; ai < 2; ++ai)
#pragma unroll
            for (int m = 0; m < 4; ++m) { const int r = u.pm * 256 + ai * 128 + wr * 64 + m * 16 + fr;
                const float rs = row_rstd(lds, u.ord, ai * 128 + wr * 64 + m * 16 + fr);
                const int s = r & (SEQ - 1); const int pos = ax ? (s & 63) : (s >> 6);
                f32x4 c4 = (f32x4){1.f, 1.f, 1.f, 1.f}, s4 = (f32x4){0.f, 0.f, 0.f, 0.f};
                if (rope_on) { c4 = *(const f32x4*)(ropec + pos * 16 + 4 * fq); s4 = *(const f32x4*)(ropes + pos * 16 + 4 * fq); }
                bf16* p = dst + (size_t)r * ld + cc;
#pragma unroll
                for (int bj = 0; bj < 2; ++bj) { const f32x4 x1 = acc[ai][bj][m][0] * rs + bv[bj][0], x2 = acc[ai][bj][m][1] * rs + bv[bj][1];
                    const f32x4 o1 = (x1 * c4 - x2 * s4) * scale, o2 = (x2 * c4 + x1 * s4) * scale;
                    *(u32x2*)(p + bj * 128) = pack4(o1); *(u32x2*)(p + bj * 128 + 16) = pack4(o2); } }
    }
};

DI void item_desc(const Args& a, int it, const float*& src, int& ldN, bf16*& dst, int& K) {
    unsigned char* ws = a.ws;
    constexpr int I0 = 16 * 80, I1 = 16 * 32, I2 = 16 * 176, I4 = 44 * 32, I6 = 16 * 48;
    const float* W; bf16* WT; int N; bool remap = false; int r = it;
    if (r < I0) { W = a.in[11]; K = 1024; N = RCW; WT = (bf16*)(ws + WS_WRCIN); }
    else if ((r -= I0) < I2) { W = a.in[9]; K = 1024; N = 2 * DFF; WT = (bf16*)(ws + WS_WFIN0); remap = true; }
    else if ((r -= I2) < I6) { W = a.in[21]; K = 1024; N = NQKV; WT = (bf16*)(ws + WS_WQKV); }
    else if ((r -= I6) < I1) { W = a.in[20]; K = 1024; N = 1024; WT = (bf16*)(ws + WS_WRCOUT); }
    else if ((r -= I1) < I4) { W = a.in[10]; K = DFF; N = 1024; WT = (bf16*)(ws + WS_WFOUT0); }
    else if ((r -= I4) < I2) { W = a.in[9] + (size_t)1024 * 2 * DFF; K = 1024; N = 2 * DFF; WT = (bf16*)(ws + WS_WFIN1); remap = true; }
    else if ((r -= I2) < I1) { W = a.in[23]; K = 1024; N = 1024; WT = (bf16*)(ws + WS_WAOUT); }
    else { r -= I1; W = a.in[10] + (size_t)DFF * 1024; K = DFF; N = 1024; WT = (bf16*)(ws + WS_WFOUT1); }
    const int nblk = N / 32, kb = r / nblk, nb = r % nblk; const int dst_n0 = 32 * nb; int src_n0 = dst_n0;
    if (remap) { const int pn = dst_n0 >> 8, w = dst_n0 & 255; src_n0 = (w < 128) ? 128 * pn + w : DFF + 128 * pn + (w - 128); }
    ldN = N; src = W + (size_t)(64 * kb) * N + src_n0; dst = WT + (size_t)dst_n0 * K + 64 * kb;
}
constexpr int COPY_NITEMS = 16 * 80 + 16 * 32 + 2 * 16 * 176 + 2 * 44 * 32 + 16 * 48 + 16 * 32;
constexpr int COPY_GA = 16 * 80 + 16 * 176 + 16 * 48;
constexpr int COPY_G1 = 16 * 80 + 16 * 32 + 16 * 176 + 16 * 48, COPY_G2 = COPY_G1 + 44 * 32, COPY_G3 = COPY_G2 + 16 * 176 + 16 * 32;
static_assert(COPY_G3 + 44 * 32 == COPY_NITEMS, "copy groups");
DI void copy_items(const Args& a, LAS unsigned char* lds, int wave, int lane, int first, int second, int stride, int end) {
    LAS float* scr = (LAS float*)(lds + wave * 16384);
    int it = first; bool fst = true;
    float tv[32], tn[32];
    const float* src; int ldN; bf16* dst; int K;
    if (it < end) { item_desc(a, it, src, ldN, dst, K);
#pragma unroll
        for (int i = 0; i < 32; ++i) tv[i] = src[(size_t)(2 * i + (lane >> 5)) * ldN + (lane & 31)]; }
    while (it < end) {
        bf16* dcur = dst; const int Kcur = K;
        const int nx = fst ? second : it + stride; fst = false;
        const bool more = nx < end;
        if (more) { item_desc(a, nx, src, ldN, dst, K);
#pragma unroll
            for (int i = 0; i < 32; ++i) tn[i] = src[(size_t)(2 * i + (lane >> 5)) * ldN + (lane & 31)]; }
#pragma unroll
        for (int i = 0; i < 32; ++i) scr[(2 * i + (lane >> 5)) * 33 + (lane & 31)] = tv[i];
        asm volatile("s_waitcnt lgkmcnt(0)" ::: "memory");
        const int c = lane & 7;
#pragma unroll
        for (int j = 0; j < 4; ++j) { const int n = (lane >> 3) + 8 * j; const LAS float* s_ = scr + (8 * c) * 33 + n;
            u32x4 o; o.x = pk2(s_[0 * 33], s_[1 * 33]); o.y = pk2(s_[2 * 33], s_[3 * 33]); o.z = pk2(s_[4 * 33], s_[5 * 33]); o.w = pk2(s_[6 * 33], s_[7 * 33]);
            *(u32x4*)(dcur + (size_t)n * Kcur + 8 * c) = o; }
        asm volatile("s_waitcnt lgkmcnt(0)" ::: "memory");
        if (more) {
#pragma unroll
            for (int i = 0; i < 32; ++i) tv[i] = tn[i]; }
        it = nx;
    }
}
DI void ada_items(const Args& a, LAS unsigned char* lds, int tid, int wave, int lane, int first, int last, int brank, int nblk, unsigned* cnt) {
    LAS float* red = (LAS float*)lds;
    float* MOD = (float*)(a.ws + WS_MOD);
    for (int it = first + brank; it < last; it += nblk) {
        __syncthreads();
        const int l = it / 96, n0 = (it % 96) * 64, cl = lane & 15, ksub = lane >> 4;
        f32x4 a0 = {0.f, 0.f, 0.f, 0.f}, a1 = a0, a2 = a0;
        const float* wbase = a.in[4] + (size_t)l * 1024 * 6144 + n0 + 4 * cl;
#pragma unroll 16
        for (int i = 0; i < 32; ++i) { const int k = 128 * wave + 4 * i + ksub;
            const f32x4 w = *(const f32x4*)(wbase + (size_t)k * 6144);
            const float s0 = siluf_(a.in[1][k]), s1 = siluf_(a.in[1][1024 + k]), s2 = siluf_(a.in[3][k]);
            a0 += w * s0; a1 += w * s1; a2 += w * s2; }
#pragma unroll
        for (int j = 0; j < 4; ++j) { a0[j] += __shfl_xor(a0[j], 16); a0[j] += __shfl_xor(a0[j], 32); a1[j] += __shfl_xor(a1[j], 16); a1[j] += __shfl_xor(a1[j], 32); a2[j] += __shfl_xor(a2[j], 16); a2[j] += __shfl_xor(a2[j], 32); }
        if (ksub == 0) {
#pragma unroll
            for (int j = 0; j < 4; ++j) { red[(wave * 3 + 0) * 64 + 4 * cl + j] = a0[j]; red[(wave * 3 + 1) * 64 + 4 * cl + j] = a1[j]; red[(wave * 3 + 2) * 64 + 4 * cl + j] = a2[j]; } }
        __syncthreads();
        if (tid < 192) { const int bs = tid >> 6, col = tid & 63; float s_ = a.in[5][l * 6144 + n0 + col];
#pragma unroll
            for (int w = 0; w < 8; ++w) s_ += red[(w * 3 + bs) * 64 + col];
            __hip_atomic_store(MOD + (size_t)(l * 3 + bs) * 6144 + n0 + col, s_, __ATOMIC_RELAXED, __HIP_MEMORY_SCOPE_AGENT); }
        if (cnt) { asm volatile("s_waitcnt vmcnt(0)" ::: "memory"); __syncthreads(); if (tid == 0) __hip_atomic_fetch_add(cnt, 1u, __ATOMIC_RELAXED, __HIP_MEMORY_SCOPE_AGENT); }
    }
    __syncthreads();
}
constexpr int CTL_ADA = 12288;
DI void prologue(const Args& a, LAS unsigned char* lds, int tid, int lane, int wave) {
    unsigned char* ws = a.ws;
    unsigned* adacnt = (unsigned*)(ws + WS_CTL) + CTL_ADA;
    const bool deal = (gridDim.x == 256);
    const int n_ada = deal ? 96 : 192;
    ada_items(a, lds, tid, wave, lane, 0, n_ada, blockIdx.x, gridDim.x, adacnt);
    {
        const int gw = blockIdx.x * NWAVES + wave, NGW = gridDim.x * NWAVES;
        const int base = deal ? 1280 : 0; const bool ex = deal && blockIdx.x >= 96;
        copy_items(a, lds, wave, lane, ex ? (blockIdx.x - 96) * NWAVES + wave : base + gw, ex ? base + gw : base + gw + NGW, NGW, deal ? COPY_GA : COPY_NITEMS);
    }
    {
        const int gt = blockIdx.x * 512 + tid, NT = gridDim.x * 512;
        bf16* GW = (bf16*)(ws + WS_GW);
        for (int idx = gt; idx < 131072; idx += NT) {
            const int j = idx & 7, ln = (idx >> 3) & 63, ks = (idx >> 9) & 3, mt = (idx >> 11) & 1, head = (idx >> 12) & 7, dg = idx >> 15;
            const int hi = ln >> 5, m = ln & 31;
            const int cin = 32 * (ks >> 1) + 16 * (ks & 1) + 8 * (j >> 2) + 4 * hi + (j & 3), cout = 32 * mt + m;
            const int d = dg >> 1; const float* src = (dg & 1) ? a.in[16] : a.in[14];
            const float v = src[((size_t)(d * 8 + head) * 64 + cin) * 64 + cout];
            GW[idx] = (bf16)(pk2(v, 0.f) & 0xffffu);
        }
        float* sp8 = (float*)(ws + WS_SP8);
        for (int idx = gt; idx < 2 * DLRU; idx += NT) sp8[idx] = -8.0f * log1pf(expf(-a.in[18][idx]));
        float* rc = (float*)(ws + WS_ROPEC); float* rs = (float*)(ws + WS_ROPES);
        for (int idx = blockIdx.x * 8 + tid; tid < 8 && idx < 2048; idx += gridDim.x * 8) {
            const int pos = idx >> 4, f = idx & 15;
            const float inv = exp2f((float)f * -0.83048202372184058696f);
            const float ang = (float)pos * inv;
            double x = (double)ang; const double n = rint(x * 0.15915494309189535); x -= n * 6.283185307179586476925;
            const double x2 = x * x; double cs = 1.0, sn = 1.0;
            { double t = 1.0, s_ = 1.0;
#pragma unroll
              for (int i = 1; i <= 14; ++i) { t *= -x2 * (1.0 / (double)((2 * i - 1) * (2 * i))); s_ += t; } cs = s_; }
            { double t = 1.0, s_ = 1.0;
#pragma unroll
              for (int i = 1; i <= 14; ++i) { t *= -x2 * (1.0 / (double)((2 * i) * (2 * i + 1))); s_ += t; } sn = s_ * x; }
            rc[idx] = (float)cs; rs[idx] = (float)sn;
        }
    }
    wait_count(adacnt, (unsigned)n_ada, tid);

}

DI void norm_mod_phase(const float* srcL, const float* srcC, int nrows, const float* g, const float* mod, int shk, int sck, bf16* dst, int wave, int lane) {
    const int gw = blockIdx.x * NWAVES + wave, NGW = gridDim.x * NWAVES;
    f32x4 v[3][4], vn[3][4];
#pragma unroll
    for (int q = 0; q < 3; ++q) { const int row = gw + q * NGW;
        if (row < nrows) { const f32x4* x4 = (const f32x4*)(row < ML ? srcL + (size_t)row * DM : srcC + (size_t)(row - ML) * DM) + lane;
#pragma unroll
            for (int j = 0; j < 4; ++j) v[q][j] = x4[64 * j]; } }
    for (int base = gw; base < nrows; base += 3 * NGW) {
#pragma unroll
        for (int q = 0; q < 3; ++q) { const int row = base + (3 + q) * NGW;
            if (row < nrows) { const f32x4* x4 = (const f32x4*)(row < ML ? srcL + (size_t)row * DM : srcC + (size_t)(row - ML) * DM) + lane;
#pragma unroll
                for (int j = 0; j < 4; ++j) vn[q][j] = x4[64 * j]; } }
#pragma unroll
        for (int q = 0; q < 3; ++q) { const int row = base + q * NGW;
            if (row < nrows) {
                const float* mb = mod + bsel(row) * 6144;
                float ss = 0.f;
#pragma unroll
                for (int j = 0; j < 4; ++j) ss += (v[q][j][0] * v[q][j][0] + v[q][j][1] * v[q][j][1]) + (v[q][j][2] * v[q][j][2] + v[q][j][3] * v[q][j][3]);
                const float rstd = 1.0f / sqrtf(wave_sum(ss) * (1.f / DM) + 1e-6f);
                u32x2* o = (u32x2*)(dst + (size_t)row * DM) + lane;
#pragma unroll
                for (int j = 0; j < 4; ++j) { const f32x4 gg = ((const f32x4*)g)[lane + 64 * j], sc = ((const f32x4*)(mb + sck * 1024))[lane + 64 * j], sh = ((const f32x4*)(mb + shk * 1024))[lane + 64 * j];
                    const f32x4 y = (v[q][j] * rstd * gg) * (sc + 1.0f) + sh; o[64 * j] = pack4(y); } } }
#pragma unroll
        for (int q = 0; q < 3; ++q)
#pragma unroll
            for (int j = 0; j < 4; ++j) v[q][j] = vn[q][j];
    }
}
DI void final_norm_phase(const bf16* X, const float* g, float* out, int wave, int lane) {
    const int gw = blockIdx.x * NWAVES + wave, NGW = gridDim.x * NWAVES;
    for (int row = gw; row < ML; row += NGW) {
        const u32x2* x2 = (const u32x2*)(X + (size_t)row * DM) + lane;
        f32x4 v[4]; float ss = 0.f;
#pragma unroll
        for (int j = 0; j < 4; ++j) { v[j] = unpack4(x2[64 * j]); ss += (v[j][0] * v[j][0] + v[j][1] * v[j][1]) + (v[j][2] * v[j][2] + v[j][3] * v[j][3]); }
        const float rstd = 1.0f / sqrtf(wave_sum(ss) * (1.f / DM) + 1e-6f);
        f32x4* o = (f32x4*)(out + (size_t)row * DM) + lane;
#pragma unroll
        for (int j = 0; j < 4; ++j) o[64 * j] = v[j] * rstd * ((const f32x4*)g)[lane + 64 * j];
    }
}

DI void aux_bias_f32(const Args& a, LAS unsigned char* lds, int tid, int wave, int lane, int brank, int nblk) {
    unsigned char* ws = a.ws;
    const float* sh = (const float*)(ws + WS_MOD) + (size_t)3 * 6144 + 3 * 1024;
    const float* W = a.in[9] + (size_t)1024 * 2 * DFF;
    float* BV2 = (float*)(ws + WS_BV) + (size_t)2 * 3 * (2 * DFF);
    LAS float* red = (LAS float*)lds;
    for (int it = brank; it < 2 * DFF / 64; it += nblk) {
        __syncthreads();
        const int c0 = 64 * it, cl = lane & 15, ksub = lane >> 4;
        f32x4 a0 = {0.f, 0.f, 0.f, 0.f}, a1 = a0;
#pragma unroll 16
        for (int i = 0; i < 32; ++i) { const int k = 128 * wave + 4 * i + ksub;
            const f32x4 w = *(const f32x4*)(W + (size_t)k * (2 * DFF) + c0 + 4 * cl);
            a0 += w * sh[k]; a1 += w * sh[6144 + k]; }
#pragma unroll
        for (int j = 0; j < 4; ++j) { a0[j] += __shfl_xor(a0[j], 16); a0[j] += __shfl_xor(a0[j], 32); a1[j] += __shfl_xor(a1[j], 16); a1[j] += __shfl_xor(a1[j], 32); }
        if (ksub == 0) {
#pragma unroll
            for (int j = 0; j < 4; ++j) { red[(wave * 2 + 0) * 64 + 4 * cl + j] = a0[j]; red[(wave * 2 + 1) * 64 + 4 * cl + j] = a1[j]; } }
        __syncthreads();
        if (tid < 128) { const int bs = tid >> 6, col = tid & 63; float s_ = 0.f;
#pragma unroll
            for (int w = 0; w < 8; ++w) s_ += red[(w * 2 + bs) * 64 + col];
            const int c = c0 + col, half = c >= DFF ? 1 : 0, cc = c - half * DFF, np = 256 * (cc >> 7) + 128 * half + (cc & 127);
            BV2[(size_t)bs * (2 * DFF) + np] = s_; }
    }
    __syncthreads();
}
DI void aux_phase(const Args& a, int tid, int wave, int lane, int brank, int nblk, int lmask) {
    unsigned char* ws = a.ws;
    const float* MOD = (const float*)(ws + WS_MOD);
    float* GM = (float*)(ws + WS_GM); float* BV = (float*)(ws + WS_BV);
    const int gt = brank * 512 + tid, NT = nblk * 512;
    for (int idx = gt; idx < 9 * 1024; idx += NT) { const int c = idx & 1023, bs = (idx >> 10) % 3, which = idx / 3072;
        if (!((lmask >> (which == 0 ? 0 : 1)) & 1)) continue;
        const float g = which == 0 ? a.in[7][c] : (which == 1 ? a.in[6][DM + c] : a.in[7][DM + c]);
        const float sc = MOD[(size_t)((which == 0 ? 0 : 1) * 3 + bs) * 6144 + (which == 1 ? 1 : 4) * 1024 + c];
        GM[idx] = g * (1.0f + sc); }
    const int gw = brank * NWAVES + wave, NGW = nblk * NWAVES;
    for (int it = gw; it < 2 * DFF + NQKV; it += NGW) {
        int which, n; if (it < 2 * DFF) { which = 0; n = it; } else { which = 1; n = it - 2 * DFF; }
        if (!((lmask >> which) & 1)) continue;
        const bf16* Bt = (const bf16*)(ws + (which == 0 ? WS_WFIN0 : (which == 1 ? WS_WQKV : WS_WFIN1))) + (size_t)n * DM + 16 * lane;
        const int N = which == 1 ? NQKV : 2 * DFF;
        const float* shb = MOD + (size_t)((which == 0 ? 0 : 1) * 3) * 6144 + (which == 1 ? 0 : 3) * 1024 + 16 * lane;
        const u32x4 w0 = *(const u32x4*)Bt, w1 = *(const u32x4*)(Bt + 8);
        const f32x4 wv[4] = {unpack4((u32x2){w0.x, w0.y}), unpack4((u32x2){w0.z, w0.w}), unpack4((u32x2){w1.x, w1.y}), unpack4((u32x2){w1.z, w1.w})};
        float acc[3];
#pragma unroll
        for (int bs = 0; bs < 3; ++bs) { float s_ = 0.f;
#pragma unroll
            for (int q = 0; q < 4; ++q) { const f32x4 sh = *(const f32x4*)(shb + bs * 6144 + 4 * q); s_ += (wv[q][0] * sh[0] + wv[q][1] * sh[1]) + (wv[q][2] * sh[2] + wv[q][3] * sh[3]); }
            acc[bs] = wave_sum(s_); }
        if (lane == 0) { float* o = BV + (size_t)which * 3 * (2 * DFF) + n; o[0] = acc[0]; o[N] = acc[1]; o[2 * N] = acc[2]; }
    }
}

constexpr int RG_UNITS = NB * NCH * 8;
typedef _Float16 f16x4_t __attribute__((ext_vector_type(4)));
DI u32x2 pack4h(f32x4 v) { f16x4_t h = __builtin_convertvector(v, f16x4_t); return __builtin_bit_cast(u32x2, h); }
DI f32x4 unpack4h(u32x2 u) { return __builtin_convertvector(__builtin_bit_cast(f16x4_t, u), f32x4); }
DI unsigned short* rg_acum_ptr(const Args& a, int unit) { return (unsigned short*)(a.ws + WS_X) + (size_t)unit * 4096; }
DI unsigned short* rg_bcum_ptr(const Args& a, int unit) { return (unsigned short*)a.out + (size_t)unit * 4096; }
template <int CTRL, int RMASK> DI float dppf(float oldv, float v) {
    return __builtin_bit_cast(float, __builtin_amdgcn_update_dpp(__builtin_bit_cast(int, oldv), __builtin_bit_cast(int, v), CTRL, RMASK, 0xf, false));
}
#define RG_SCAN_STEP(CTRL, RMASK) do { _Pragma("unroll") for (int r = 0; r < 16; ++r) { const float am = aR[r], bm = aI[r]; \
        const float ap = dppf<CTRL, RMASK>(1.0f, am), bp = dppf<CTRL, RMASK>(0.0f, bm); aR[r] = am * ap; aI[r] = __builtin_fmaf(am, bp, bm); } } while (0)
template <int D, int MT_> DI void rg1_quarter(const float (&xc)[2][16], const bf16x8 (&xb)[4], const LAS unsigned char* gwl, const LAS float* pv,
                                              unsigned short* acum, unsigned short* bcum, float* SUMA, float* SUMB, int lane, size_t sbase) {
    const int hi = lane >> 5;
    f32x16 aR, aI;
#pragma unroll
    for (int i = 0; i < 16; ++i) { aR[i] = 0.f; aI[i] = 0.f; }
#pragma unroll
    for (int ks = 0; ks < 4; ++ks) {
        const bf16x8 wr_ = *(const LAS bf16x8*)(gwl + ((((D * 2 + 0) * 2 + MT_) * 4 + ks) * 64 + lane) * 16);
        const bf16x8 wi_ = *(const LAS bf16x8*)(gwl + ((((D * 2 + 1) * 2 + MT_) * 4 + ks) * 64 + lane) * 16);
        aR = __builtin_amdgcn_mfma_f32_32x32x16_bf16(wr_, xb[ks], aR, 0, 0, 0);
        aI = __builtin_amdgcn_mfma_f32_32x32x16_bf16(wi_, xb[ks], aI, 0, 0, 0);
    }
#pragma unroll
    for (int rq = 0; rq < 4; ++rq) {
        const int c0 = 32 * MT_ + 8 * rq + 4 * hi;
        const f32x4 rb4 = *(const LAS f32x4*)(pv + 320 + D * 64 + c0), ib4 = *(const LAS f32x4*)(pv + 448 + D * 64 + c0), lm4 = *(const LAS f32x4*)(pv + 576 + D * 64 + c0);
#pragma unroll
        for (int j = 0; j < 4; ++j) { const int r = 4 * rq + j;
            const float rr = __builtin_amdgcn_rcpf(1.0f + __builtin_amdgcn_exp2f(__builtin_fmaf(aR[r], -LOG2E, rb4[j])));
            const float ii = __builtin_amdgcn_rcpf(1.0f + __builtin_amdgcn_exp2f(__builtin_fmaf(aI[r], -LOG2E, ib4[j])));
            const float av = __builtin_amdgcn_exp2f(rr * lm4[j]);
            const float mult = __builtin_amdgcn_sqrtf(fmaxf(__builtin_fmaf(-av, av, 1.0f), 1e-12f));
            aR[r] = av; aI[r] = mult * ii * xc[MT_][r]; }
    }
    if (D == 1) {
#pragma unroll
        for (int r = 0; r < 16; ++r) { aR[r] = __shfl_xor(aR[r], 31); aI[r] = __shfl_xor(aI[r], 31); }
    }
    RG_SCAN_STEP(0x111, 0xf);
    RG_SCAN_STEP(0x112, 0xf);
    RG_SCAN_STEP(0x114, 0xf);
    RG_SCAN_STEP(0x118, 0xf);
    RG_SCAN_STEP(0x142, 0xa);
#pragma unroll
    for (int rq = 0; rq < 4; ++rq) {
        *(u32x2*)(acum + ((D * 2 + MT_) * 4 + rq) * 256 + lane * 4) = pack4h((f32x4){aR[4 * rq], aR[4 * rq + 1], aR[4 * rq + 2], aR[4 * rq + 3]});
        *(u32x2*)(bcum + ((D * 2 + MT_) * 4 + rq) * 256 + lane * 4) = pack4h((f32x4){aI[4 * rq], aI[4 * rq + 1], aI[4 * rq + 2], aI[4 * rq + 3]});
    }
    if ((lane & 31) == 31) {
#pragma unroll
        for (int rq = 0; rq < 4; ++rq) { const int c0 = 32 * MT_ + 8 * rq + 4 * hi;
            *(f32x4*)(SUMA + sbase + D * DLRU + c0) = (f32x4){aR[4 * rq], aR[4 * rq + 1], aR[4 * rq + 2], aR[4 * rq + 3]};
            *(f32x4*)(SUMB + sbase + D * DLRU + c0) = (f32x4){aI[4 * rq], aI[4 * rq + 1], aI[4 * rq + 2], aI[4 * rq + 3]}; }
    }
}
template <int QMASK> DI void rg1_unit(const Args& a, const LAS unsigned char* gwl, const LAS float* pv, int cb, int head, int lane_in) {
    unsigned char* ws = a.ws;
    const bf16* U = (const bf16*)(ws + WS_R1);
    float* SUMA = (float*)(ws + WS_SUMA); float* SUMB = (float*)(ws + WS_SUMB);
    int lane_o = lane_in; asm volatile("" : "+v"(lane_o));
    const int lane = lane_o, tok = lane & 31, hi = lane >> 5;
    const int gc = cb >> 1, b = cb & 1, unit = cb * 8 + head;
    const bool lat = gc < 256;
    const int ts0 = lat ? gc * 32 : (gc - 256) * 32, len = lat ? SEQ : CTX, rowbase = lat ? b * SEQ : ML + b * CTX;
    const int ts = ts0 + tok;
    u32x2 tap[8][4];
#pragma unroll
    for (int k = 0; k < 4; ++k) { const int tt = ts - 2 + k; const bool ok = (tt >= 0) && (tt < len); const int ttc = ok ? tt : ts;
        const bf16* up = U + (size_t)(rowbase + ttc) * RCW + head * 64 + 4 * hi;
#pragma unroll
        for (int q = 0; q < 8; ++q) { u32x2 v = *(const u32x2*)(up + 8 * q); if (!ok) { v.x = 0u; v.y = 0u; } tap[q][k] = v; } }
    float xc[2][16];
#pragma unroll
    for (int q = 0; q < 8; ++q) {
        f32x4 acc = *(const LAS f32x4*)(pv + 256 + 8 * q + 4 * hi);
#pragma unroll
        for (int k = 0; k < 4; ++k) acc += *(const LAS f32x4*)(pv + k * 64 + 8 * q + 4 * hi) * unpack4(tap[q][k]);
#pragma unroll
        for (int j = 0; j < 4; ++j) xc[q >> 2][4 * (q & 3) + j] = acc[j];
    }
    bf16x8 xb[4];
#pragma unroll
    for (int ks = 0; ks < 4; ++ks) { const int mt = ks >> 1, r0 = 8 * (ks & 1);
        u32x4 p; p.x = pk2(xc[mt][r0], xc[mt][r0 + 1]); p.y = pk2(xc[mt][r0 + 2], xc[mt][r0 + 3]); p.z = pk2(xc[mt][r0 + 4], xc[mt][r0 + 5]); p.w = pk2(xc[mt][r0 + 6], xc[mt][r0 + 7]);
        xb[ks] = __builtin_bit_cast(bf16x8, p); }
    unsigned short* acum = rg_acum_ptr(a, unit); unsigned short* bcum = rg_bcum_ptr(a, unit);
    const size_t sbase = ((size_t)(b * NCH + gc) * 2) * DLRU + head * 64;
    if (QMASK & 1) { rg1_quarter<0, 0>(xc, xb, gwl, pv, acum, bcum, SUMA, SUMB, lane, sbase); asm volatile("" ::: "memory"); }
    if (QMASK & 2) { rg1_quarter<0, 1>(xc, xb, gwl, pv, acum, bcum, SUMA, SUMB, lane, sbase); asm volatile("" ::: "memory"); }
    if (QMASK & 4) { rg1_quarter<1, 0>(xc, xb, gwl, pv, acum, bcum, SUMA, SUMB, lane, sbase); asm volatile("" ::: "memory"); }
    if (QMASK & 8) { rg1_quarter<1, 1>(xc, xb, gwl, pv, acum, bcum, SUMA, SUMB, lane, sbase); asm volatile("" ::: "memory"); }
}
DI void rg1_phase(const Args& a, LAS unsigned char* lds, int tid, int lane, int wave) {
    unsigned char* ws = a.ws;
    const int head = blockIdx.x & 7, nbh = ((int)gridDim.x - head + 7) >> 3;
    const int wslot = (blockIdx.x >> 3) * NWAVES + wave, NWS = nbh * NWAVES;
    LAS unsigned char* gwl = lds; LAS float* pv = (LAS float*)(lds + 32768);
    {
        const bf16* GW = (const bf16*)(ws + WS_GW);
#pragma unroll
        for (int i = 0; i < 4; ++i) { const int idx16 = tid + 512 * i, dg = idx16 >> 9;
            *(LAS u32x4*)(gwl + idx16 * 16) = *(const u32x4*)(GW + (size_t)(dg * 8 + head) * 4096 + (idx16 & 511) * 8); }
        for (int t = tid; t < 704; t += 512) { const int c = t & 63; float v;
            if (t < 256) v = a.in[12][(t >> 6) * DLRU + head * 64 + c];
            else if (t < 320) v = a.in[13][head * 64 + c];
            else if (t < 448) v = -LOG2E * a.in[15][((t - 320) >> 6) * DLRU + head * 64 + c];
            else if (t < 576) v = -LOG2E * a.in[17][((t - 448) >> 6) * DLRU + head * 64 + c];
            else v = LOG2E * ((const float*)(ws + WS_SP8))[((t - 576) >> 6) * DLRU + head * 64 + c];
            pv[t] = v; }
        __syncthreads();
    }
    for (int cb = wslot; cb < 512; cb += NWS) rg1_unit<15>(a, gwl, pv, cb, head, lane);
    for (int qi = wslot; qi < 64; qi += NWS) { const int cb = 512 + (qi >> 2), qq = qi & 3;
        if (qq == 0) rg1_unit<1>(a, gwl, pv, cb, head, lane); else if (qq == 1) rg1_unit<2>(a, gwl, pv, cb, head, lane);
        else if (qq == 2) rg1_unit<4>(a, gwl, pv, cb, head, lane); else rg1_unit<8>(a, gwl, pv, cb, head, lane); }
    __syncthreads();
}
DI void rg_carry_phase(const Args& a, LAS unsigned char* lds, int wave, int lane) {
    unsigned char* ws = a.ws;
    const float* SUMA = (const float*)(ws + WS_SUMA); const float* SUMB = (const float*)(ws + WS_SUMB); float* HIN = (float*)(ws + WS_HIN);
    LAS float* sh = (LAS float*)lds;
    for (int it = blockIdx.x; it < 32; it += gridDim.x) {
        const int head = it & 7, d = (it >> 3) & 1, b = it >> 4;
        const int c = lane, seg = wave; const float* sa = SUMA + c; const float* sb = SUMB + c; float* ho = HIN + c;
        float av[33], bv[33];
#pragma unroll
        for (int i = 0; i < 33; ++i) { const int st = seg * 33 + i; const int gc = d == 0 ? (st + 256) % NCH : (NCH - 1 - st);
            const unsigned idx = (unsigned)(((b * NCH + gc) * 2 + d) * DLRU + head * 64); av[i] = sa[idx]; bv[i] = sb[idx]; }
        float A = 1.f, B = 0.f;
#pragma unroll
        for (int i = 0; i < 33; ++i) { B = av[i] * B + bv[i]; A = av[i] * A; }
        __syncthreads();
        sh[(seg * 64 + c) * 2] = A; sh[(seg * 64 + c) * 2 + 1] = B;
        __syncthreads();
        float h = 0.f;
        for (int s = 0; s < seg; ++s) h = sh[(s * 64 + c) * 2] * h + sh[(s * 64 + c) * 2 + 1];
#pragma unroll
        for (int i = 0; i < 33; ++i) { const int st = seg * 33 + i; const int gc = d == 0 ? (st + 256) % NCH : (NCH - 1 - st);
            const unsigned idx = (unsigned)(((b * NCH + gc) * 2 + d) * DLRU + head * 64); ho[idx] = h; h = av[i] * h + bv[i]; }
    }
    __syncthreads();
}
struct Rg3In { u32x2 A[2][4], B[2][4], ga[4]; f32x4 H[2][4]; };
DI void rg3_load(const Args& a, int hu, int lane, Rg3In& r, int& row, int& ycol) {
    unsigned char* ws = a.ws;
    const bf16* U = (const bf16*)(ws + WS_R1); const float* HIN = (const float*)(ws + WS_HIN);
    const int tok = lane & 31, hi = lane >> 5;
    const int mt = hu & 1, unit = hu >> 1, head = unit & 7, cb = unit >> 3, gc = cb >> 1, b = cb & 1;
    row = (gc < 256 ? b * SEQ + gc * 32 : ML + b * CTX + (gc - 256) * 32) + tok; ycol = head * 64 + 32 * mt + 4 * hi;
    const unsigned short* acum = rg_acum_ptr(a, unit) + mt * 1024 + lane * 4; const unsigned short* bcum = rg_bcum_ptr(a, unit) + mt * 1024 + lane * 4;
    const float* hin = HIN + ((size_t)(b * NCH + gc) * 2) * DLRU + head * 64 + 32 * mt + 4 * hi;
#pragma unroll
    for (int d = 0; d < 2; ++d)
#pragma unroll
        for (int rq = 0; rq < 4; ++rq) { r.A[d][rq] = *(const u32x2*)(acum + d * 2048 + rq * 256); r.B[d][rq] = *(const u32x2*)(bcum + d * 2048 + rq * 256); r.H[d][rq] = *(const f32x4*)(hin + d * DLRU + 8 * rq); }
#pragma unroll
    for (int rq = 0; rq < 4; ++rq) r.ga[rq] = *(const u32x2*)(U + (size_t)row * RCW + DLRU + ycol + 8 * rq);
}
DI void rg3_phase(const Args& a, int wave, int lane_in) {
    bf16* Y = (bf16*)(a.ws + WS_HB);
    const int gw = blockIdx.x * NWAVES + wave, NGW = gridDim.x * NWAVES;
    int lane_o = lane_in; asm volatile("" : "+v"(lane_o));
    const int lane = lane_o;
    Rg3In cur, nxt; int row = 0, ycol = 0, nrow = 0, nycol = 0;
    if (gw < 2 * RG_UNITS) rg3_load(a, gw, lane, cur, row, ycol);
    for (int hu = gw; hu < 2 * RG_UNITS; hu += NGW) {
        const bool more = hu + NGW < 2 * RG_UNITS;
        if (more) rg3_load(a, hu + NGW, lane, nxt, nrow, nycol);
        u32x2 py[4];
#pragma unroll
        for (int rq = 0; rq < 4; ++rq) { const f32x4 ga = unpack4(cur.ga[rq]), A0 = unpack4h(cur.A[0][rq]), A1 = unpack4h(cur.A[1][rq]), B0 = unpack4h(cur.B[0][rq]), B1 = unpack4h(cur.B[1][rq]); f32x4 y;
#pragma unroll
            for (int j = 0; j < 4; ++j) { const float h0 = __builtin_fmaf(A0[j], cur.H[0][rq][j], B0[j]), h1 = __builtin_fmaf(A1[j], cur.H[1][rq][j], B1[j]);
                y[j] = (h0 + __shfl_xor(h1, 31)) * gelu_tanh(ga[j]); }
            py[rq] = pack4(y); }
        {
            const int hi_ = lane >> 5; bf16* yrow = Y + (size_t)row * DM + (ycol - 4 * hi_);
#pragma unroll
            for (int rp = 0; rp < 2; ++rp) { const u32x2 p0_ = py[2 * rp], p1_ = py[2 * rp + 1]; const u32x2 sd_ = hi_ ? p0_ : p1_; u32x2 rc_; rc_.x = (unsigned)__shfl_xor((int)sd_.x, 32); rc_.y = (unsigned)__shfl_xor((int)sd_.y, 32);
                *(u32x4*)(yrow + 8 * (2 * rp + hi_)) = hi_ ? (u32x4){rc_.x, rc_.y, p1_.x, p1_.y} : (u32x4){p0_.x, p0_.y, rc_.x, rc_.y}; } }
        if (more) { cur = nxt; row = nrow; ycol = nycol; }
    }
}
DI void sc_phase(const Args& a, int wave, int lane) {
    unsigned char* ws = a.ws;
    const bf16* U = (const bf16*)(ws + WS_R1);
    bf16* Y = (bf16*)(ws + WS_HB);
    const float* convB = a.in[19];
    const int gw = blockIdx.x * NWAVES + wave, NGW = gridDim.x * NWAVES;
    f32x4 w[3][2];
#pragma unroll
    for (int k = 0; k < 3; ++k) { w[k][0] = *(const f32x4*)(convB + k * DLRU + 8 * lane); w[k][1] = *(const f32x4*)(convB + k * DLRU + 8 * lane + 4); }
    for (int tile = gw; tile < MT / 8; tile += NGW) {
        const int row0 = tile * 8;
        const int seq0 = row0 < ML ? (row0 & ~(SEQ - 1)) : ML + ((row0 - ML) & ~(CTX - 1)), seqlen = row0 < ML ? SEQ : CTX;
        const bf16* up = U + (size_t)row0 * RCW + 8 * lane;
        u32x4 cgr[10], vr[10], bgr[8];
#pragma unroll
        for (int i = 0; i < 10; ++i) { const int r = row0 - 1 + i; const bool ok = (r >= seq0) && (r < seq0 + seqlen); const bf16* q = up + (ptrdiff_t)(ok ? i - 1 : 0) * RCW;
            cgr[i] = *(const u32x4*)(q + 3 * DLRU); vr[i] = *(const u32x4*)(q + 4 * DLRU); if (!ok) { cgr[i] = (u32x4){0u, 0u, 0u, 0u}; } }
#pragma unroll
        for (int i = 0; i < 8; ++i) bgr[i] = *(const u32x4*)(up + (size_t)i * RCW + 2 * DLRU);
        f32x4 p[10][2];
#pragma unroll
        for (int i = 0; i < 10; ++i) { p[i][0] = unpack4((u32x2){cgr[i].x, cgr[i].y}) * unpack4((u32x2){vr[i].x, vr[i].y}); p[i][1] = unpack4((u32x2){cgr[i].z, cgr[i].w}) * unpack4((u32x2){vr[i].z, vr[i].w}); }
#pragma unroll
        for (int i = 0; i < 8; ++i) {
            const f32x4 o0 = unpack4((u32x2){bgr[i].x, bgr[i].y}) * (w[0][0] * p[i][0] + w[1][0] * p[i + 1][0] + w[2][0] * p[i + 2][0]);
            const f32x4 o1 = unpack4((u32x2){bgr[i].z, bgr[i].w}) * (w[0][1] * p[i][1] + w[1][1] * p[i + 1][1] + w[2][1] * p[i + 2][1]);
            const u32x2 q0 = pack4(o0), q1 = pack4(o1);
            *(u32x4*)(Y + (size_t)(row0 + i) * DM + DLRU + 8 * lane) = (u32x4){q0.x, q0.y, q1.x, q1.y}; }
    }
}

constexpr int ATT_TB = 64 * 144;
DI int att_nt(int u) { const int q64 = (u >> 2) & 127; const int lo = q64 - 2 < 0 ? 0 : q64 - 2, hi = q64 + 2 > 127 ? 127 : q64 + 2; return hi - lo + 1 + 4; }
DI void att_load(const bf16* KV, int u, int t, int srow, int sch, u32x4& kreg, u32x4& vreg) {
    const int hk = u & 3, q64 = (u >> 2) & 127, b = u >> 9;
    const int kt_lo = q64 - 2 < 0 ? 0 : q64 - 2, kt_hi = q64 + 2 > 127 ? 127 : q64 + 2, nwin = kt_hi - kt_lo + 1;
    const int rowk = (t < nwin) ? (b * SEQ + (kt_lo + t) * 64 + srow) : (ML + b * CTX + (t - nwin) * 64 + srow);
    const bf16* kp = KV + (size_t)rowk * 512 + hk * 64 + sch * 8; kreg = *(const u32x4*)kp; vreg = *(const u32x4*)(kp + 256);
}
DI void att_store(LAS unsigned char* base, int srow, int sch, const u32x4& kreg, const u32x4& vreg) {
    *(LAS u32x4*)(base + srow * 144 + sch * 16) = kreg;
    *(LAS u32x4*)(base + ATT_TB + srow * 144 + sch * 16) = vreg;
}
typedef short v4i16_t __attribute__((ext_vector_type(4)));
DI void att_tile(const LAS unsigned char* kb_, const bf16x8 (&qr)[4], float& m, float& l, f32x16 (&o)[2], f32x16& negm, bool edge, int kt, int qrow, int r32, int hi, int lane) {
    const LAS unsigned char* vb_ = kb_ + ATT_TB;
    f32x16 p[2];
#pragma unroll
    for (int sub = 0; sub < 2; ++sub)
#pragma unroll
        for (int d0 = 0; d0 < 4; ++d0) { const bf16x8 kf = *(const LAS bf16x8*)(kb_ + (32 * sub + r32) * 144 + (16 * d0 + 8 * hi) * 2);
            p[sub] = __builtin_amdgcn_mfma_f32_32x32x16_bf16(kf, qr[d0], d0 == 0 ? negm : p[sub], 0, 0, 0); }
    if (edge) {
#pragma unroll
        for (int sub = 0; sub < 2; ++sub)
#pragma unroll
            for (int r = 0; r < 16; ++r) { const int kpos = kt * 64 + 32 * sub + (r & 3) + 8 * (r >> 2) + 4 * hi; const int df = kpos - qrow;
                if (df > 128 || df < -128) p[sub][r] = -1e30f; }
    }
    float mx = p[0][0];
#pragma unroll
    for (int r = 1; r < 16; ++r) mx = fmaxf(mx, p[0][r]);
#pragma unroll
    for (int r = 0; r < 16; ++r) mx = fmaxf(mx, p[1][r]);
    mx = fmaxf(mx, __shfl_xor(mx, 32));
    if (__any(mx > 8.0f)) {
        const float dl = fmaxf(mx, 0.f), f = __builtin_amdgcn_exp2f(-dl); m += dl; l *= f;
#pragma unroll
        for (int i = 0; i < 16; ++i) { p[0][i] -= dl; p[1][i] -= dl; o[0][i] *= f; o[1][i] *= f; negm[i] = -m; }
    }
    float ls = 0.f;
#pragma unroll
    for (int sub = 0; sub < 2; ++sub)
#pragma unroll
        for (int r = 0; r < 16; ++r) { const float e = __builtin_amdgcn_exp2f(p[sub][r]); p[sub][r] = e; ls += e; }
    l += ls;
    bf16x8 pb[4];
#pragma unroll
    for (int ks = 0; ks < 4; ++ks) { const int sub = ks >> 1, r0 = 8 * (ks & 1);
        u32x4 w; w.x = pk2(p[sub][r0], p[sub][r0 + 1]); w.y = pk2(p[sub][r0 + 2], p[sub][r0 + 3]); w.z = pk2(p[sub][r0 + 4], p[sub][r0 + 5]); w.w = pk2(p[sub][r0 + 6], p[sub][r0 + 7]);
        pb[ks] = __builtin_bit_cast(bf16x8, w); }
    const LAS unsigned char* vtb = vb_ + (4 * hi + ((lane & 15) >> 2)) * 144 + (16 * ((lane >> 4) & 1) + 4 * (lane & 3)) * 2;
#pragma unroll
    for (int dt = 0; dt < 2; ++dt)
#pragma unroll
        for (int ks = 0; ks < 4; ++ks) { const LAS unsigned char* vp = vtb + (16 * ks) * 144 + (32 * dt) * 2;
            const v4i16_t lo = __builtin_amdgcn_ds_read_tr16_b64_v4i16((LAS v4i16_t*)vp), hi2 = __builtin_amdgcn_ds_read_tr16_b64_v4i16((LAS v4i16_t*)(vp + 8 * 144));
            const bf16x8 av = __builtin_shufflevector(lo, hi2, 0, 1, 2, 3, 4, 5, 6, 7);
            o[dt] = __builtin_amdgcn_mfma_f32_32x32x16_bf16(av, pb[ks], o[dt], 0, 0, 0); }
}
DI void attn_phase(const Args& a, LAS unsigned char* lds, int tid, int lane, int wave) {
    unsigned char* ws = a.ws;
    const bf16* Q = (const bf16*)(ws + WS_Q); const bf16* KV = (const bf16*)(ws + WS_KV);
    bf16* O = (bf16*)(ws + WS_O);
    const float* sink = a.in[22];
    const int r32 = lane & 31, hi = lane >> 5, srow = tid >> 3, sch = tid & 7;
    const int G = gridDim.x, NU = NB * 128 * 4;
    f32x16 zero16;
#pragma unroll
    for (int i = 0; i < 16; ++i) zero16[i] = 0.f;
    asm volatile("" : "+v"(zero16));
    const int u0 = blockIdx.x;
    if (u0 >= NU) return;
    for (int ubase = u0; ubase < NU; ubase += 4 * G) {
        const int c1 = att_nt(ubase);
        const int c2 = c1 + ((ubase + G < NU) ? att_nt(ubase + G) : 0);
        const int c3 = c2 + ((ubase + 2 * G < NU) ? att_nt(ubase + 2 * G) : 0);
        const int T = c3 + ((ubase + 3 * G < NU) ? att_nt(ubase + 3 * G) : 0);
#define ATT_DECODE(g, uu, tt) do { const int i_ = ((g) >= c1) + ((g) >= c2) + ((g) >= c3); uu = ubase + i_ * G; tt = (g) - (i_ == 0 ? 0 : (i_ == 1 ? c1 : (i_ == 2 ? c2 : c3))); } while (0)
        u32x4 k0, v0, k1, v1;
        { att_load(KV, ubase, 0, srow, sch, k0, v0); if (T > 1) { int uu, tt; ATT_DECODE(1, uu, tt); att_load(KV, uu, tt, srow, sch, k1, v1); } }
        int cu = ubase, ct = 0, cnt = c1;
        bf16x8 qr[4], qn[4];
        float m, l; f32x16 o[2], negm;
#define ATT_QLOAD(dst, uu) do { const int hk_ = (uu) & 3, q64_ = ((uu) >> 2) & 127, b_ = (uu) >> 9; const int head_ = hk_ * 4 + (wave >> 1), qrow_ = q64_ * 64 + (wave & 1) * 32 + r32; \
            _Pragma("unroll") for (int d0 = 0; d0 < 4; ++d0) dst[d0] = *(const bf16x8*)(Q + (size_t)(b_ * SEQ + qrow_) * DM + head_ * 64 + 16 * d0 + 8 * hi); } while (0)
#define ATT_INIT(uu) do { const int head_ = ((uu) & 3) * 4 + (wave >> 1); m = sink[head_] * LOG2E; l = (hi == 0) ? 1.f : 0.f; \
            _Pragma("unroll") for (int i = 0; i < 16; ++i) { o[0][i] = 0.f; o[1][i] = 0.f; negm[i] = -m; } } while (0)
        ATT_QLOAD(qr, cu); ATT_INIT(cu);
        att_store(lds, srow, sch, k0, v0);
        __syncthreads();
#define ATT_ITER(f, KL, VL, KS, VS, CB, SB) do { \
            if ((f) + 2 < T) { int uu_, tt_; ATT_DECODE((f) + 2, uu_, tt_); att_load(KV, uu_, tt_, srow, sch, KL, VL); } \
            const bool last_ = (ct == cnt - 1); const bool more_ = last_ && ((f) + 1 < T); \
            if (more_) ATT_QLOAD(qn, cu + G); \
            { const int q64_ = (cu >> 2) & 127; const int kt_lo_ = q64_ - 2 < 0 ? 0 : q64_ - 2; const int nwin_ = cnt - 4; const int kt_ = kt_lo_ + ct; \
              const bool edge_ = (ct < nwin_) && (kt_ == q64_ - 2 || kt_ == q64_ + 2); \
              att_tile(lds + (CB) * 2 * ATT_TB, qr, m, l, o, negm, edge_, kt_, q64_ * 64 + (wave & 1) * 32 + r32, r32, hi, lane); } \
            if ((f) + 1 < T) att_store(lds + (SB) * 2 * ATT_TB, srow, sch, KS, VS); \
            __syncthreads(); \
            if (last_) { const int hk_ = cu & 3, q64_ = (cu >> 2) & 127, b_ = cu >> 9; const int head_ = hk_ * 4 + (wave >> 1), qrow_ = q64_ * 64 + (wave & 1) * 32 + r32; \
                const float lt_ = l + __shfl_xor(l, 32), inv_ = 1.0f / lt_; bf16* op_ = O + (size_t)(b_ * SEQ + qrow_) * DM + head_ * 64; \
                _Pragma("unroll") for (int dt = 0; dt < 2; ++dt) _Pragma("unroll") for (int rp = 0; rp < 2; ++rp) {   \
                    const f32x4 va_ = {o[dt][8 * rp] * inv_, o[dt][8 * rp + 1] * inv_, o[dt][8 * rp + 2] * inv_, o[dt][8 * rp + 3] * inv_}, vb_ = {o[dt][8 * rp + 4] * inv_, o[dt][8 * rp + 5] * inv_, o[dt][8 * rp + 6] * inv_, o[dt][8 * rp + 7] * inv_}; \
                    const u32x2 p0_ = pack4(va_), p1_ = pack4(vb_); const u32x2 sd_ = hi ? p0_ : p1_; u32x2 rc_; rc_.x = (unsigned)__shfl_xor((int)sd_.x, 32); rc_.y = (unsigned)__shfl_xor((int)sd_.y, 32); \
                    const u32x4 w_ = hi ? (u32x4){rc_.x, rc_.y, p1_.x, p1_.y} : (u32x4){p0_.x, p0_.y, rc_.x, rc_.y}; *(u32x4*)(op_ + 32 * dt + 8 * (2 * rp + hi)) = w_; } \
                if (more_) { cu += G; ct = 0; cnt = att_nt(cu); _Pragma("unroll") for (int d0 = 0; d0 < 4; ++d0) qr[d0] = qn[d0]; ATT_INIT(cu); } } \
            else { ++ct; } } while (0)
        for (int f = 0; f < T; f += 2) {
            ATT_ITER(f, k0, v0, k1, v1, 0, 1);
            if (f + 1 < T) ATT_ITER(f + 1, k1, v1, k0, v0, 1, 0);
        }
#undef ATT_ITER
#undef ATT_QLOAD
#undef ATT_INIT
#undef ATT_DECODE
    }
}

#define XB_TMO      128
#define XB_XCNT(j)  (256  + 64 * (j))
#define XB_XSUB(j)  (1280 + 64 * (j))
#define XB_XGEN(j)  (2304 + 64 * (j))
#define XB_TOP      3328
#define XB_TOPGEN   3392
#define XCD_BAR_WORDS 3456
#define XB_SPIN_CAP (1u << 18)

__device__ __forceinline__ unsigned xb_ld(unsigned* p)              { return __hip_atomic_load(p, __ATOMIC_RELAXED, __HIP_MEMORY_SCOPE_AGENT); }
__device__ __forceinline__ unsigned xb_add(unsigned* p, unsigned v) { return __hip_atomic_fetch_add(p, v, __ATOMIC_RELAXED, __HIP_MEMORY_SCOPE_AGENT); }
__device__ __forceinline__ unsigned xb_xcc_id() { return (unsigned)__builtin_amdgcn_s_getreg((3 << 11) | 20) & 0xFu; }
#define XB_SPIN(cond, bar) do { unsigned _sp = 0; while (cond) { __builtin_amdgcn_s_sleep(1); \
    if ((++_sp & 255u) == 0u) { if (xb_ld(&(bar)[XB_TMO])) break; if (_sp > XB_SPIN_CAP) { atomicAdd(&(bar)[XB_TMO], 1u); break; } } } } while (0)

struct XcdBarrier {
    unsigned* bar; unsigned x;
    volatile LAS unsigned* st;
};

__device__ __forceinline__ XcdBarrier xcd_barrier_post(unsigned* bar, volatile LAS unsigned* st) {
    XcdBarrier b; b.bar = bar; b.x = xb_xcc_id(); b.st = st;
    if (threadIdx.x == 0) (void)xb_add(&bar[XB_XCNT(b.x)], 1u);
    return b;
}
__device__ __forceinline__ void xcd_barrier_complete(unsigned* bar, unsigned x, unsigned& nloc, unsigned& nx) {
    const unsigned G = gridDim.x * gridDim.y * gridDim.z;
    unsigned sum, cnt, mine, sp = 0u;
    for (;;) {
        sum = 0u; cnt = 0u; mine = 0u;
#pragma unroll
        for (unsigned j = 0; j < 16; ++j) { const unsigned c = xb_ld(&bar[XB_XCNT(j)]); sum += c; cnt += (c > 0u) ? 1u : 0u; mine = (j == x) ? c : mine; }
        if (sum == G) break;
        __builtin_amdgcn_s_sleep(1);
        if ((++sp & 255u) == 0u) { if (xb_ld(&bar[XB_TMO])) break; if (sp > XB_SPIN_CAP) { atomicAdd(&bar[XB_TMO], 1u); break; } }
    }
    nloc = mine > 0u ? mine : 1u; nx = cnt > 0u ? cnt : 1u;
}

__device__ __forceinline__ void xcd_barrier(const XcdBarrier& b) {
    asm volatile("s_waitcnt vmcnt(0)" ::: "memory");
    __syncthreads();
    if (threadIdx.x == 0) {
        unsigned* bar = b.bar;
        __builtin_amdgcn_s_waitcnt(0);
        unsigned nloc = b.st[0], nx = b.st[1];
        if (nloc == 0u) { xcd_barrier_complete(bar, b.x, nloc, nx); b.st[0] = nloc; b.st[1] = nx; }
        const unsigned old = xb_add(&bar[XB_XSUB(b.x)], 1u);
        const unsigned gen = old / nloc;
        if (old + 1u == (gen + 1u) * nloc) {
            __builtin_amdgcn_fence(__ATOMIC_RELEASE, "agent");
            asm volatile("s_waitcnt vmcnt(0)" ::: "memory");
            const unsigned og = xb_add(&bar[XB_TOP], 1u);
            const unsigned tg = og / nx;
            if (og + 1u == (tg + 1u) * nx) xb_add(&bar[XB_TOPGEN], 1u);
            else XB_SPIN(xb_ld(&bar[XB_TOPGEN]) == tg, bar);
            __builtin_amdgcn_fence(__ATOMIC_ACQUIRE, "agent");
            xb_add(&bar[XB_XGEN(b.x)], 1u);
            asm volatile("s_waitcnt vmcnt(0)" ::: "memory");
        } else {
            XB_SPIN(xb_ld(&bar[XB_XGEN(b.x)]) == gen, bar);
            __builtin_amdgcn_fence(__ATOMIC_ACQUIRE, "agent");
            asm volatile("s_waitcnt vmcnt(0)" ::: "memory");
        }
    }
    __syncthreads();
}

DI void static_unit(int L, int nM, int nN, pg8::Unit& u) {
    const int nwg = nM * nN; int wgid = L; { const int q = nwg / pg8::NXCD, r = nwg % pg8::NXCD, xcd = wgid % pg8::NXCD, off = wgid / pg8::NXCD; wgid = (xcd < r ? xcd * (q + 1) : r * (q + 1) + (xcd - r) * q) + off; }
    const int nig = pg8::WGM * nN, gid = wgid / nig, fm = gid * pg8::WGM, gsz = (nM - fm) < pg8::WGM ? (nM - fm) : pg8::WGM;
    u.pm = fm + ((wgid % nig) % gsz); u.pn = (wgid % nig) / gsz;
}
constexpr int FIN_NN = 2 * DFF / 256, FIN_CTX_UNITS = 2 * FIN_NN, FIN_LAT_UNITS = 64 * FIN_NN;
struct CtxFirstOrder {
    int G, c, lane; unsigned* cnt;
    DI bool next(int i, pg8::Unit& u) const {
        const int L = i * G + c; if (L >= FIN_CTX_UNITS + FIN_LAT_UNITS) return false;
        if (L < FIN_CTX_UNITS) { u.pm = 64 + L / FIN_NN; u.pn = L % FIN_NN; } else static_unit(L - FIN_CTX_UNITS, 64, FIN_NN, u);
        return true;
    }
    DI void a_ready(const pg8::Unit&) const {}
    DI void done(const pg8::Unit& u) const { if (u.pm >= 64) { asm volatile("s_waitcnt vmcnt(0)" ::: "memory"); if (lane == 0) __hip_atomic_fetch_add(cnt, 1u, __ATOMIC_RELAXED, __HIP_MEMORY_SCOPE_AGENT); } }
};
struct OneUnit {
    int pm, pn;
    DI bool next(int i, pg8::Unit& u) const { if (i) return false; u.pm = pm; u.pn = pn; return true; }
    DI void a_ready(const pg8::Unit&) const {}
    DI void done(const pg8::Unit&) const {}
};
struct EpiPartial {
    static constexpr bool PERM = false, AFTER_DRAIN = false;
    float* P;
    DI void operator()(const f32x4 (&acc)[2][2][4][2], const pg8::Unit& u, int wr, int wc, int fr, int fq) const {
        const __amdgpu_buffer_rsrc_t rs = __builtin_amdgcn_make_buffer_rsrc(P, 0, MC * DM * 4, 0x00020000);
        const int col0 = u.pn * 256 + wc * 32 + 4 * fq;
#pragma unroll
        for (int ai = 0; ai < 2; ++ai)
#pragma unroll
            for (int m = 0; m < 4; ++m) { const unsigned ob = (unsigned)(((u.pm * 256 + ai * 128 + wr * 64 + m * 16 + fr) * DM + col0) * 4);
#pragma unroll
                for (int bj = 0; bj < 2; ++bj)
#pragma unroll
                    for (int n = 0; n < 2; ++n) __builtin_amdgcn_raw_buffer_store_b128(__builtin_bit_cast(u32x4, acc[ai][bj][m][n]), rs, ob + (bj * 128 + n * 16) * 4, 0, 16); }
    }
};
template <bool BASEBF> DI void ctx_finish_row(const Args& a, int rc, int lane, const void* base, const float* gate, const float* gm, bf16* hbn) {
    unsigned char* ws = a.ws;
    const float* P = (const float*)(ws + WS_PART) + (size_t)rc * DM; bf16* X = (bf16*)(ws + WS_X) + (size_t)(ML + rc) * DM;
    bf16* hb = hbn + (size_t)(ML + rc) * DM; float* ssp = (float*)(ws + WS_SSP) + (size_t)(ML + rc) * 16;
    float ss = 0.f;
#pragma unroll
    for (int j = 0; j < 4; ++j) { const int c = 4 * (lane + 64 * j);
        const f32x4 p0 = *(const f32x4*)(P + c), p1 = *(const f32x4*)(P + (size_t)MC * DM + c), p2 = *(const f32x4*)(P + (size_t)2 * MC * DM + c), p3 = *(const f32x4*)(P + (size_t)3 * MC * DM + c);
        const f32x4 b4 = BASEBF ? unpack4(*(const u32x2*)((const bf16*)base + (size_t)rc * DM + c)) : *(const f32x4*)((const float*)base + (size_t)rc * DM + c);
        const f32x4 xn = b4 + *(const f32x4*)(gate + c) * (((p0 + p1) + p2) + p3);
        *(u32x2*)(X + c) = pack4(xn); ss += (xn[0] * xn[0] + xn[1] * xn[1]) + (xn[2] * xn[2] + xn[3] * xn[3]);
        *(u32x2*)(hb + c) = pack4(xn * *(const f32x4*)(gm + c)); }
    ss = wave_sum(ss);
    if (lane < 16) ssp[lane] = lane == 0 ? ss : 0.f;
}
struct OneUnitCounted {
    int pm, pn, lane; unsigned* cnt;
    DI bool next(int i, pg8::Unit& u) const { if (i) return false; u.pm = pm; u.pn = pn; return true; }
    DI void a_ready(const pg8::Unit&) const {}
    DI void done(const pg8::Unit&) const { asm volatile("s_waitcnt vmcnt(0)" ::: "memory"); if (lane == 0) __hip_atomic_fetch_add(cnt, 1u, __ATOMIC_RELAXED, __HIP_MEMORY_SCOPE_AGENT); }
};

struct EpiFinal {
    static constexpr bool PERM = false, AFTER_DRAIN = true;
    const bf16* X; const float* gate; const float* gfin; float* out; float* ssp; unsigned* cnt;
    DI void fused(f32x4 (&acc)[2][2][4][2], const pg8::Unit& u, int wr, int wc, int fr, int fq, LAS unsigned char* lds, int wid, int lane) const {
        const int bs = u.pm < 32 ? 0 : 1;
        const int col0 = u.pn * 256 + wc * 32 + 4 * fq;
        f32x4 gv[2][2];
#pragma unroll
        for (int bj = 0; bj < 2; ++bj)
#pragma unroll
            for (int n = 0; n < 2; ++n) gv[bj][n] = *(const f32x4*)(gate + bs * 6144 + col0 + bj * 128 + n * 16);
#pragma unroll
        for (int ai = 0; ai < 2; ++ai) {
            u32x2 praw[4][2][2];
#pragma unroll
            for (int m = 0; m < 4; ++m) { const int r = u.pm * 256 + ai * 128 + wr * 64 + m * 16 + fr; const bf16* bp = X + (size_t)r * DM + col0;
#pragma unroll
                for (int bj = 0; bj < 2; ++bj)
#pragma unroll
                    for (int n = 0; n < 2; ++n) praw[m][bj][n] = *(const u32x2*)(bp + bj * 128 + n * 16); }
#pragma unroll
            for (int m = 0; m < 4; ++m) { const int r = u.pm * 256 + ai * 128 + wr * 64 + m * 16 + fr;
                float ss = 0.f;
#pragma unroll
                for (int bj = 0; bj < 2; ++bj)
#pragma unroll
                    for (int n = 0; n < 2; ++n) { const f32x4 xn = unpack4(praw[m][bj][n]) + gv[bj][n] * acc[ai][bj][m][n]; acc[ai][bj][m][n] = xn;
                        ss += (xn[0] * xn[0] + xn[1] * xn[1]) + (xn[2] * xn[2] + xn[3] * xn[3]); }
                ss += __shfl_xor(ss, 16); ss += __shfl_xor(ss, 32); if (fq == 0) __hip_atomic_store(ssp + (size_t)r * 16 + u.pn * 4 + wc, ss, __ATOMIC_RELAXED, __HIP_MEMORY_SCOPE_AGENT); }
        }
        asm volatile("s_waitcnt vmcnt(0)" ::: "memory");
        if (lane == 0) __hip_atomic_fetch_add(cnt + 64 * u.pm, 1u, __ATOMIC_RELAXED, __HIP_MEMORY_SCOPE_AGENT);
        const int tid = wid * 64 + lane;
        if (tid == 0) { unsigned sp = 0; while (__hip_atomic_load(cnt + 64 * u.pm, __ATOMIC_RELAXED, __HIP_MEMORY_SCOPE_AGENT) < 32u) { __builtin_amdgcn_s_sleep(1); if (++sp > (1u << 22)) break; } }
        __syncthreads();
        LAS float* tab = (LAS float*)(lds + RS_TAB_OFF);
        { const int rr = tid >> 1, hf = tid & 1; const float* q = ssp + (size_t)(u.pm * 256 + rr) * 16 + hf * 8; float v_[8];
#pragma unroll
          for (int i = 0; i < 8; ++i) v_[i] = __hip_atomic_load(q + i, __ATOMIC_RELAXED, __HIP_MEMORY_SCOPE_AGENT);
          float s_ = ((v_[0] + v_[1]) + (v_[2] + v_[3])) + ((v_[4] + v_[5]) + (v_[6] + v_[7])); s_ += __shfl_xor(s_, 1);
          if (hf == 0) tab[rr] = 1.0f / sqrtf(s_ * (1.f / DM) + 1e-6f); }
        __syncthreads();
        f32x4 gf[2][2];
#pragma unroll
        for (int bj = 0; bj < 2; ++bj)
#pragma unroll
            for (int n = 0; n < 2; ++n) gf[bj][n] = *(const f32x4*)(gfin + col0 + bj * 128 + n * 16);
#pragma unroll
        for (int ai = 0; ai < 2; ++ai)
#pragma unroll
            for (int m = 0; m < 4; ++m) { const int rin = ai * 128 + wr * 64 + m * 16 + fr; const float rs = tab[rin]; float* op = out + (size_t)(u.pm * 256 + rin) * DM + col0;
#pragma unroll
                for (int bj = 0; bj < 2; ++bj)
#pragma unroll
                    for (int n = 0; n < 2; ++n) *(f32x4*)(op + bj * 128 + n * 16) = acc[ai][bj][m][n] * rs * gf[bj][n]; }
    }
};

constexpr int N_PHASES = 18;
__global__ void __launch_bounds__(NWAVES * 64, 2) fwd_kernel(Args a) {
    extern __shared__ __attribute__((aligned(16))) unsigned char lds_raw[];
    LAS unsigned char* lds = (LAS unsigned char*)lds_raw;
    cg::grid_group grid = cg::this_grid();
    const int tid = threadIdx.x, lane = tid & 63, wave = __builtin_amdgcn_readfirstlane(tid >> 6);
    unsigned char* ws = a.ws;
    const int lo = a.ph_lo, hi = a.ph_hi, G = gridDim.x, bx = blockIdx.x;
#ifndef PHASE_MASK
#define PHASE_MASK 0x3ffff
#endif
#define IN(k) (((PHASE_MASK >> (k)) & 1) && lo <= (k) && (k) < hi)
    {
        if (tid < 256) ((LAS unsigned*)(lds + 131072))[tid] = 0u;
        __syncthreads();
    }
    XcdBarrier bar = xcd_barrier_post((unsigned*)(ws + WS_CTL), (volatile LAS unsigned*)(lds + 131072 + 64));
    if (a.ph_lo < 0) grid.sync();
#define GSYNC() xcd_barrier(bar)
#ifndef TPROBE_MASK
#define TPROBE_MASK 0
#endif
#define TSTAMP(k) do { if (TPROBE_MASK != 0 && bx == 0 && tid == 0) ((LAS unsigned long long*)(lds + 131072 + 512))[(k)] = __builtin_amdgcn_s_memrealtime(); } while (0)
#define SEAM(k) do { if (IN(k) && (k) + 1 < hi) GSYNC(); TSTAMP((k) + 1); } while (0)
#ifndef RPT_MASK
#define RPT_MASK 0
#endif
#ifndef RPT_N
#define RPT_N 1
#endif
#ifndef EXTRA_SYNCS
#define EXTRA_SYNCS 0
#endif
#define PHASE(k, ...) do { if (IN(k)) { _Pragma("nounroll") for (int rp_ = 0; rp_ <= ((((RPT_MASK) >> (k)) & 1) ? (RPT_N) : 0); ++rp_) { if (rp_) GSYNC(); __VA_ARGS__; } } SEAM(k); } while (0)
    bf16* HB = (bf16*)(ws + WS_HB); bf16* X = (bf16*)(ws + WS_X);
    bf16* U = (bf16*)(ws + WS_R1); bf16* FH = (bf16*)(ws + WS_R1);
    const float* MOD = (const float*)(ws + WS_MOD); const float* GM = (const float*)(ws + WS_GM); const float* BV = (const float*)(ws + WS_BV); float* SSP = (float*)(ws + WS_SSP);
    const float* xin = a.in[0]; const float* ctxin = a.in[2];

    TSTAMP(0);
    PHASE(0, prologue(a, lds, tid, lane, wave); norm_mod_phase(xin, ctxin, MT, a.in[6], MOD, 0, 1, HB, wave, lane););
    PHASE(2, pg8::Gemm g{HB, (const bf16*)(ws + WS_WRCIN), MT, RCW, DM, 0}; pg8::StaticOrder S; S.init(MT, RCW, G, bx);
        EpiStore E{U, RCW}; pg8::gemm_phase<EpiStore, pg8::StaticOrder, true, true>(lds, g, S, E);
        {
            const int nfull2 = ((MT / 256) * (RCW / 256)) % G;
            const bool sub2 = !(nfull2 == 0 || G - nfull2 < 16); const int br2 = sub2 ? bx - nfull2 : bx, nb2 = sub2 ? G - nfull2 : G;
            if (br2 >= 0) {
                if (G == 256) { ada_items(a, lds, tid, wave, lane, 96, 192, br2, nb2, nullptr); aux_phase(a, tid, wave, lane, br2, nb2, 1);
                    copy_items(a, lds, wave, lane, COPY_GA + br2 * NWAVES + wave, COPY_GA + (br2 + nb2) * NWAVES + wave, nb2 * NWAVES, COPY_G1); }
                else { aux_phase(a, tid, wave, lane, br2, nb2, 3); aux_bias_f32(a, lds, tid, wave, lane, br2, nb2); }
            }
        });
    PHASE(3, rg1_phase(a, lds, tid, lane, wave););
    PHASE(4, rg_carry_phase(a, lds, wave, lane); sc_phase(a, wave, lane););
    PHASE(5, rg3_phase(a, wave, lane););
    PHASE(6, const bool split6 = (G == 256);
        if (split6) {
            { pg8::Gemm g{HB, (const bf16*)(ws + WS_WRCOUT), ML, DM, DM, 0}; pg8::StaticOrder S; S.init(ML, DM, G, bx);
              EpiResid<false> E{xin, ctxin, X, MOD + 2 * 1024, (bf16*)a.out, GM, SSP}; pg8::gemm_phase<EpiResid<false>, pg8::StaticOrder, true, true>(lds, g, S, E); }
            unsigned* cnt6 = (unsigned*)(ws + WS_CTL) + CTL_CTXCNT + 64;
            if (bx < 32) { const int sl = bx & 3, cu_ = bx >> 2;
                pg8::Gemm g2{HB + (size_t)ML * DM + sl * 256, (const bf16*)(ws + WS_WRCOUT) + sl * 256, MC, DM, 256, DM}; OneUnitCounted S2{cu_ >> 2, cu_ & 3, lane, cnt6};
                EpiPartial E2{(float*)(ws + WS_PART) + (size_t)sl * MC * DM}; pg8::gemm_phase<EpiPartial, OneUnitCounted, true, true>(lds, g2, S2, E2); }
            else if (bx < 96) { wait_count(cnt6, 8u * 32u, tid);
                ctx_finish_row<false>(a, (bx - 32) * NWAVES + wave, lane, ctxin, MOD + (size_t)2 * 6144 + 2 * 1024, GM + 2 * 1024, (bf16*)a.out); }
            else { const int w0 = (bx - 96) * NWAVES + wave, nw = (G - 96) * NWAVES; copy_items(a, lds, wave, lane, COPY_G1 + w0, COPY_G1 + w0 + nw, nw, COPY_G2); }
        } else { pg8::Gemm g{HB, (const bf16*)(ws + WS_WRCOUT), MT, DM, DM, 0}; pg8::StaticOrder S; S.init(MT, DM, G, bx);
            EpiResid<false> E{xin, ctxin, X, MOD + 2 * 1024, (bf16*)a.out, GM, SSP}; pg8::gemm_phase<EpiResid<false>, pg8::StaticOrder, true, true>(lds, g, S, E); });
    PHASE(8, pg8::Gemm g{(const bf16*)a.out, (const bf16*)(ws + WS_WFIN0), MT, 2 * DFF, DM, 0}; CtxFirstOrder S{G, bx, lane, (unsigned*)(ws + WS_CTL) + CTL_CTXCNT};
        rstd_table(lds, SSP, S, tid); EpiSwiGLU E{FH, DFF, lds, BV, true}; pg8::gemm_phase<EpiSwiGLU, CtxFirstOrder, true, true>(lds, g, S, E);
        {
            const int nfull = (FIN_CTX_UNITS + FIN_LAT_UNITS) % G, su = bx - nfull;
            if (nfull != 0 && G - nfull >= 32 && su >= 0 && su < 32) {
                wait_count((unsigned*)(ws + WS_CTL) + CTL_CTXCNT, 8u * FIN_CTX_UNITS, tid);
                const int sl = su & 3, cu_ = su >> 2, k0 = sl < 2 ? sl * 768 : 1536 + (sl - 2) * 640, klen = sl < 2 ? 768 : 640;
                pg8::Gemm g2{FH + (size_t)ML * DFF + k0, (const bf16*)(ws + WS_WFOUT0) + k0, MC, DM, klen, DFF}; OneUnit S2{cu_ >> 2, cu_ & 3};
                EpiPartial E2{(float*)(ws + WS_PART) + (size_t)sl * MC * DM}; pg8::gemm_phase<EpiPartial, OneUnit, true, true>(lds, g2, S2, E2);
            }
            else if (G == 256 && su >= 32) { aux_phase(a, tid, wave, lane, su - 32, G - nfull - 32, 2); aux_bias_f32(a, lds, tid, wave, lane, su - 32, G - nfull - 32); }
        });
    PHASE(9, const int nfull9 = (FIN_CTX_UNITS + FIN_LAT_UNITS) % G; const bool split9 = nfull9 != 0 && G - nfull9 >= 32;
        if (split9) { { const int rpb = (MC + G - 1) / G <= NWAVES ? (MC + G - 1) / G : NWAVES;
              const int rc = rpb * ((MC + G - 1) / G <= NWAVES ? bx : 0) + wave + ((MC + G - 1) / G <= NWAVES ? 0 : bx * NWAVES); if (wave < rpb && rc < MC) ctx_finish_row<true>(a, rc, lane, X + (size_t)ML * DM, MOD + (size_t)2 * 6144 + 5 * 1024, GM + 3072 + 2 * 1024, HB); }
            pg8::Gemm g{FH, (const bf16*)(ws + WS_WFOUT0), ML, DM, DFF, 0}; pg8::StaticOrder S; S.init(ML, DM, G, bx);
            EpiResid<true> E{X, X + (size_t)ML * DM, X, MOD + 5 * 1024, HB, GM + 3072, SSP}; pg8::gemm_phase<EpiResid<true>, pg8::StaticOrder, true, true>(lds, g, S, E); }
        else { pg8::Gemm g{FH, (const bf16*)(ws + WS_WFOUT0), MT, DM, DFF, 0}; pg8::StaticOrder S; S.init(MT, DM, G, bx);
            EpiResid<true> E{X, X + (size_t)ML * DM, X, MOD + 5 * 1024, HB, GM + 3072, SSP}; pg8::gemm_phase<EpiResid<true>, pg8::StaticOrder, true, true>(lds, g, S, E); });
    const float* MOD1 = MOD + 3 * 6144;
    PHASE(11, pg8::Gemm g{HB, (const bf16*)(ws + WS_WQKV), MT, NQKV, DM}; pg8::StaticOrder S; S.init(MT, NQKV, G, bx);
        EpiQKV E{(bf16*)(ws + WS_Q), (bf16*)(ws + WS_KV), (const float*)(ws + WS_ROPEC), (const float*)(ws + WS_ROPES), lds, BV + 3 * 2 * DFF}; rstd_table(lds, SSP, S, tid);
        pg8::gemm_phase<EpiQKV, pg8::StaticOrder, true, true>(lds, g, S, E);
        if (G == 256) {
            const int nfull11 = ((MT / 256) * (NQKV / 256)) % G, nidle = G - nfull11;
            if (bx >= nfull11) { const int w0 = (bx - nfull11) * NWAVES + wave; copy_items(a, lds, wave, lane, COPY_G2 + w0, COPY_G2 + w0 + nidle * NWAVES, nidle * NWAVES, COPY_G3); }
        });
    PHASE(12, attn_phase(a, lds, tid, lane, wave););
    PHASE(13, pg8::Gemm g{(const bf16*)(ws + WS_O), (const bf16*)(ws + WS_WAOUT), ML, DM, DM}; pg8::StaticOrder S; S.init(ML, DM, G, bx);
        EpiResid<true> E{X, X + (size_t)ML * DM, X, MOD1 + 2 * 1024, HB, GM + 2 * 3072, SSP}; pg8::gemm_phase<EpiResid<true>, pg8::StaticOrder, true, true>(lds, g, S, E););
    PHASE(15, pg8::Gemm g{HB, (const bf16*)(ws + WS_WFIN1), ML, 2 * DFF, DM}; pg8::StaticOrder S; S.init(ML, 2 * DFF, G, bx);
        rstd_table(lds, SSP, S, tid); EpiSwiGLU E{FH, DFF, lds, BV + 2 * 3 * 2 * DFF, WT_ALL != 0}; pg8::gemm_phase<EpiSwiGLU, pg8::StaticOrder, true, true>(lds, g, S, E);
        if (G == 256) { const int nfull15 = ((ML / 256) * (2 * DFF / 256)) % G, nidle = G - nfull15;
            if (bx >= nfull15) { const int w0 = (bx - nfull15) * NWAVES + wave; copy_items(a, lds, wave, lane, COPY_G3 + w0, COPY_G3 + w0 + nidle * NWAVES, nidle * NWAVES, COPY_NITEMS); } });
    const bool fuse16 = (G == 256);
    if (IN(16)) {
        if (fuse16) { pg8::Gemm g{FH, (const bf16*)(ws + WS_WFOUT1), ML, DM, DFF, 0}; pg8::StaticOrder S; S.init(ML, DM, G, bx);
            EpiFinal E{X, MOD1 + 5 * 1024, a.in[8], a.out, SSP, (unsigned*)(ws + WS_CTL) + CTL_CTXCNT + 128}; pg8::gemm_phase<EpiFinal, pg8::StaticOrder, false, true>(lds, g, S, E); }
        else { pg8::Gemm g{FH, (const bf16*)(ws + WS_WFOUT1), ML, DM, DFF, 0}; pg8::StaticOrder S; S.init(ML, DM, G, bx);
            EpiResid<true> E{X, X + (size_t)ML * DM, X, MOD1 + 5 * 1024, nullptr, nullptr, nullptr}; pg8::gemm_phase<EpiResid<true>, pg8::StaticOrder, true, true>(lds, g, S, E);
            GSYNC(); }
    }
    TSTAMP(17);
    if (IN(17) && !fuse16) { final_norm_phase(X, a.in[8], a.out, wave, lane); }
    TSTAMP(18);
    for (int es_ = 0; es_ < EXTRA_SYNCS; ++es_) GSYNC();
    if (TPROBE_MASK != 0 && bx == 0 && tid == 0) {
        const LAS unsigned long long* ts = (const LAS unsigned long long*)(lds + 131072 + 512); unsigned long long sum = 0;
        unsigned long long last = ts[0];
        for (int k = 0; k < N_PHASES; ++k) { const unsigned long long t = ts[k + 1]; if (t != 0ull) { if ((TPROBE_MASK >> k) & 1) sum += t - last; last = t; } }
        const unsigned long long t0 = __builtin_amdgcn_s_memrealtime();
        while (__builtin_amdgcn_s_memrealtime() - t0 < 7ull * sum) __builtin_amdgcn_s_sleep(8);
    }
#undef IN
#undef SEAM
}

#ifndef MK_MULTI
#define MK_MULTI 0
#endif
extern "C" void kernel_launch(void* const* d_in, const int* in_sizes, int n_in, void* d_out, int out_size, void* d_ws, size_t ws_size, hipStream_t stream) {
    static int grid = 0;
    if (grid == 0) {
        if (n_in != 24 || out_size != ML * DM || ws_size < WS_END) { fprintf(stderr, "kernel_launch: unexpected shapes n_in %d out %d ws %zu\n", n_in, out_size, ws_size); grid = -1; return; }
        int dev = 0, cus = 0, per_cu = 0;
        hipGetDevice(&dev); hipDeviceGetAttribute(&cus, hipDeviceAttributeMultiprocessorCount, dev);
        if (hipFuncSetAttribute((const void*)fwd_kernel, hipFuncAttributeMaxDynamicSharedMemorySize, LDS_BYTES) != hipSuccess) { fprintf(stderr, "kernel_launch: hipFuncSetAttribute failed\n"); grid = -1; return; }
        if (hipOccupancyMaxActiveBlocksPerMultiprocessor(&per_cu, (const void*)fwd_kernel, NWAVES * 64, LDS_BYTES) != hipSuccess || per_cu < 1) { fprintf(stderr, "kernel_launch: occupancy query says %d\n", per_cu); per_cu = 1; }
        (void)hipGetLastError();
        grid = cus * 1;
    }
    if (grid < 0) return;
    Args a{};
    for (int i = 0; i < 24; ++i) a.in[i] = (const float*)d_in[i];
    a.out = (float*)d_out; a.ws = (unsigned char*)d_ws;
#if MK_MULTI
    for (int p = 0; p < N_PHASES; ++p) { a.ph_lo = p; a.ph_hi = p + 1; hipLaunchKernelGGL(fwd_kernel, dim3(grid), dim3(NWAVES * 64), LDS_BYTES, stream, a); }
#else
    a.ph_lo = 0; a.ph_hi = N_PHASES;
    if (hipMemsetAsync((char*)d_ws + WS_CTL, 0, CTL_BYTES, stream) != hipSuccess) { fprintf(stderr, "kernel_launch: memset failed\n"); return; }
    void* args[] = {&a};
    hipError_t e = hipLaunchCooperativeKernel((const void*)fwd_kernel, dim3(grid), dim3(NWAVES * 64), args, LDS_BYTES, stream);
    if (e != hipSuccess) fprintf(stderr, "kernel_launch: cooperative launch failed: %s (grid %d)\n", hipGetErrorString(e), grid);
#endif
}
```
